# Optimizing an MI355X kernel written in HIP

```python
import jax, jax.numpy as jnp
from jax import lax
import numpy as np

D_MODEL = 1024
BATCH = 2
SEQ = 16384
DEPTH = 4
DEC_BATCH = 16
DEC_SEQ = 16
PAST_LEN = 1024

CHUNK = 64
N_MIXERS = 2
N_RET_LAYERS = (DEPTH + 1) // 2
N_POOL_LAYERS = DEPTH // 2
RET_HEADS = 4
RET_DK = D_MODEL // RET_HEADS
RET_DV = 2 * RET_DK
RET_QK = RET_HEADS * RET_DK
RET_VDIM = RET_HEADS * RET_DV
RET_IN = 2 * RET_QK + 2 * RET_VDIM
ROPE_BASE = 10000.0
POOL_WINDOWS = (2, 4, 8, 16)
POOL_GROUPS = len(POOL_WINDOWS)
POOL_GW = D_MODEL // POOL_GROUPS
POOL_BUF = max(POOL_WINDOWS) - 1
D_FF = -(-8 * D_MODEL // (3 * 256)) * 256
EPS = 1e-6

kernel_name = "retnet_pool_interleaved_stream_step"


def _rmsnorm(x, g):
    xf = x.astype(jnp.float32)
    y = xf * lax.rsqrt(jnp.mean(xf * xf, axis=-1, keepdims=True) + EPS)
    return (y * g.astype(jnp.float32)).astype(x.dtype)


def _rotary(x, pos):
    half = x.shape[-1] // 2
    inv = ROPE_BASE ** (-jnp.arange(half, dtype=jnp.float32) / half)
    ang = pos.astype(jnp.float32)[:, None] * inv[None, :]
    cos, sin = jnp.cos(ang), jnp.sin(ang)
    x1, x2 = x[..., :half], x[..., half:]
    return jnp.concatenate([x1 * cos - x2 * sin, x1 * sin + x2 * cos], axis=-1)


def _log_gamma():
    return jnp.log1p(-jnp.exp2(-5.0 - jnp.arange(RET_HEADS, dtype=jnp.float32)))[:, None]


def _retention_block(q, k, v, S, lg):
    C = q.shape[2]
    idx = jnp.arange(C, dtype=jnp.float32)
    diff = idx[:, None] - idx[None, :]
    dmask = jnp.where(diff >= 0, jnp.exp(lg[:, :, None] * jnp.maximum(diff, 0.0)), 0.0)
    scores = jnp.einsum('bhnd,bhmd->bhnm', q, k) * dmask
    inner = jnp.einsum('bhnm,bhme->bhne', scores, v)
    q_dec = q * jnp.exp(lg * (idx + 1.0))[None, :, :, None]
    cross = jnp.einsum('bhnd,bhde->bhne', q_dec, S)
    k_dec = k * jnp.exp(lg * (C - 1.0 - idx))[None, :, :, None]
    S_new = jnp.exp(lg * C)[None, :, :, None] * S + jnp.einsum('bhmd,bhme->bhde', k_dec, v)
    return inner + cross, S_new


def _retention(h, S0, pos, w_in, w_out):
    B, L, _ = h.shape
    proj = h @ w_in
    q, k, v, g = jnp.split(proj, [RET_QK, 2 * RET_QK, 2 * RET_QK + RET_VDIM], axis=-1)

    def heads(t, dh):
        return t.reshape(B, L, RET_HEADS, dh).transpose(0, 2, 1, 3).astype(jnp.float32)

    q = _rotary(heads(q, RET_DK), pos)
    k = _rotary(heads(k, RET_DK), pos) * (RET_DK ** -0.5)
    v = heads(v, RET_DV)
    nc = max(L // CHUNK, 1)
    c = L // nc

    def to_blocks(t):
        return t.reshape(B, RET_HEADS, nc, c, t.shape[-1]).transpose(2, 0, 1, 3, 4)

    lg = _log_gamma()

    def step(S, blk):
        qb, kb, vb = blk
        o, S = _retention_block(qb, kb, vb, S, lg)
        return S, o

    S_fin, o = lax.scan(step, S0.astype(jnp.float32), (to_blocks(q), to_blocks(k), to_blocks(v)))
    o = o.transpose(1, 2, 0, 3, 4).reshape(B, RET_HEADS, L, RET_DV)
    o = o * lax.rsqrt(jnp.mean(o * o, axis=-1, keepdims=True) + EPS)
    o = o.transpose(0, 2, 1, 3).reshape(B, L, RET_VDIM)
    y = (jax.nn.silu(g.astype(jnp.float32)) * o).astype(h.dtype) @ w_out
    return y, S_fin


def _pool(h, buf, pos, w_pool, scale):
    B, L, D = h.shape
    xp = jnp.concatenate([buf.astype(h.dtype), h], axis=1)
    cs = jnp.cumsum(xp.astype(jnp.float32), axis=1)
    cs = jnp.concatenate([jnp.zeros((B, 1, D), jnp.float32), cs], axis=1)
    hf = h.astype(jnp.float32)
    start = POOL_BUF + 1
    diffs = []
    for gi, w in enumerate(POOL_WINDOWS):
        sl = slice(gi * POOL_GW, (gi + 1) * POOL_GW)
        wsum = cs[:, start:start + L, sl] - cs[:, start - w:start - w + L, sl]
        cnt = jnp.minimum(pos + 1, w).astype(jnp.float32)[None, :, None]
        diffs.append(wsum / cnt - hf[:, :, sl])
    d = jnp.stack(diffs, axis=2).astype(h.dtype)
    y = jnp.einsum('blgc,gce->blge', d, w_pool).reshape(B, L, D) * scale
    return y, xp[:, -POOL_BUF:]


def _swiglu(h, w_in, w_out):
    a, b = jnp.split(h @ w_in, 2, axis=-1)
    return (jax.nn.silu(a) * b) @ w_out


def _trunk(x, pos, ret_states, pool_bufs, norm_mix, w_ret_in, w_ret_out, w_pool, pool_scale,
           norm_ffn, w_ffn_in, w_ffn_out, norm_final):
    new_ret, new_pool = [], []
    for i in range(DEPTH):
        j = i // N_MIXERS
        h = _rmsnorm(x, norm_mix[i])
        if i % N_MIXERS == 0:
            y, s = _retention(h, ret_states[j], pos, w_ret_in[j], w_ret_out[j])
            new_ret.append(s.astype(ret_states.dtype))
        else:
            y, b = _pool(h, pool_bufs[j], pos, w_pool[j], pool_scale[j])
            new_pool.append(b.astype(pool_bufs.dtype))
        x = x + y
        x = x + _swiglu(_rmsnorm(x, norm_ffn[i]), w_ffn_in[i], w_ffn_out[i])
    return _rmsnorm(x, norm_final), jnp.stack(new_ret), jnp.stack(new_pool)


def setup_inputs(seed: int = 0) -> dict:
    key = jax.random.key(seed)
    ks = jax.random.split(key, 14)
    f32 = jnp.float32
    nrm = lambda k, s, sc: jax.random.normal(k, s, f32) * sc
    return {
        "x_prompt": nrm(ks[0], (BATCH, SEQ, D_MODEL), 1.0),
        "x_sample": nrm(ks[1], (DEC_BATCH, DEC_SEQ, D_MODEL), 1.0),
        "state_ret": nrm(ks[2], (N_RET_LAYERS, DEC_BATCH, RET_HEADS, RET_DK, RET_DV), 0.5),
        "state_pool": nrm(ks[3], (N_POOL_LAYERS, DEC_BATCH, POOL_BUF, D_MODEL), 1.0),
        "norm_mix": 1.0 + nrm(ks[4], (DEPTH, D_MODEL), 0.1),
        "w_ret_in": nrm(ks[5], (N_RET_LAYERS, D_MODEL, RET_IN), D_MODEL ** -0.5),
        "w_ret_out": nrm(ks[6], (N_RET_LAYERS, RET_VDIM, D_MODEL), RET_VDIM ** -0.5),
        "w_pool": nrm(ks[7], (N_POOL_LAYERS, POOL_GROUPS, POOL_GW, POOL_GW), POOL_GW ** -0.5),
        "pool_scale": 1.0 + nrm(ks[8], (N_POOL_LAYERS, D_MODEL), 0.1),
        "norm_ffn": 1.0 + nrm(ks[9], (DEPTH, D_MODEL), 0.1),
        "w_ffn_in": nrm(ks[10], (DEPTH, D_MODEL, 2 * D_FF), D_MODEL ** -0.5),
        "w_ffn_out": nrm(ks[11], (DEPTH, D_FF, D_MODEL), D_FF ** -0.5),
        "norm_final": 1.0 + nrm(ks[12], (D_MODEL,), 0.1),
    }


def reference(x_prompt, x_sample, state_ret, state_pool, norm_mix, w_ret_in, w_ret_out, w_pool,
              pool_scale, norm_ffn, w_ffn_in, w_ffn_out, norm_final):
    Bp, Lp, _ = x_prompt.shape
    Bs, Ls, _ = x_sample.shape
    pos_p = jnp.arange(Lp, dtype=jnp.int32)
    pos_s = PAST_LEN + jnp.arange(Ls, dtype=jnp.int32)
    ret0 = jnp.zeros((N_RET_LAYERS, Bp, RET_HEADS, RET_DK, RET_DV), state_ret.dtype)
    pool0 = jnp.zeros((N_POOL_LAYERS, Bp, POOL_BUF, D_MODEL), state_pool.dtype)
    y_prompt, ret_prompt_new, pool_prompt_new = _trunk(
        x_prompt, pos_p, ret0, pool0, norm_mix, w_ret_in, w_ret_out, w_pool, pool_scale,
        norm_ffn, w_ffn_in, w_ffn_out, norm_final)
    y_sample, ret_sample_new, pool_sample_new = _trunk(
        x_sample, pos_s, state_ret, state_pool, norm_mix, w_ret_in, w_ret_out, w_pool, pool_scale,
        norm_ffn, w_ffn_in, w_ffn_out, norm_final)
    return (y_prompt, y_sample, ret_prompt_new, ret_sample_new, pool_prompt_new, pool_sample_new)
```

```cpp
#include <hip/hip_runtime.h>
#include <hip/hip_cooperative_groups.h>
#include <cstdio>
namespace cg = cooperative_groups;
__device__ __forceinline__ int opaque_tid() { int t = (int)threadIdx.x; asm volatile("" : "+v"(t)); return t; }
namespace pg8 {
#define PG8_LAS __attribute__((address_space(3)))
typedef unsigned short bf16_t;
typedef short bf16x8 __attribute__((ext_vector_type(8)));
typedef float f32x4 __attribute__((ext_vector_type(4)));
typedef unsigned u32x4 __attribute__((ext_vector_type(4)));
constexpr int BM = 256, BK = 64, HALF = 128, HTB = HALF * BK * 2  , STAGE_BYTES = 8 * HTB, NXCD = 8, WGM = 8;

__host__ __device__ __forceinline__ int lds_byte(int r, int c) { const int st = (r >> 4) * 2 + (c >> 5), rr = r & 15, cc = c & 31, ob = rr * 64 + cc * 2; return st * 1024 + (ob ^ (((ob >> 9) & 1) << 5)); }
__host__ __device__ __forceinline__ void stage_rc(int b, int& R, int& C) { const int st = b / 1024, sb = b % 1024, swz = sb ^ (((sb >> 9) & 1) << 5); R = (st >> 1) * 16 + swz / 64; C = (st & 1) * 32 + (swz % 64) / 2; }
__host__ __device__ __forceinline__ int perm32(int rho) { const int n = rho >> 4, i = rho & 15; return 8 * (i >> 2) + 4 * n + (i & 3); }

struct Unit { int pm, pn; };
struct Gemm { const bf16_t* A; const bf16_t* Bt; int M, N, K; };

struct StaticOrder {
    int nM, nN, nwg, G, c;
    __host__ __device__ void init(int M, int N, int G_, int c_) { nM = M / BM; nN = N / BM; nwg = nM * nN; G = G_; c = c_; }
    __host__ __device__ bool next(int i, Unit& u) const {
        const long L = (long)i * G + c; if (L >= nwg) return false;
        int wgid = (int)L; { const int q = nwg / NXCD, r = nwg % NXCD, xcd = wgid % NXCD, off = wgid / NXCD; wgid = (xcd < r ? xcd * (q + 1) : r * (q + 1) + (xcd - r) * q) + off; }
        const int nig = WGM * nN, gid = wgid / nig, fm = gid * WGM, gsz = (nM - fm) < WGM ? (nM - fm) : WGM;
        u.pm = fm + ((wgid % nig) % gsz); u.pn = (wgid % nig) / gsz; return true;
    }
    __device__ __forceinline__ void a_ready(const Unit&) const {}
    __device__ __forceinline__ void done(const Unit&) const {}
};
struct CountedOrder : StaticOrder {
    const unsigned* ready; unsigned need; unsigned* tmo;
    __device__ __forceinline__ void a_ready(const Unit& u) const {
        if (threadIdx.x < 64) {
            const unsigned long long t0 = __builtin_amdgcn_s_memrealtime(); unsigned polls = 0;
            while ((unsigned)__builtin_amdgcn_readfirstlane(__hip_atomic_load(ready + 64 * u.pm, __ATOMIC_RELAXED, __HIP_MEMORY_SCOPE_AGENT)) < need) {
                if ((++polls & 255u) == 0u && __builtin_amdgcn_readfirstlane(__hip_atomic_load(tmo, __ATOMIC_RELAXED, __HIP_MEMORY_SCOPE_AGENT)) != 0u) break;
                if (__builtin_amdgcn_s_memrealtime() - t0 > 2000000ull) {
                    if (threadIdx.x == 0) { unsigned expect = 0u; __hip_atomic_compare_exchange_strong(tmo + 1, &expect, 0x600u | (unsigned)(u.pm & 0xff), __ATOMIC_RELAXED, __ATOMIC_RELAXED, __HIP_MEMORY_SCOPE_AGENT); __hip_atomic_store(tmo, 1u, __ATOMIC_RELAXED, __HIP_MEMORY_SCOPE_AGENT); }
                    break; }
                __builtin_amdgcn_s_sleep(2); }
            __builtin_amdgcn_fence(__ATOMIC_ACQUIRE, "agent");
            asm volatile("s_waitcnt vmcnt(0)" ::: "memory");
        }
#if !defined(BROKEN_HOOK_NO_BARRIER)
        asm volatile("" ::: "memory"); __builtin_amdgcn_s_barrier(); asm volatile("" ::: "memory");
#endif
    }
};

__device__ __forceinline__ unsigned cvt_pk_bf16(float lo, float hi) { unsigned r; asm volatile("v_cvt_pk_bf16_f32 %0, %1, %2" : "=v"(r) : "v"(lo), "v"(hi)); return r; }
typedef float f32x2 __attribute__((ext_vector_type(2)));
__device__ __forceinline__ f32x2 gelu_pk(f32x2 v) {
    const f32x2 av = __builtin_elementwise_abs(v), d = av * 0.2316418882f + 1.0f;
    f32x2 t; t.x = __builtin_amdgcn_rcpf(d.x); t.y = __builtin_amdgcn_rcpf(d.y);
    f32x2 q = t * 0.5307027145f + (-0.7265760135f); q = q * t + 0.7107068705f; q = q * t + (-0.142248368f); q = q * t + 0.127414796f; q = q * t;
    const f32x2 s = (v * v) * (-0.72134752044f);
    f32x2 e; e.x = __builtin_amdgcn_exp2f(s.x); e.y = __builtin_amdgcn_exp2f(s.y);
    const f32x2 m = v * (q * e), r = v - m;
    f32x2 o; o.x = v.x < 0.f ? m.x : r.x; o.y = v.y < 0.f ? m.y : r.y; return o;
}

struct EpiF32 {
    static constexpr bool PERM = false, AFTER_DRAIN = false;
    float* C; int ldc; const float* bias;
    __device__ __forceinline__ void operator()(const f32x4 (&acc)[2][2][4][2], const Unit& u, int wr, int wc, int fr, int fq) const {
        const int row0 = u.pm * BM + wr * 64 + fr, col0 = u.pn * BM + wc * 32 + 4 * fq;
        f32x4 bv[2][2];
#pragma unroll
        for (int bj = 0; bj < 2; ++bj)
#pragma unroll
            for (int n = 0; n < 2; ++n) bv[bj][n] = bias ? *(const f32x4*)(bias + col0 + bj * HALF + n * 16) : (f32x4){0.f, 0.f, 0.f, 0.f};
#pragma unroll
        for (int ai = 0; ai < 2; ++ai)
#pragma unroll
            for (int m = 0; m < 4; ++m) { float* rowp = C + (size_t)(row0 + ai * HALF + m * 16) * ldc + col0;
#pragma unroll
                for (int bj = 0; bj < 2; ++bj)
#pragma unroll
                    for (int n = 0; n < 2; ++n) *(f32x4*)(rowp + bj * HALF + n * 16) = acc[ai][bj][m][n] + bv[bj][n]; }
    }
};
template <int ACT  > struct EpiBf16 {
    static constexpr bool PERM = true, AFTER_DRAIN = false;
    bf16_t* O; int ldc; const float* bias; int split_cols; size_t split_stride;
    __device__ __forceinline__ void operator()(const f32x4 (&acc)[2][2][4][2], const Unit& u, int wr, int wc, int fr, int fq) const {
        const int row0 = u.pm * BM + wr * 64 + fr; int colt = u.pn * BM; bf16_t* base = O;
        if (split_cols) { const int t = colt / split_cols; base += (size_t)t * split_stride; colt -= t * split_cols; }
        const int col0 = colt + wc * 32 + 8 * fq, bcol0 = u.pn * BM + wc * 32 + 8 * fq;
        f32x4 bv[2][2];
#pragma unroll
        for (int bj = 0; bj < 2; ++bj)
#pragma unroll
            for (int n = 0; n < 2; ++n) bv[bj][n] = bias ? *(const f32x4*)(bias + bcol0 + bj * HALF + 4 * n) : (f32x4){0.f, 0.f, 0.f, 0.f};
#pragma unroll
        for (int ai = 0; ai < 2; ++ai)
#pragma unroll
            for (int m = 0; m < 4; ++m) { bf16_t* rowp = base + (size_t)(row0 + ai * HALF + m * 16) * ldc + col0;
#pragma unroll
                for (int bj = 0; bj < 2; ++bj) { f32x4 v0 = acc[ai][bj][m][0] + bv[bj][0], v1 = acc[ai][bj][m][1] + bv[bj][1];
                    if (ACT == 1) { f32x2 a = gelu_pk((f32x2){v0[0], v0[1]}), b = gelu_pk((f32x2){v0[2], v0[3]}), c = gelu_pk((f32x2){v1[0], v1[1]}), d = gelu_pk((f32x2){v1[2], v1[3]});
                        v0 = (f32x4){a.x, a.y, b.x, b.y}; v1 = (f32x4){c.x, c.y, d.x, d.y}; }
                    if (ACT == 2) {
#pragma unroll
                        for (int j = 0; j < 4; ++j) { v0[j] = 0.5f * v0[j] * (1.0f + erff(v0[j] * 0.70710678f)); v1[j] = 0.5f * v1[j] * (1.0f + erff(v1[j] * 0.70710678f)); } }
                    u32x4 w; w.x = cvt_pk_bf16(v0[0], v0[1]); w.y = cvt_pk_bf16(v0[2], v0[3]); w.z = cvt_pk_bf16(v1[0], v1[1]); w.w = cvt_pk_bf16(v1[2], v1[3]);
                    *(u32x4*)(rowp + bj * HALF) = w; } }
    }
};

template <class Epi, class Sched, bool STAMP = false>
__device__ __forceinline__ void gemm_phase(PG8_LAS unsigned char* lds, const Gemm g, const Sched& S, const Epi& E, unsigned long long* stamps, int lda_ = 0) {
    const int tid = opaque_tid(), wid = __builtin_amdgcn_readfirstlane(tid >> 6), lane = tid & 63, wr = wid >> 2, wc = wid & 3, fr = lane & 15, fq = lane >> 4;
    const int K = g.K, nt = K / BK, lda = lda_ ? lda_ : K;
    int ts_lo = 0, ts_hi = 0, nts = 0; const unsigned long long rt_entry = STAMP ? (unsigned long long)wall_clock64() : 0ull;
#define PG8_STAMP() do { if (STAMP && wid == 0 && nts < 64) { const unsigned long long _c = (unsigned long long)clock64(); \
        ts_lo = (lane == nts) ? (int)(unsigned)_c : ts_lo; ts_hi = (lane == nts) ? (int)(unsigned)(_c >> 32) : ts_hi; ++nts; } } while (0)
    PG8_STAMP();
    unsigned voffA[2], voffB[2];
#pragma unroll
    for (int i = 0; i < 2; ++i) { int R, C; stage_rc(tid * 16 + i * 8192, R, C); const int Rb = Epi::PERM ? ((R & ~31) + perm32(R & 31)) : R;
        voffA[i] = (unsigned)(R * lda + C) * 2u; voffB[i] = (unsigned)(Rb * K + C) * 2u; }
    const size_t kstep = (size_t)(BK * 2);
    const size_t hstep = (size_t)HALF * K * 2;
    const size_t tstep = 2 * hstep; const size_t hstepA = (size_t)HALF * lda * 2, tstepA = 2 * hstepA;
    const unsigned ldsw = (unsigned)wid * 1024u;
    const int aoff = lds_byte(wr * 64 + fr, fq * 8), boff = lds_byte(wc * 32 + fr, fq * 8);
#define PG8_SA(b, h) (((b) * 2 + (h)) * HTB)
#define PG8_SB(b, h) ((4 + (b) * 2 + (h)) * HTB)
#define PG8_STAGE(bufoff, gbase, voff) do { _Pragma("unroll") for (int _i = 0; _i < 2; ++_i) \
        __builtin_amdgcn_global_load_lds((const unsigned*)((const char*)(gbase) + (voff)[_i]), (PG8_LAS unsigned*)(lds + (bufoff) + ldsw + _i * 8192), 16, 0, 0); } while (0)
#define PG8_LDA(dst, b, h) do { _Pragma("unroll") for (int m = 0; m < 4; ++m) _Pragma("unroll") for (int k = 0; k < 2; ++k) dst[m][k] = *(const PG8_LAS bf16x8*)(lds + PG8_SA(b, h) + aoff + m * 2048 + k * 1024); } while (0)
#define PG8_LDB(dst, b, h) do { _Pragma("unroll") for (int n = 0; n < 2; ++n) _Pragma("unroll") for (int k = 0; k < 2; ++k) dst[n][k] = *(const PG8_LAS bf16x8*)(lds + PG8_SB(b, h) + boff + n * 2048 + k * 1024); } while (0)
#define PG8_MMA(ai, bj, At, Bt) do { __builtin_amdgcn_s_setprio(1); _Pragma("unroll") for (int m = 0; m < 4; ++m) _Pragma("unroll") for (int n = 0; n < 2; ++n) _Pragma("unroll") for (int k = 0; k < 2; ++k) \
        acc[ai][bj][m][n] = __builtin_amdgcn_mfma_f32_16x16x32_bf16(Bt[n][k], At[m][k], acc[ai][bj][m][n], 0, 0, 0); __builtin_amdgcn_s_setprio(0); } while (0)
#define PG8_WAIT_V(n) asm volatile("s_waitcnt vmcnt(" #n ")" ::: "memory")
#define PG8_WAIT_L(n) asm volatile("s_waitcnt lgkmcnt(" #n ")" ::: "memory")
#define PG8_BAR __builtin_amdgcn_s_barrier()
#define PG8_SCHED __builtin_amdgcn_sched_barrier(0)
    Unit cur, nxt; int ui = 0;
    if (!S.next(0, cur)) return;
    f32x4 acc[2][2][4][2];
#pragma unroll
    for (int a = 0; a < 2; ++a)
#pragma unroll
        for (int b = 0; b < 2; ++b)
#pragma unroll
            for (int m = 0; m < 4; ++m)
#pragma unroll
                for (int n = 0; n < 2; ++n) acc[a][b][m][n] = (f32x4){0.f, 0.f, 0.f, 0.f};
    bf16x8 At[4][2], B0[2][2], B1[2][2];
    const char* cA = (const char*)g.A + (size_t)cur.pm * tstepA; const char* cB = (const char*)g.Bt + (size_t)cur.pn * tstep;
    S.a_ready(cur);
    PG8_STAGE(PG8_SB(0, 0), cB, voffB); PG8_STAGE(PG8_SA(0, 0), cA, voffA); PG8_STAGE(PG8_SB(0, 1), cB + hstep, voffB); PG8_STAGE(PG8_SA(0, 1), cA + hstepA, voffA);
    if (wr == 1) PG8_BAR;
    PG8_WAIT_V(4); PG8_BAR;
    PG8_STAGE(PG8_SB(1, 0), cB + kstep, voffB); PG8_STAGE(PG8_SA(1, 0), cA + kstep, voffA); PG8_STAGE(PG8_SB(1, 1), cB + hstep + kstep, voffB);
    PG8_WAIT_V(6); PG8_BAR;
    PG8_STAMP();
    for (;;) {
        const bool has_next = S.next(ui + 1, nxt);
        const char* nA = has_next ? (const char*)g.A + (size_t)nxt.pm * tstepA : cA; const char* nB = has_next ? (const char*)g.Bt + (size_t)nxt.pn * tstep : cB;
        for (int t = 0; t < nt; t += 2) {
            const bool last = (t == nt - 2);
            const char* a1 = cA + (size_t)(t + 1) * kstep;
            const char* a2 = last ? nA : cA + (size_t)(t + 2) * kstep; const char* b2 = last ? nB : cB + (size_t)(t + 2) * kstep;
            const char* a3 = a2 + kstep; const char* b3 = b2 + kstep;
            if (last && has_next) S.a_ready(nxt);
            PG8_LDB(B0, 0, 0); PG8_SCHED; PG8_LDA(At, 0, 0); PG8_STAGE(PG8_SA(1, 1), a1 + hstepA, voffA);
            PG8_WAIT_L(8); PG8_BAR; PG8_WAIT_L(0); PG8_MMA(0, 0, At, B0); PG8_BAR; PG8_SCHED;
            PG8_LDB(B1, 0, 1); PG8_STAGE(PG8_SB(0, 0), b2, voffB);
            PG8_BAR; PG8_WAIT_L(0); PG8_MMA(0, 1, At, B1); PG8_BAR;
            PG8_LDA(At, 0, 1); PG8_STAGE(PG8_SA(0, 0), a2, voffA);
            PG8_BAR; PG8_WAIT_L(0); PG8_MMA(1, 0, At, B0); PG8_BAR; PG8_SCHED;
            PG8_STAGE(PG8_SB(0, 1), b2 + hstep, voffB);
            PG8_WAIT_V(6); PG8_BAR; PG8_MMA(1, 1, At, B1); PG8_BAR;
            PG8_LDB(B0, 1, 0); PG8_SCHED; PG8_LDA(At, 1, 0); PG8_STAGE(PG8_SA(0, 1), a2 + hstepA, voffA);
            PG8_WAIT_L(8); PG8_BAR; PG8_WAIT_L(0); PG8_MMA(0, 0, At, B0); PG8_BAR; PG8_SCHED;
            PG8_LDB(B1, 1, 1); PG8_STAGE(PG8_SB(1, 0), b3, voffB);
            PG8_BAR; PG8_WAIT_L(0); PG8_MMA(0, 1, At, B1); PG8_BAR;
            PG8_LDA(At, 1, 1); PG8_STAGE(PG8_SA(1, 0), a3, voffA);
            PG8_BAR; PG8_WAIT_L(0); PG8_MMA(1, 0, At, B0); PG8_BAR; PG8_SCHED;
            PG8_STAGE(PG8_SB(1, 1), b3 + hstep, voffB);
            PG8_WAIT_V(6); PG8_BAR; PG8_MMA(1, 1, At, B1); PG8_BAR;
        }
        PG8_STAMP();
        if constexpr (!Epi::AFTER_DRAIN) { E(acc, cur, wr, wc, fr, fq); S.done(cur); }
        PG8_STAMP();
        if (!has_next) break;
#pragma unroll
        for (int a = 0; a < 2; ++a)
#pragma unroll
            for (int b = 0; b < 2; ++b)
#pragma unroll
                for (int m = 0; m < 4; ++m)
#pragma unroll
                    for (int n = 0; n < 2; ++n) acc[a][b][m][n] = (f32x4){0.f, 0.f, 0.f, 0.f};
        cur = nxt; cA = nA; cB = nB; ++ui;
    }
    PG8_WAIT_V(0);
    if (wr == 0) PG8_BAR;
    PG8_BAR;
    if constexpr (Epi::AFTER_DRAIN) { E.fused(acc, cur, wr, wc, fr, fq, lds, wid, lane); S.done(cur); }
    PG8_STAMP();
    if (STAMP && wid == 0) { stamps[lane] = lane < nts ? (((unsigned long long)(unsigned)ts_hi << 32) | (unsigned)ts_lo) : 0ull;
        if (lane == 62) stamps[62] = rt_entry; if (lane == 63) stamps[63] = (unsigned long long)wall_clock64(); }
#undef PG8_STAMP
#undef PG8_SA
#undef PG8_SB
#undef PG8_STAGE
#undef PG8_LDA
#undef PG8_LDB
#undef PG8_MMA
#undef PG8_WAIT_V
#undef PG8_WAIT_L
#undef PG8_BAR
#undef PG8_SCHED
}
}

namespace mk {
using pg8::bf16_t; using pg8::bf16x8; using pg8::f32x4; using pg8::u32x4; using pg8::Unit; using pg8::cvt_pk_bf16;
typedef float f32x16 __attribute__((ext_vector_type(16)));
typedef short s16x4 __attribute__((ext_vector_type(4)));
typedef unsigned u32x2 __attribute__((ext_vector_type(2)));
#define LAS __attribute__((address_space(3)))

constexpr int NTOK = 33024, NP = 32768, DM = 1024, SEQ = 16384, DFF = 2816;
constexpr float EPS = 1e-6f;
constexpr int NPHASE = 24;
constexpr size_t OUT_RETP = 33816576, OUT_RETS = 35913728, OUT_POOLP = 52690944, OUT_POOLS = 52752384;
constexpr size_t WS_WRI = 0, WS_WRO = 12582912, WS_WPL = 16777216, WS_WFI = 18874368, WS_WFO = 30408704, WS_XB = 36175872,
                 WS_QKV = 103809024, WS_T = 374341632, WS_COS = 441450496, WS_SIN = 449839104, WS_RSS = 458227712, WS_GSS = 477249536, WS_END = 494157824;

struct Params {
    const float *x_prompt, *x_sample, *state_ret, *state_pool, *norm_mix, *w_ret_in, *w_ret_out, *w_pool, *pool_scale, *norm_ffn, *w_ffn_in, *w_ffn_out, *norm_final;
    float* out; unsigned char* ws; int ph_lo, ph_hi;
};

__device__ __forceinline__ float lg2gamma(int h) { return h == 0 ? -0.04580368961312479f : h == 1 ? -0.02272007650008353f : h == 2 ? -0.011315313227834146f : -0.005646563141142063f; }
__device__ __forceinline__ float sum16(const float* p) {
    const float4 a = *(const float4*)p, b = *(const float4*)(p + 4), c = *(const float4*)(p + 8), d = *(const float4*)(p + 12);
    return (((a.x + a.y) + (a.z + a.w)) + ((b.x + b.y) + (b.z + b.w))) + (((c.x + c.y) + (c.z + c.w)) + ((d.x + d.y) + (d.z + d.w)));
}
__device__ __forceinline__ float rs_row(const float* rssrow) { return 1.0f / sqrtf(sum16(rssrow) * (1.0f / 1024.0f) + EPS); }
__device__ __forceinline__ float silu_f(float v) { return v / (1.0f + __expf(-v)); }
__device__ __forceinline__ bf16_t f2bf(float f) { unsigned u = __float_as_uint(f); u += 0x7FFFu + ((u >> 16) & 1u); return (bf16_t)(u >> 16); }
__device__ __forceinline__ float bf2f(unsigned short b) { return __uint_as_float(((unsigned)b) << 16); }

struct EpiQKV {
    static constexpr bool PERM = true, AFTER_DRAIN = false;
    bf16_t* O; const float* rss; const float* cosT; const float* sinT;
    __device__ __forceinline__ void operator()(const f32x4 (&acc)[2][2][4][2], const Unit& u, int wr, int wc, int fr, int fq) const {
        const int row0 = u.pm * 256 + wr * 64 + fr, cin = wc * 32 + 8 * fq;
        const bool rot = u.pn < 8; const float lg = lg2gamma(u.pn & 3);
#pragma unroll
        for (int ai = 0; ai < 2; ++ai)
#pragma unroll
            for (int m = 0; m < 4; ++m) {
                const int row = row0 + ai * 128 + m * 16;
                const float r = rs_row(rss + (size_t)row * 16);
                int pos, l, Lc;
                if (row < NP) { pos = row & (SEQ - 1); l = pos & 63; Lc = 64; } else { l = (row - NP) & 15; pos = 1024 + l; Lc = 16; }
                bf16_t* rowp = O + (size_t)row * 4096 + u.pn * 256 + cin;
                f32x4 o1[2], o2[2];
                if (rot) {
                    const float e = (u.pn < 4) ? (float)(l + 1) : (float)(Lc - 1 - l);
                    const float dec = exp2f(e * lg) * r;
#pragma unroll
                    for (int n = 0; n < 2; ++n) {
                        const f32x4 c4 = *(const f32x4*)(cosT + (size_t)pos * 128 + cin + 4 * n), s4 = *(const f32x4*)(sinT + (size_t)pos * 128 + cin + 4 * n);
                        const f32x4 x1 = acc[ai][0][m][n] * dec, x2 = acc[ai][1][m][n] * dec;
                        o1[n] = x1 * c4 - x2 * s4; o2[n] = x1 * s4 + x2 * c4;
                    }
                } else {
#pragma unroll
                    for (int n = 0; n < 2; ++n) { o1[n] = acc[ai][0][m][n] * r; o2[n] = acc[ai][1][m][n] * r; }
                }
                u32x4 w; w.x = cvt_pk_bf16(o1[0][0], o1[0][1]); w.y = cvt_pk_bf16(o1[0][2], o1[0][3]); w.z = cvt_pk_bf16(o1[1][0], o1[1][1]); w.w = cvt_pk_bf16(o1[1][2], o1[1][3]);
                *(u32x4*)rowp = w;
                w.x = cvt_pk_bf16(o2[0][0], o2[0][1]); w.y = cvt_pk_bf16(o2[0][2], o2[0][3]); w.z = cvt_pk_bf16(o2[1][0], o2[1][1]); w.w = cvt_pk_bf16(o2[1][2], o2[1][3]);
                *(u32x4*)(rowp + 128) = w;
            }
    }
};
struct EpiGate {
    static constexpr bool PERM = true, AFTER_DRAIN = false;
    bf16_t* QKV; const float* rss; const float* gss;
    __device__ __forceinline__ void operator()(const f32x4 (&acc)[2][2][4][2], const Unit& u, int wr, int wc, int fr, int fq) const {
        const int row0 = u.pm * 256 + wr * 64 + fr, cin = wc * 32 + 8 * fq, head = u.pn >> 1;
#pragma unroll
        for (int ai = 0; ai < 2; ++ai)
#pragma unroll
            for (int m = 0; m < 4; ++m) {
                const int row = row0 + ai * 128 + m * 16;
                const float r = rs_row(rss + (size_t)row * 16);
                const float rn = 1.0f / sqrtf(sum16(gss + ((size_t)row * 4 + head) * 16) * (1.0f / 512.0f) + EPS);
                bf16_t* rowp = QKV + (size_t)row * 4096 + 2048 + u.pn * 256 + cin;
#pragma unroll
                for (int bj = 0; bj < 2; ++bj) {
                    const u32x4 ov = *(const u32x4*)(rowp + bj * 128);
                    float g[8], o[8];
#pragma unroll
                    for (int j = 0; j < 4; ++j) { g[j] = acc[ai][bj][m][0][j] * r; g[4 + j] = acc[ai][bj][m][1][j] * r; }
                    o[0] = __uint_as_float(ov.x << 16); o[1] = __uint_as_float(ov.x & 0xffff0000u); o[2] = __uint_as_float(ov.y << 16); o[3] = __uint_as_float(ov.y & 0xffff0000u);
                    o[4] = __uint_as_float(ov.z << 16); o[5] = __uint_as_float(ov.z & 0xffff0000u); o[6] = __uint_as_float(ov.w << 16); o[7] = __uint_as_float(ov.w & 0xffff0000u);
                    float y[8];
#pragma unroll
                    for (int j = 0; j < 8; ++j) y[j] = silu_f(g[j]) * o[j] * rn;
                    u32x4 w; w.x = cvt_pk_bf16(y[0], y[1]); w.y = cvt_pk_bf16(y[2], y[3]); w.z = cvt_pk_bf16(y[4], y[5]); w.w = cvt_pk_bf16(y[6], y[7]);
                    *(u32x4*)(rowp + bj * 128) = w;
                }
            }
    }
};
struct EpiFfn {
    static constexpr bool PERM = true, AFTER_DRAIN = false;
    bf16_t* ACT; const float* rss;
    __device__ __forceinline__ void operator()(const f32x4 (&acc)[2][2][4][2], const Unit& u, int wr, int wc, int fr, int fq) const {
        const int row0 = u.pm * 256 + wr * 64 + fr, cout = u.pn * 128 + wc * 16 + 4 * fq;
#pragma unroll
        for (int ai = 0; ai < 2; ++ai)
#pragma unroll
            for (int m = 0; m < 4; ++m) {
                const int row = row0 + ai * 128 + m * 16;
                const float r = rs_row(rss + (size_t)row * 16);
                bf16_t* rowp = ACT + (size_t)row * DFF + cout;
#pragma unroll
                for (int bj = 0; bj < 2; ++bj) {
                    const f32x4 a = acc[ai][bj][m][0] * r, b = acc[ai][bj][m][1] * r;
                    u32x2 w; w.x = cvt_pk_bf16(silu_f(a[0]) * b[0], silu_f(a[1]) * b[1]); w.y = cvt_pk_bf16(silu_f(a[2]) * b[2], silu_f(a[3]) * b[3]);
                    *(u32x2*)(rowp + bj * 64) = w;
                }
            }
    }
};
struct EpiRes {
    static constexpr bool PERM = false, AFTER_DRAIN = false;
    const float* base_p; const float* base_s; float* xres; bf16_t* xb; float* rss_next;
    __device__ __forceinline__ void operator()(const f32x4 (&acc)[2][2][4][2], const Unit& u, int wr, int wc, int fr, int fq) const {
        const int row0 = u.pm * 256 + wr * 64 + fr, col0 = u.pn * 256 + wc * 32 + 4 * fq;
#pragma unroll
        for (int ai = 0; ai < 2; ++ai)
#pragma unroll
            for (int m = 0; m < 4; ++m) {
                const int row = row0 + ai * 128 + m * 16;
                const float* bp = (row < NP) ? base_p + (size_t)row * DM : base_s + (size_t)(row - NP) * DM;
                float ss = 0.f;
#pragma unroll
                for (int bj = 0; bj < 2; ++bj)
#pragma unroll
                    for (int n = 0; n < 2; ++n) {
                        const int c = col0 + bj * 128 + n * 16;
                        const f32x4 v = *(const f32x4*)(bp + c) + acc[ai][bj][m][n];
                        *(f32x4*)(xres + (size_t)row * DM + c) = v;
                        u32x2 w; w.x = cvt_pk_bf16(v[0], v[1]); w.y = cvt_pk_bf16(v[2], v[3]);
                        *(u32x2*)(xb + (size_t)row * DM + c) = w;
                        ss += (v[0] * v[0] + v[1] * v[1]) + (v[2] * v[2] + v[3] * v[3]);
                    }
                ss += __shfl_xor(ss, 16); ss += __shfl_xor(ss, 32);
                if (fq == 0) rss_next[(size_t)row * 16 + u.pn * 4 + wc] = ss;
            }
    }
};

struct MapId { __device__ __forceinline__ float scale(int) const { return 1.f; } __device__ __forceinline__ int drow(int n) const { return n; } };
struct MapRetIn { __device__ __forceinline__ float scale(int n) const { return (n >= 1024 && n < 2048) ? 0.0625f : 1.f; } __device__ __forceinline__ int drow(int n) const { return n; } };
struct MapFfnIn { __device__ __forceinline__ float scale(int) const { return 1.f; }
    __device__ __forceinline__ int drow(int n) const { const int isb = n >= DFF, j = n - isb * DFF; return (j >> 2) * 8 + isb * 4 + (j & 3); } };
struct MapPool { const float* cs; __device__ __forceinline__ float scale(int n) const { return cs[n]; } __device__ __forceinline__ int drow(int n) const { return n; } };

template <class MapF>
__device__ __forceinline__ void conv_T(LAS unsigned char* lds, const float* src, int K, int Nsrc, int ldsrc, bf16_t* dst, int lddst, const float* gain, const MapF map) {
    const int tid = opaque_tid(), tk = K >> 6, tn = Nsrc >> 6, ntile = tk * tn;
    LAS bf16_t* tile = (LAS bf16_t*)lds;
    for (int t = blockIdx.x; t < ntile; t += gridDim.x) {
        const int k0 = (t % tk) << 6, n0 = (t / tk) << 6;
        {
            const int kk = tid >> 3, nn = (tid & 7) * 8; const float* s = src + (size_t)(k0 + kk) * ldsrc + n0 + nn;
            const float4 a = *(const float4*)s, b = *(const float4*)(s + 4); const float gk = gain ? gain[k0 + kk] : 1.f;
            tile[(nn + 0) * 72 + kk] = f2bf(a.x * gk * map.scale(n0 + nn + 0)); tile[(nn + 1) * 72 + kk] = f2bf(a.y * gk * map.scale(n0 + nn + 1));
            tile[(nn + 2) * 72 + kk] = f2bf(a.z * gk * map.scale(n0 + nn + 2)); tile[(nn + 3) * 72 + kk] = f2bf(a.w * gk * map.scale(n0 + nn + 3));
            tile[(nn + 4) * 72 + kk] = f2bf(b.x * gk * map.scale(n0 + nn + 4)); tile[(nn + 5) * 72 + kk] = f2bf(b.y * gk * map.scale(n0 + nn + 5));
            tile[(nn + 6) * 72 + kk] = f2bf(b.z * gk * map.scale(n0 + nn + 6)); tile[(nn + 7) * 72 + kk] = f2bf(b.w * gk * map.scale(n0 + nn + 7));
        }
        __syncthreads();
        {
            const int nn = tid >> 3, kc = (tid & 7) * 8;
            const u32x4 raw = *(const LAS u32x4*)(tile + nn * 72 + kc);
            *(u32x4*)(dst + (size_t)map.drow(n0 + nn) * lddst + k0 + kc) = raw;
        }
        __syncthreads();
    }
}
__device__ __forceinline__ void convert_ret(const Params& p, LAS unsigned char* lds, int j) {
    conv_T(lds, p.w_ret_in + (size_t)j * 1024 * 6144, 1024, 6144, 6144, (bf16_t*)(p.ws + WS_WRI), 1024, p.norm_mix + (size_t)(2 * j) * DM, MapRetIn{});
    conv_T(lds, p.w_ret_out + (size_t)j * 2048 * 1024, 2048, 1024, 1024, (bf16_t*)(p.ws + WS_WRO), 2048, nullptr, MapId{});
}
__device__ __forceinline__ void convert_pool(const Params& p, LAS unsigned char* lds, int j) {
    bf16_t* W = (bf16_t*)(p.ws + WS_WPL);
    for (size_t i = (size_t)blockIdx.x * blockDim.x + opaque_tid(); i < (size_t)1024 * 128; i += (size_t)gridDim.x * blockDim.x) {
        const int n = (int)(i >> 7), k = (int)(i & 127) * 8;
        if ((n >> 8) != (k >> 8)) *(u32x4*)(W + (size_t)n * 1024 + k) = (u32x4){0u, 0u, 0u, 0u};
    }
    for (int g = 0; g < 4; ++g)
        conv_T(lds, p.w_pool + ((size_t)j * 4 + g) * 65536, 256, 256, 256, W + (size_t)(g * 256) * 1024 + g * 256, 1024, nullptr, MapPool{p.pool_scale + (size_t)j * DM + g * 256});
}
__device__ __forceinline__ void convert_ffn(const Params& p, LAS unsigned char* lds, int i) {
    conv_T(lds, p.w_ffn_in + (size_t)i * 1024 * 5632, 1024, 5632, 5632, (bf16_t*)(p.ws + WS_WFI), 1024, p.norm_ffn + (size_t)i * DM, MapFfnIn{});
    conv_T(lds, p.w_ffn_out + (size_t)i * DFF * 1024, DFF, 1024, 1024, (bf16_t*)(p.ws + WS_WFO), DFF, nullptr, MapId{});
}
__device__ __forceinline__ void convert_mixer(const Params& p, LAS unsigned char* lds, int layer) { if (layer & 1) convert_pool(p, lds, layer >> 1); else convert_ret(p, lds, layer >> 1); }

__device__ __forceinline__ void phase0(const Params& p, LAS unsigned char* lds) {
    const int tid = opaque_tid(), lane = tid & 63, wid = tid >> 6;
    bf16_t* xb = (bf16_t*)(p.ws + WS_XB); float* rss = (float*)(p.ws + WS_RSS);
    for (int row = blockIdx.x * 8 + wid; row < NTOK; row += gridDim.x * 8) {
        const float* src = (row < NP) ? p.x_prompt + (size_t)row * DM : p.x_sample + (size_t)(row - NP) * DM;
        float ss = 0.f;
#pragma unroll
        for (int i = 0; i < 4; ++i) {
            const float4 v = *(const float4*)(src + i * 256 + lane * 4);
            ss += (v.x * v.x + v.y * v.y) + (v.z * v.z + v.w * v.w);
            u32x2 w; w.x = cvt_pk_bf16(v.x, v.y); w.y = cvt_pk_bf16(v.z, v.w);
            *(u32x2*)(xb + (size_t)row * DM + i * 256 + lane * 4) = w;
        }
#pragma unroll
        for (int o = 32; o >= 1; o >>= 1) ss += __shfl_xor(ss, o);
        if (lane < 16) rss[(size_t)row * 16 + lane] = (lane == 0) ? ss : 0.f;
    }
    const size_t gt = (size_t)blockIdx.x * blockDim.x + tid, nth = (size_t)gridDim.x * blockDim.x;
    float* cosT = (float*)(p.ws + WS_COS); float* sinT = (float*)(p.ws + WS_SIN);
    for (size_t i = gt; i < (size_t)SEQ * 128; i += nth) {
        const int pos = (int)(i >> 7), j = (int)(i & 127);
        const double inv = exp2(-(double)j * 0.10381025296523007), t = (double)pos * inv * 0.31830988618379067154;
        double s, c; sincospi(t, &s, &c);
        cosT[i] = (float)c; sinT[i] = (float)s;
    }
    convert_mixer(p, lds, 0); convert_mixer(p, lds, 1); convert_ffn(p, lds, 0);
}

__device__ __forceinline__ float2 pool_h(const float* xres, const float* rssc, const float* sp, int rowbase, int t, int c0, float g0, float g1, bool isS) {
    if (t >= 0) { const int row = rowbase + t; const float r = rs_row(rssc + (size_t)row * 16); const float2 x = *(const float2*)(xres + (size_t)row * DM + c0); return make_float2(x.x * r * g0, x.y * r * g1); }
    if (isS) return *(const float2*)(sp + (size_t)(15 + t) * DM + c0);
    return make_float2(0.f, 0.f);
}
__device__ __forceinline__ void phase_pool_prep(const Params& p, int layer) {
    const int j = layer >> 1, tid = opaque_tid(), c0 = tid * 2, gi = c0 >> 8, w = 2 << gi;
    const float* xres = p.out; const float* rssc = (const float*)(p.ws + WS_RSS) + (size_t)(2 * layer) * NTOK * 16;
    const float g0 = p.norm_mix[(size_t)layer * DM + c0], g1 = p.norm_mix[(size_t)layer * DM + c0 + 1];
    bf16_t* dbuf = (bf16_t*)(p.ws + WS_QKV);
    for (int u = blockIdx.x; u < 272; u += gridDim.x) {
        int t0, nT, rowbase; bool isS; const float* sp = nullptr; float* po;
        if (u < 256) { const int b = u >> 7; t0 = (u & 127) * 128; nT = 128; rowbase = b * SEQ; isS = false; po = p.out + OUT_POOLP + ((size_t)(j * 2 + b) * 15) * DM; }
        else { const int sb = u - 256; t0 = 0; nT = 16; rowbase = NP + sb * 16; isS = true; sp = p.state_pool + ((size_t)(j * 16 + sb) * 15) * DM; po = p.out + OUT_POOLS + ((size_t)(j * 16 + sb) * 15) * DM; }
        float2 ws = make_float2(0.f, 0.f);
        for (int i = 1; i < w; ++i) { const float2 h = pool_h(xres, rssc, sp, rowbase, t0 - i, c0, g0, g1, isS); ws.x += h.x; ws.y += h.y; }
        for (int t = t0; t < t0 + nT; ++t) {
            const float2 h = pool_h(xres, rssc, sp, rowbase, t, c0, g0, g1, isS);
            ws.x += h.x; ws.y += h.y;
            const float cnt = isS ? (float)w : (float)min(t + 1, w);
            const float inv = 1.0f / cnt;
            *(unsigned*)(dbuf + (size_t)(rowbase + t) * DM + c0) = cvt_pk_bf16(ws.x * inv - h.x, ws.y * inv - h.y);
            const int pi = isS ? t - 1 : t - (SEQ - 15);
            if (pi >= 0) *(float2*)(po + (size_t)pi * DM + c0) = h;
            const float2 ho = pool_h(xres, rssc, sp, rowbase, t - w + 1, c0, g0, g1, isS);
            ws.x -= ho.x; ws.y -= ho.y;
        }
    }
}

__device__ __forceinline__ void phase_final(const Params& p) {
    const float* rssc = (const float*)(p.ws + WS_RSS) + (size_t)8 * NTOK * 16;
    for (size_t i = (size_t)blockIdx.x * blockDim.x + opaque_tid(); i < (size_t)NTOK * 256; i += (size_t)gridDim.x * blockDim.x) {
        const int row = (int)(i >> 8), c = (int)(i & 255) * 4;
        const float r = rs_row(rssc + (size_t)row * 16);
        const float4 g = *(const float4*)(p.norm_final + c);
        float4 v = *(const float4*)(p.out + (size_t)row * DM + c);
        v.x *= r * g.x; v.y *= r * g.y; v.z *= r * g.z; v.w *= r * g.w;
        *(float4*)(p.out + (size_t)row * DM + c) = v;
    }
}

__device__ __forceinline__ unsigned offb(unsigned row, unsigned ch) { return 256u * row + 16u * (ch ^ (((row & 3u) << 2) | ((row >> 2) & 3u))); }
__device__ __forceinline__ unsigned img_off(unsigned row, unsigned ch32) { return (ch32 >> 4) * 16384u + offb(row, ch32 & 15u); }
constexpr unsigned IMG_Q = 0, IMG_K = 32768, IMG_V = 65536, IMG_P = 98304;

__device__ __forceinline__ void tile_load(u32x4 (&r)[4], const bf16_t* g, int ld, int nvalid, int tid_) {
    int tid = tid_; asm volatile("" : "+v"(tid));
    const int r0 = (tid >> 5) & 15, ch = tid & 31;
    const bf16_t* gp = g + (size_t)r0 * ld + ch * 8;
    if (nvalid >= 64) {
#pragma unroll
        for (int i = 0; i < 4; ++i) r[i] = *(const u32x4*)(gp + (size_t)(16 * i) * ld);
    } else {
        r[0] = *(const u32x4*)gp;
#pragma unroll
        for (int i = 1; i < 4; ++i) r[i] = (u32x4){0u, 0u, 0u, 0u};
    }
}
__device__ __forceinline__ void tile_store(LAS unsigned char* img, const u32x4 (&r)[4], int tid_) {
    int tid = tid_; asm volatile("" : "+v"(tid));
    const unsigned r0 = (tid >> 5) & 15, ch = tid & 31;
    LAS unsigned char* bp = img + img_off(r0, ch);
#pragma unroll
    for (int i = 0; i < 4; ++i) *(LAS u32x4*)(bp + 4096 * i) = r[i];
}
__device__ __forceinline__ bf16x8 tr_frag(LAS unsigned char* img, int lane, int cblk  , int ks) {
    const unsigned h = lane >> 5, blk = (lane >> 4) & 1, q = (lane & 15) >> 2, pp = lane & 3;
    const unsigned c = cblk & 3;
    const unsigned lowc = 2 * blk + (pp >> 1);
    const unsigned chx0 = ((c ^ q) << 2) | (lowc ^ (2 * h)), chx1 = chx0 ^ 1u;
    const unsigned rb = 256u * (8 * h + q) + 8 * (pp & 1);
    const unsigned a0 = rb + 16u * chx0, a1 = rb + 1024u + 16u * chx1;
    LAS unsigned char* base = img + (cblk >> 2) * 16384 + ks * 4096;
    const s16x4 lo = __builtin_amdgcn_ds_read_tr16_b64_v4i16((LAS s16x4*)(base + a0));
    const s16x4 hi = __builtin_amdgcn_ds_read_tr16_b64_v4i16((LAS s16x4*)(base + a1));
    return __builtin_shufflevector(lo, hi, 0, 1, 2, 3, 4, 5, 6, 7);
}
__device__ __forceinline__ bf16x8 pack8(const f32x16& s, int base) {
    u32x4 w; w.x = cvt_pk_bf16(s[base + 0], s[base + 1]); w.y = cvt_pk_bf16(s[base + 2], s[base + 3]); w.z = cvt_pk_bf16(s[base + 4], s[base + 5]); w.w = cvt_pk_bf16(s[base + 6], s[base + 7]);
    return __builtin_bit_cast(bf16x8, w);
}

__device__ __forceinline__ void state_update(f32x16 (&S)[8], LAS unsigned char* lds, const bf16x8 (&Vf)[4], int lane) {
#pragma unroll
    for (int dt = 0; dt < 8; ++dt)
#pragma unroll
        for (int ks = 0; ks < 4; ++ks) {
            const bf16x8 a = tr_frag(lds + IMG_K, lane, dt, ks);
            S[dt] = __builtin_amdgcn_mfma_f32_32x32x16_bf16(a, Vf[ks], S[dt], 0, 0, 0);
        }
}

__device__ __forceinline__ void phase_scan_local(const Params& p, LAS unsigned char* lds) {
    const int tid = opaque_tid(), lane_ = tid & 63, wid = __builtin_amdgcn_readfirstlane(tid >> 6);
    const bf16_t* qkv = (const bf16_t*)(p.ws + WS_QKV); float* T = (float*)(p.ws + WS_T);
    for (int u = blockIdx.x; u < 256; u += gridDim.x) {
        const int eh = u & 1, seg = (u >> 1) & 15, h = (u >> 5) & 3, b = u >> 7;
        const size_t row0 = (size_t)b * SEQ + (size_t)seg * 1024;
        const bf16_t* kb = qkv + row0 * 4096 + 1024 + h * 256; const bf16_t* vb = qkv + row0 * 4096 + 2048 + h * 512 + eh * 256;
        const float gC = exp2f(64.f * lg2gamma(h));
        f32x16 S[8];
#pragma unroll
        for (int i = 0; i < 8; ++i)
#pragma unroll
            for (int r = 0; r < 16; ++r) S[i][r] = 0.f;
        u32x4 rk[4], rv[4];
        tile_load(rk, kb, 4096, 64, tid); tile_load(rv, vb, 4096, 64, tid);
        __syncthreads();
        tile_store(lds + IMG_K, rk, tid); tile_store(lds + IMG_V, rv, tid);
        __syncthreads();
        for (int c = 0; c < 16; ++c) {
            int lane = lane_; asm volatile("" : "+v"(lane));
            if (c + 1 < 16) { tile_load(rk, kb + (size_t)(c + 1) * 64 * 4096, 4096, 64, tid); tile_load(rv, vb + (size_t)(c + 1) * 64 * 4096, 4096, 64, tid); }
#pragma unroll
            for (int i = 0; i < 8; ++i) S[i] *= gC;
            bf16x8 Vf[4];
#pragma unroll
            for (int ks = 0; ks < 4; ++ks) Vf[ks] = tr_frag(lds + IMG_V, lane, wid, ks);
            state_update(S, lds, Vf, lane);
            __syncthreads();
            if (c + 1 < 16) { tile_store(lds + IMG_K, rk, tid); tile_store(lds + IMG_V, rv, tid); }
            __syncthreads();
        }
        float* Tu = T + (size_t)u * 65536;
        int lz = lane_; asm volatile("" : "+v"(lz));
        const int hl = lz >> 5, e = wid * 32 + (lz & 31);
#pragma unroll
        for (int dt = 0; dt < 8; ++dt)
#pragma unroll
            for (int r = 0; r < 16; ++r) Tu[(size_t)(32 * dt + (r & 3) + 8 * (r >> 2) + 4 * hl) * 256 + e] = S[dt][r];
    }
}

__device__ __forceinline__ void phase_scan(const Params& p, LAS unsigned char* lds, int jl) {
    const int tid = opaque_tid(), lane_ = tid & 63, wid = __builtin_amdgcn_readfirstlane(tid >> 6);
    bf16_t* qkv = (bf16_t*)(p.ws + WS_QKV); const float* T = (const float*)(p.ws + WS_T);
    float* gss = (float*)(p.ws + WS_GSS) + (size_t)jl * NTOK * 64;
    for (int v = blockIdx.x; v < 384; v += gridDim.x) {
        int eh, h, Lc, nch; size_t row0; float* Sout = nullptr;
        f32x16 S[8];
        if (v < 256) {
            eh = v & 1; const int seg = (v >> 1) & 15; h = (v >> 5) & 3; const int b = v >> 7;
            row0 = (size_t)b * SEQ + (size_t)seg * 1024; Lc = 64; nch = 16;
            if (seg == 15) Sout = p.out + OUT_RETP + ((size_t)((jl * 2 + b) * 4 + h) * 256) * 512 + eh * 256;
#pragma unroll
            for (int i = 0; i < 8; ++i)
#pragma unroll
                for (int r = 0; r < 16; ++r) S[i][r] = 0.f;
            const float gS = exp2f(1024.f * lg2gamma(h));
            for (int j = 0; j < seg; ++j) {
                int lz = lane_; asm volatile("" : "+v"(lz)); const int hl_ = lz >> 5, ecol_ = wid * 32 + (lz & 31);
                const float* Tu = T + (size_t)(v - 2 * (seg - j)) * 65536;
#pragma unroll
                for (int dt = 0; dt < 8; ++dt)
#pragma unroll
                    for (int r = 0; r < 16; ++r) S[dt][r] = S[dt][r] * gS + Tu[(size_t)(32 * dt + (r & 3) + 8 * (r >> 2) + 4 * hl_) * 256 + ecol_];
            }
        } else {
            const int su = v - 256; eh = su & 1; h = (su >> 1) & 3; const int sb = su >> 3;
            row0 = (size_t)NP + (size_t)sb * 16; Lc = 16; nch = 1;
            Sout = p.out + OUT_RETS + ((size_t)((jl * 16 + sb) * 4 + h) * 256) * 512 + eh * 256;
            int lz = lane_; asm volatile("" : "+v"(lz)); const int hl_ = lz >> 5, ecol_ = wid * 32 + (lz & 31);
            const float* Sin = p.state_ret + ((size_t)((jl * 16 + sb) * 4 + h) * 256) * 512 + eh * 256;
#pragma unroll
            for (int dt = 0; dt < 8; ++dt)
#pragma unroll
                for (int r = 0; r < 16; ++r) S[dt][r] = Sin[(size_t)(32 * dt + (r & 3) + 8 * (r >> 2) + 4 * hl_) * 512 + ecol_];
        }
        const float lg = lg2gamma(h), gC = exp2f((float)Lc * lg), gCinv = exp2f(-(float)Lc * lg);
        bf16_t* qb = qkv + row0 * 4096 + h * 256; bf16_t* kb = qkv + row0 * 4096 + 1024 + h * 256; bf16_t* vb = qkv + row0 * 4096 + 2048 + h * 512 + eh * 256;
        u32x4 rq[4], rk[4], rv[4];
        tile_load(rq, qb, 4096, Lc, tid); tile_load(rk, kb, 4096, Lc, tid); tile_load(rv, vb, 4096, Lc, tid);
        __syncthreads();
        tile_store(lds + IMG_Q, rq, tid); tile_store(lds + IMG_K, rk, tid); tile_store(lds + IMG_V, rv, tid);
        __syncthreads();
        for (int c = 0; c < nch; ++c) {
            int lane = lane_; asm volatile("" : "+v"(lane)); const int hl = lane >> 5, ecol = wid * 32 + (lane & 31);
            {
                const int mi = wid >> 1, nj0 = 2 * (wid & 1), l15 = lane & 15, l4 = lane >> 4;
                f32x4 sc[2] = {(f32x4){0.f, 0.f, 0.f, 0.f}, (f32x4){0.f, 0.f, 0.f, 0.f}};
#pragma unroll
                for (int s = 0; s < 8; ++s) {
                    const bf16x8 a = *(const LAS bf16x8*)(lds + IMG_K + img_off(16 * mi + l15, 4 * s + l4));
#pragma unroll
                    for (int t = 0; t < 2; ++t) {
                        const bf16x8 bq = *(const LAS bf16x8*)(lds + IMG_Q + img_off(16 * (nj0 + t) + l15, 4 * s + l4));
                        sc[t] = __builtin_amdgcn_mfma_f32_16x16x32_bf16(a, bq, sc[t], 0, 0, 0);
                    }
                }
#pragma unroll
                for (int t = 0; t < 2; ++t) {
                    const int n = 16 * (nj0 + t) + l15, m0 = 16 * mi + 4 * l4;
                    float pv[4];
#pragma unroll
                    for (int r = 0; r < 4; ++r) pv[r] = (n >= m0 + r) ? sc[t][r] * gCinv : 0.f;
                    u32x2 w; w.x = cvt_pk_bf16(pv[0], pv[1]); w.y = cvt_pk_bf16(pv[2], pv[3]);
                    *(LAS u32x2*)(lds + IMG_P + n * 144 + m0 * 2) = w;
                }
            }
            __syncthreads();
            f32x16 o[2];
#pragma unroll
            for (int nt = 0; nt < 2; ++nt)
#pragma unroll
                for (int r = 0; r < 16; ++r) o[nt][r] = 0.f;
#pragma unroll
            for (int s = 0; s < 16; ++s) {
                const bf16x8 bs = pack8(S[s >> 1], 8 * (s & 1));
#pragma unroll
                for (int nt = 0; nt < 2; ++nt) {
                    const unsigned rown = 32 * nt + (lane & 31);
                    const u32x2 lo = *(const LAS u32x2*)(lds + IMG_Q + img_off(rown, 2 * s) + 8 * hl);
                    const u32x2 hi = *(const LAS u32x2*)(lds + IMG_Q + img_off(rown, 2 * s + 1) + 8 * hl);
                    const u32x4 aw = (u32x4){lo.x, lo.y, hi.x, hi.y};
                    o[nt] = __builtin_amdgcn_mfma_f32_32x32x16_bf16(__builtin_bit_cast(bf16x8, aw), bs, o[nt], 0, 0, 0);
                }
            }
            bf16x8 Vf[4];
#pragma unroll
            for (int ks = 0; ks < 4; ++ks) Vf[ks] = tr_frag(lds + IMG_V, lane, wid, ks);
#pragma unroll
            for (int ks = 0; ks < 4; ++ks)
#pragma unroll
                for (int nt = 0; nt < 2; ++nt) {
                    const bf16x8 a = *(const LAS bf16x8*)(lds + IMG_P + (32 * nt + (lane & 31)) * 144 + (16 * ks + 8 * hl) * 2);
                    o[nt] = __builtin_amdgcn_mfma_f32_32x32x16_bf16(a, Vf[ks], o[nt], 0, 0, 0);
                }
            {
                bf16_t* ob = vb + (size_t)c * 64 * 4096 + ecol + (size_t)(4 * hl) * 4096;
                float sq[32];
                if (Lc == 64) {
#pragma unroll
                    for (int nt = 0; nt < 2; ++nt)
#pragma unroll
                        for (int r = 0; r < 16; ++r) ob[(size_t)(32 * nt + (r & 3) + 8 * (r >> 2)) * 4096] = f2bf(o[nt][r]);
                } else {
#pragma unroll
                    for (int r = 0; r < 8; ++r) ob[(size_t)((r & 3) + 8 * (r >> 2)) * 4096] = f2bf(o[0][r]);
                }
#pragma unroll
                for (int nt = 0; nt < 2; ++nt)
#pragma unroll
                    for (int r = 0; r < 16; ++r) sq[nt * 16 + r] = o[nt][r] * o[nt][r];
                float s16[16], s8[8], s4[4], s2[2], s1;
                { const bool bit = (lane & 16) != 0;
#pragma unroll
                  for (int i = 0; i < 16; ++i) { const float keep = bit ? sq[i + 16] : sq[i], send = bit ? sq[i] : sq[i + 16]; s16[i] = keep + __shfl_xor(send, 16); } }
                { const bool bit = (lane & 8) != 0;
#pragma unroll
                  for (int i = 0; i < 8; ++i) { const float keep = bit ? s16[i + 8] : s16[i], send = bit ? s16[i] : s16[i + 8]; s8[i] = keep + __shfl_xor(send, 8); } }
                { const bool bit = (lane & 4) != 0;
#pragma unroll
                  for (int i = 0; i < 4; ++i) { const float keep = bit ? s8[i + 4] : s8[i], send = bit ? s8[i] : s8[i + 4]; s4[i] = keep + __shfl_xor(send, 4); } }
                { const bool bit = (lane & 2) != 0;
#pragma unroll
                  for (int i = 0; i < 2; ++i) { const float keep = bit ? s4[i + 2] : s4[i], send = bit ? s4[i] : s4[i + 2]; s2[i] = keep + __shfl_xor(send, 2); } }
                { const bool bit = (lane & 1) != 0; const float keep = bit ? s2[1] : s2[0], send = bit ? s2[0] : s2[1]; s1 = keep + __shfl_xor(send, 1); }
                const int L = lane & 31, n = 32 * (L >> 4) + (L & 3) + 8 * ((L & 15) >> 2) + 4 * hl;
                if (n < Lc) gss[((row0 + (size_t)c * 64 + n) * 4 + h) * 16 + eh * 8 + wid] = s1;
            }
            if (c + 1 < nch) { tile_load(rk, kb + (size_t)(c + 1) * 64 * 4096, 4096, 64, tid); tile_load(rv, vb + (size_t)(c + 1) * 64 * 4096, 4096, 64, tid); }
#pragma unroll
            for (int i = 0; i < 8; ++i) S[i] *= gC;
            {
                int lane2 = lane_; asm volatile("" : "+v"(lane2));
                bf16x8 Vg[4];
#pragma unroll
                for (int ks = 0; ks < 4; ++ks) Vg[ks] = tr_frag(lds + IMG_V, lane2, wid, ks);
                state_update(S, lds, Vg, lane2);
            }
            __builtin_amdgcn_sched_barrier(0);
            __syncthreads();
            if (c + 1 < nch) { tile_load(rq, qb + (size_t)(c + 1) * 64 * 4096, 4096, 64, tid); tile_store(lds + IMG_K, rk, tid); tile_store(lds + IMG_V, rv, tid); tile_store(lds + IMG_Q, rq, tid); }
            __syncthreads();
        }
        if (Sout) {
            int lz = lane_; asm volatile("" : "+v"(lz)); const int hl_ = lz >> 5, ecol_ = wid * 32 + (lz & 31);
#pragma unroll
            for (int dt = 0; dt < 8; ++dt)
#pragma unroll
                for (int r = 0; r < 16; ++r) Sout[(size_t)(32 * dt + (r & 3) + 8 * (r >> 2) + 4 * hl_) * 512 + ecol_] = S[dt][r];
        }
    }
}

template <class Epi>
__device__ __forceinline__ void run_gemm(LAS unsigned char* lds, const bf16_t* A, const bf16_t* Bt, int N, int K, const Epi& E) {
    pg8::Gemm g{A, Bt, NTOK, N, K}; pg8::StaticOrder S; S.init(NTOK, N, (int)gridDim.x, (int)blockIdx.x);
    pg8::gemm_phase<Epi, pg8::StaticOrder, false>(lds, g, S, E, nullptr);
}

__device__ __forceinline__ void run_phase(const Params& p, LAS unsigned char* lds, int ph) {
    bf16_t* xb = (bf16_t*)(p.ws + WS_XB); bf16_t* qkv = (bf16_t*)(p.ws + WS_QKV); float* rss = (float*)(p.ws + WS_RSS); float* gss = (float*)(p.ws + WS_GSS);
    const bf16_t* Wri = (const bf16_t*)(p.ws + WS_WRI); const bf16_t* Wro = (const bf16_t*)(p.ws + WS_WRO); const bf16_t* Wpl = (const bf16_t*)(p.ws + WS_WPL);
    const bf16_t* Wfi = (const bf16_t*)(p.ws + WS_WFI); const bf16_t* Wfo = (const bf16_t*)(p.ws + WS_WFO);
    float* xres = p.out;
    if (ph == 23) { phase_final(p); return; }
    int layer, step;
    if (ph < 8) { layer = 0; step = ph - 1; } else if (ph < 12) { layer = 1; step = ph - 8; } else if (ph < 19) { layer = 2; step = ph - 12; } else { layer = 3; step = ph - 19; }
    const int jl = layer >> 1;
    const bool is_ret = (layer & 1) == 0;
    const int fstep = is_ret ? step - 5 : step - 2;
    if (step == 0 && layer >= 1) { convert_ffn(p, lds, layer); if (layer + 1 < 4) convert_mixer(p, lds, layer + 1); __syncthreads(); }
    if (fstep == 0) { EpiFfn E{qkv, rss + (size_t)(2 * layer + 1) * NTOK * 16}; run_gemm(lds, xb, Wfi, 5632, 1024, E); return; }
    if (fstep == 1) { EpiRes E{xres, xres + (size_t)NP * DM, xres, xb, rss + (size_t)(2 * layer + 2) * NTOK * 16}; run_gemm(lds, qkv, Wfo, 1024, DFF, E); return; }
    if (is_ret) {
        if (step == 0) { EpiQKV E{qkv, rss + (size_t)(2 * layer) * NTOK * 16, (const float*)(p.ws + WS_COS), (const float*)(p.ws + WS_SIN)}; run_gemm(lds, xb, Wri, 4096, 1024, E); }
        else if (step == 1) phase_scan_local(p, lds);
        else if (step == 2) phase_scan(p, lds, jl);
        else if (step == 3) { EpiGate E{qkv, rss + (size_t)(2 * layer) * NTOK * 16, gss + (size_t)jl * NTOK * 64}; run_gemm(lds, xb, Wri + (size_t)4096 * 1024, 2048, 1024, E); }
        else if (step == 4) {
            const float* bp = layer == 0 ? p.x_prompt : xres; const float* bs = layer == 0 ? p.x_sample : xres + (size_t)NP * DM;
            EpiRes E{bp, bs, xres, xb, rss + (size_t)(2 * layer + 1) * NTOK * 16};
            pg8::Gemm g{qkv + 2048, Wro, NTOK, 1024, 2048}; pg8::StaticOrder S; S.init(NTOK, 1024, (int)gridDim.x, (int)blockIdx.x);
            pg8::gemm_phase<EpiRes, pg8::StaticOrder, false>(lds, g, S, E, nullptr, 4096);
        }
    } else {
        if (step == 0) phase_pool_prep(p, layer);
        else if (step == 1) { EpiRes E{xres, xres + (size_t)NP * DM, xres, xb, rss + (size_t)(2 * layer + 1) * NTOK * 16}; run_gemm(lds, qkv, Wpl, 1024, 1024, E); }
    }
}

__global__ void __launch_bounds__(512) mega(Params p) {
    extern __shared__ __attribute__((aligned(16))) unsigned char lds_raw[];
    LAS unsigned char* lds = (LAS unsigned char*)lds_raw;
    int ph = p.ph_lo;
    if (ph == 0) { phase0(p, lds); ++ph; if (ph < p.ph_hi) cg::this_grid().sync(); }
    for (; ph < p.ph_hi; ++ph) {
        run_phase(p, lds, ph);
        if (ph + 1 < p.ph_hi) { cg::this_grid().sync(); }
    }
}
}

#ifndef MK_SINGLE
#define MK_SINGLE 0
#endif
extern "C" void kernel_launch(void* const* d_in, const int* in_sizes, int n_in, void* d_out, int out_size, void* d_ws, size_t ws_size, hipStream_t stream) {
    static int grid = 0;
    constexpr int LDS_BYTES = 131072;
    if (grid == 0) {
        int dev = 0, cus = 0, per_cu = 0;
        hipGetDevice(&dev); hipDeviceGetAttribute(&cus, hipDeviceAttributeMultiprocessorCount, dev);
        if (hipFuncSetAttribute((const void*)mk::mega, hipFuncAttributeMaxDynamicSharedMemorySize, LDS_BYTES) != hipSuccess) { fprintf(stderr, "hipFuncSetAttribute failed\n"); }
        if (hipOccupancyMaxActiveBlocksPerMultiprocessor(&per_cu, (const void*)mk::mega, 512, LDS_BYTES) != hipSuccess || per_cu < 1) { fprintf(stderr, "occupancy query: %d\n", per_cu); per_cu = 1; }
        (void)hipGetLastError();
        grid = cus * 1;
        if (grid <= 0) grid = 256;
    }
    if (ws_size < mk::WS_END) { fprintf(stderr, "workspace too small: %zu < %zu\n", ws_size, (size_t)mk::WS_END); return; }
    mk::Params p{};
    p.x_prompt = (const float*)d_in[0]; p.x_sample = (const float*)d_in[1]; p.state_ret = (const float*)d_in[2]; p.state_pool = (const float*)d_in[3];
    p.norm_mix = (const float*)d_in[4]; p.w_ret_in = (const float*)d_in[5]; p.w_ret_out = (const float*)d_in[6]; p.w_pool = (const float*)d_in[7];
    p.pool_scale = (const float*)d_in[8]; p.norm_ffn = (const float*)d_in[9]; p.w_ffn_in = (const float*)d_in[10]; p.w_ffn_out = (const float*)d_in[11]; p.norm_final = (const float*)d_in[12];
    p.out = (float*)d_out; p.ws = (unsigned char*)d_ws;
#if MK_SINGLE
    p.ph_lo = 0; p.ph_hi = mk::NPHASE;
    void* args[] = {&p};
    hipError_t e = hipLaunchCooperativeKernel((const void*)mk::mega, dim3(grid), dim3(512), args, LDS_BYTES, stream);
    if (e != hipSuccess) fprintf(stderr, "cooperative launch failed: %s (grid %d)\n", hipGetErrorString(e), grid);
#else
#ifndef MK_STOP
#define MK_STOP 23
#endif
    if (MK_STOP < 23) hipMemsetAsync((float*)d_out + mk::OUT_RETP, 0, (size_t)(53243904 - mk::OUT_RETP) * 4, stream);
    for (int ph = 0; ph < mk::NPHASE; ++ph) {
        if (ph >= MK_STOP && ph != 23) continue;
        p.ph_lo = ph; p.ph_hi = ph + 1;
        hipLaunchKernelGGL(mk::mega, dim3(grid), dim3(512), LDS_BYTES, stream, p);
    }
#endif
}
```

```cpp
#include <hip/hip_runtime.h>
#include <hip/hip_cooperative_groups.h>
#include <cstdio>
namespace cg = cooperative_groups;
#define LDS_BARRIER() asm volatile("s_waitcnt lgkmcnt(0)\n\ts_barrier" ::: "memory")
__device__ __forceinline__ int opaque_tid() { int t = (int)threadIdx.x; asm volatile("" : "+v"(t)); return t; }
namespace pg8 {
#define PG8_LAS __attribute__((address_space(3)))
typedef unsigned short bf16_t;
typedef short bf16x8 __attribute__((ext_vector_type(8)));
typedef float f32x4 __attribute__((ext_vector_type(4)));
typedef unsigned u32x4 __attribute__((ext_vector_type(4)));
constexpr int BM = 256, BK = 64, HALF = 128, HTB = HALF * BK * 2  , STAGE_BYTES = 8 * HTB, NXCD = 8, WGM = 8;

__host__ __device__ __forceinline__ int lds_byte(int r, int c) { const int st = (r >> 4) * 2 + (c >> 5), rr = r & 15, cc = c & 31, ob = rr * 64 + cc * 2; return st * 1024 + (ob ^ (((ob >> 9) & 1) << 5)); }
__host__ __device__ __forceinline__ void stage_rc(int b, int& R, int& C) { const int st = b / 1024, sb = b % 1024, swz = sb ^ (((sb >> 9) & 1) << 5); R = (st >> 1) * 16 + swz / 64; C = (st & 1) * 32 + (swz % 64) / 2; }
__host__ __device__ __forceinline__ int perm32(int rho) { const int n = rho >> 4, i = rho & 15; return 8 * (i >> 2) + 4 * n + (i & 3); }

struct Unit { int pm, pn, kofs; };
struct Gemm { const bf16_t* A; const bf16_t* Bt; int M, N, K, lda, ldb; };

struct StaticOrder {
    int nM, nN, nwg, G, c;
    __host__ __device__ void init(int M, int N, int G_, int c_) { nM = M / BM; nN = N / BM; nwg = nM * nN; G = G_; c = c_; }
    __host__ __device__ bool next(int i, Unit& u) const {
        const long L = (long)i * G + c; if (L >= nwg) return false;
        int wgid = (int)L; { const int q = nwg / NXCD, r = nwg % NXCD, xcd = wgid % NXCD, off = wgid / NXCD; wgid = (xcd < r ? xcd * (q + 1) : r * (q + 1) + (xcd - r) * q) + off; }
        const int nig = WGM * nN, gid = wgid / nig, fm = gid * WGM, gsz = (nM - fm) < WGM ? (nM - fm) : WGM;
        u.pm = fm + ((wgid % nig) % gsz); u.pn = (wgid % nig) / gsz; u.kofs = 0; return true;
    }
    __device__ __forceinline__ void a_ready(const Unit&) const {}
    __device__ __forceinline__ void done(const Unit&) const {}
};
struct CountedOrder : StaticOrder {
    const unsigned* ready; unsigned need; unsigned* tmo;
    __device__ __forceinline__ void a_ready(const Unit& u) const {
        if (threadIdx.x < 64) {
            const unsigned long long t0 = __builtin_amdgcn_s_memrealtime(); unsigned polls = 0;
            while ((unsigned)__builtin_amdgcn_readfirstlane(__hip_atomic_load(ready + 64 * u.pm, __ATOMIC_RELAXED, __HIP_MEMORY_SCOPE_AGENT)) < need) {
                if ((++polls & 255u) == 0u && __builtin_amdgcn_readfirstlane(__hip_atomic_load(tmo, __ATOMIC_RELAXED, __HIP_MEMORY_SCOPE_AGENT)) != 0u) break;
                if (__builtin_amdgcn_s_memrealtime() - t0 > 2000000ull) {
                    if (threadIdx.x == 0) { unsigned expect = 0u; __hip_atomic_compare_exchange_strong(tmo + 1, &expect, 0x600u | (unsigned)(u.pm & 0xff), __ATOMIC_RELAXED, __ATOMIC_RELAXED, __HIP_MEMORY_SCOPE_AGENT); __hip_atomic_store(tmo, 1u, __ATOMIC_RELAXED, __HIP_MEMORY_SCOPE_AGENT); }
                    break; }
                __builtin_amdgcn_s_sleep(2); }
            __builtin_amdgcn_fence(__ATOMIC_ACQUIRE, "agent");
            asm volatile("s_waitcnt vmcnt(0)" ::: "memory");
        }
#if !defined(BROKEN_HOOK_NO_BARRIER)
        asm volatile("" ::: "memory"); __builtin_amdgcn_s_barrier(); asm volatile("" ::: "memory");
#endif
    }
};

__device__ __forceinline__ unsigned cvt_pk_bf16(float lo, float hi) { unsigned r; asm volatile("v_cvt_pk_bf16_f32 %0, %1, %2" : "=v"(r) : "v"(lo), "v"(hi)); return r; }
typedef float f32x2 __attribute__((ext_vector_type(2)));
__device__ __forceinline__ f32x2 gelu_pk(f32x2 v) {
    const f32x2 av = __builtin_elementwise_abs(v), d = av * 0.2316418882f + 1.0f;
    f32x2 t; t.x = __builtin_amdgcn_rcpf(d.x); t.y = __builtin_amdgcn_rcpf(d.y);
    f32x2 q = t * 0.5307027145f + (-0.7265760135f); q = q * t + 0.7107068705f; q = q * t + (-0.142248368f); q = q * t + 0.127414796f; q = q * t;
    const f32x2 s = (v * v) * (-0.72134752044f);
    f32x2 e; e.x = __builtin_amdgcn_exp2f(s.x); e.y = __builtin_amdgcn_exp2f(s.y);
    const f32x2 m = v * (q * e), r = v - m;
    f32x2 o; o.x = v.x < 0.f ? m.x : r.x; o.y = v.y < 0.f ? m.y : r.y; return o;
}

struct EpiF32 {
    static constexpr bool PERM = false, AFTER_DRAIN = false;
    float* C; int ldc; const float* bias;
    __device__ __forceinline__ void operator()(const f32x4 (&acc)[2][2][4][2], const Unit& u, int wr, int wc, int fr_, int fq_) const {
        const int tl_ = opaque_tid(), fr = tl_ & 15, fq = (tl_ >> 4) & 3; (void)fr_; (void)fq_;
        const int row0 = u.pm * BM + wr * 64 + fr, col0 = u.pn * BM + wc * 32 + 4 * fq;
        f32x4 bv[2][2];
#pragma unroll
        for (int bj = 0; bj < 2; ++bj)
#pragma unroll
            for (int n = 0; n < 2; ++n) bv[bj][n] = bias ? *(const f32x4*)(bias + col0 + bj * HALF + n * 16) : (f32x4){0.f, 0.f, 0.f, 0.f};
#pragma unroll
        for (int ai = 0; ai < 2; ++ai)
#pragma unroll
            for (int m = 0; m < 4; ++m) { float* rowp = C + (size_t)(row0 + ai * HALF + m * 16) * ldc + col0;
#pragma unroll
                for (int bj = 0; bj < 2; ++bj)
#pragma unroll
                    for (int n = 0; n < 2; ++n) *(f32x4*)(rowp + bj * HALF + n * 16) = acc[ai][bj][m][n] + bv[bj][n]; }
    }
};
template <int ACT  > struct EpiBf16 {
    static constexpr bool PERM = true, AFTER_DRAIN = false;
    bf16_t* O; int ldc; const float* bias; int split_cols; size_t split_stride;
    __device__ __forceinline__ void operator()(const f32x4 (&acc)[2][2][4][2], const Unit& u, int wr, int wc, int fr_, int fq_) const {
        const int tl_ = opaque_tid(), fr = tl_ & 15, fq = (tl_ >> 4) & 3; (void)fr_; (void)fq_;
        const int row0 = u.pm * BM + wr * 64 + fr; int colt = u.pn * BM; bf16_t* base = O;
        if (split_cols) { const int t = colt / split_cols; base += (size_t)t * split_stride; colt -= t * split_cols; }
        const int col0 = colt + wc * 32 + 8 * fq, bcol0 = u.pn * BM + wc * 32 + 8 * fq;
        f32x4 bv[2][2];
#pragma unroll
        for (int bj = 0; bj < 2; ++bj)
#pragma unroll
            for (int n = 0; n < 2; ++n) bv[bj][n] = bias ? *(const f32x4*)(bias + bcol0 + bj * HALF + 4 * n) : (f32x4){0.f, 0.f, 0.f, 0.f};
#pragma unroll
        for (int ai = 0; ai < 2; ++ai)
#pragma unroll
            for (int m = 0; m < 4; ++m) { bf16_t* rowp = base + (size_t)(row0 + ai * HALF + m * 16) * ldc + col0;
#pragma unroll
                for (int bj = 0; bj < 2; ++bj) { f32x4 v0 = acc[ai][bj][m][0] + bv[bj][0], v1 = acc[ai][bj][m][1] + bv[bj][1];
                    if (ACT == 1) { f32x2 a = gelu_pk((f32x2){v0[0], v0[1]}), b = gelu_pk((f32x2){v0[2], v0[3]}), c = gelu_pk((f32x2){v1[0], v1[1]}), d = gelu_pk((f32x2){v1[2], v1[3]});
                        v0 = (f32x4){a.x, a.y, b.x, b.y}; v1 = (f32x4){c.x, c.y, d.x, d.y}; }
                    if (ACT == 2) {
#pragma unroll
                        for (int j = 0; j < 4; ++j) { v0[j] = 0.5f * v0[j] * (1.0f + erff(v0[j] * 0.70710678f)); v1[j] = 0.5f * v1[j] * (1.0f + erff(v1[j] * 0.70710678f)); } }
                    u32x4 w; w.x = cvt_pk_bf16(v0[0], v0[1]); w.y = cvt_pk_bf16(v0[2], v0[3]); w.z = cvt_pk_bf16(v1[0], v1[1]); w.w = cvt_pk_bf16(v1[2], v1[3]);
                    *(u32x4*)(rowp + bj * HALF) = w; } }
    }
};

template <class Epi, class Sched, bool STAMP = false>
__device__ __forceinline__ void gemm_phase(PG8_LAS unsigned char* lds, const Gemm g, const Sched& S, const Epi& E, unsigned long long* stamps) {
    const int tid = opaque_tid(), wid = __builtin_amdgcn_readfirstlane(tid >> 6), lane = tid & 63, wr = wid >> 2, wc = wid & 3, fr = lane & 15, fq = lane >> 4;
    const int K = g.K, nt = K / BK, lda = g.lda, ldb = g.ldb;
    int ts_lo = 0, ts_hi = 0, nts = 0; const unsigned long long rt_entry = STAMP ? (unsigned long long)wall_clock64() : 0ull;
#define PG8_STAMP() do { if (STAMP && wid == 0 && nts < 64) { const unsigned long long _c = (unsigned long long)clock64(); \
        ts_lo = (lane == nts) ? (int)(unsigned)_c : ts_lo; ts_hi = (lane == nts) ? (int)(unsigned)(_c >> 32) : ts_hi; ++nts; } } while (0)
    PG8_STAMP();
    unsigned voffA[2], voffB[2];
#pragma unroll
    for (int i = 0; i < 2; ++i) { int R, C; stage_rc(tid * 16 + i * 8192, R, C); const int Rb = Epi::PERM ? ((R & ~31) + perm32(R & 31)) : R;
        voffA[i] = (unsigned)(R * lda + C) * 2u; voffB[i] = (unsigned)(Rb * ldb + C) * 2u; }
    const size_t kstep = (size_t)(BK * 2);
    const size_t hstep = (size_t)HALF * ldb * 2;
    const size_t tstep = 2 * hstep; const size_t hstepA = (size_t)HALF * lda * 2, tstepA = 2 * hstepA;
    const unsigned ldsw = (unsigned)wid * 1024u;
    const int aoff = lds_byte(wr * 64 + fr, fq * 8), boff = lds_byte(wc * 32 + fr, fq * 8);
#define PG8_SA(b, h) (((b) * 2 + (h)) * HTB)
#define PG8_SB(b, h) ((4 + (b) * 2 + (h)) * HTB)
#define PG8_STAGE(bufoff, gbase, voff) do { _Pragma("unroll") for (int _i = 0; _i < 2; ++_i) \
        __builtin_amdgcn_global_load_lds((const unsigned*)((const char*)(gbase) + (voff)[_i]), (PG8_LAS unsigned*)(lds + (bufoff) + ldsw + _i * 8192), 16, 0, 0); } while (0)
#define PG8_LDA(dst, b, h) do { _Pragma("unroll") for (int m = 0; m < 4; ++m) _Pragma("unroll") for (int k = 0; k < 2; ++k) dst[m][k] = *(const PG8_LAS bf16x8*)(lds + PG8_SA(b, h) + aoff + m * 2048 + k * 1024); } while (0)
#define PG8_LDB(dst, b, h) do { _Pragma("unroll") for (int n = 0; n < 2; ++n) _Pragma("unroll") for (int k = 0; k < 2; ++k) dst[n][k] = *(const PG8_LAS bf16x8*)(lds + PG8_SB(b, h) + boff + n * 2048 + k * 1024); } while (0)
#define PG8_MMA(ai, bj, At, Bt) do { __builtin_amdgcn_s_setprio(1); _Pragma("unroll") for (int m = 0; m < 4; ++m) _Pragma("unroll") for (int n = 0; n < 2; ++n) _Pragma("unroll") for (int k = 0; k < 2; ++k) \
        acc[ai][bj][m][n] = __builtin_amdgcn_mfma_f32_16x16x32_bf16(Bt[n][k], At[m][k], acc[ai][bj][m][n], 0, 0, 0); __builtin_amdgcn_s_setprio(0); } while (0)
#define PG8_WAIT_V(n) asm volatile("s_waitcnt vmcnt(" #n ")" ::: "memory")
#define PG8_WAIT_L(n) asm volatile("s_waitcnt lgkmcnt(" #n ")" ::: "memory")
#define PG8_BAR __builtin_amdgcn_s_barrier()
#define PG8_SCHED __builtin_amdgcn_sched_barrier(0)
    Unit cur, nxt; int ui = 0;
    if (!S.next(0, cur)) return;
    f32x4 acc[2][2][4][2];
#pragma unroll
    for (int a = 0; a < 2; ++a)
#pragma unroll
        for (int b = 0; b < 2; ++b)
#pragma unroll
            for (int m = 0; m < 4; ++m)
#pragma unroll
                for (int n = 0; n < 2; ++n) acc[a][b][m][n] = (f32x4){0.f, 0.f, 0.f, 0.f};
    bf16x8 At[4][2], B0[2][2], B1[2][2];
    const char* cA = (const char*)g.A + (size_t)cur.pm * tstepA + (size_t)cur.kofs * 2; const char* cB = (const char*)g.Bt + (size_t)cur.pn * tstep + (size_t)cur.kofs * 2;
    S.a_ready(cur);
    PG8_STAGE(PG8_SB(0, 0), cB, voffB); PG8_STAGE(PG8_SA(0, 0), cA, voffA); PG8_STAGE(PG8_SB(0, 1), cB + hstep, voffB); PG8_STAGE(PG8_SA(0, 1), cA + hstepA, voffA);
    if (wr == 1) PG8_BAR;
    PG8_WAIT_V(4); PG8_BAR;
    PG8_STAGE(PG8_SB(1, 0), cB + kstep, voffB); PG8_STAGE(PG8_SA(1, 0), cA + kstep, voffA); PG8_STAGE(PG8_SB(1, 1), cB + hstep + kstep, voffB);
    PG8_WAIT_V(6); PG8_BAR;
    PG8_STAMP();
    for (;;) {
        const bool has_next = S.next(ui + 1, nxt);
        const char* nA = has_next ? (const char*)g.A + (size_t)nxt.pm * tstepA + (size_t)nxt.kofs * 2 : cA; const char* nB = has_next ? (const char*)g.Bt + (size_t)nxt.pn * tstep + (size_t)nxt.kofs * 2 : cB;
        for (int t = 0; t < nt; t += 2) {
            const bool last = (t == nt - 2);
            const char* a1 = cA + (size_t)(t + 1) * kstep;
            const char* a2 = last ? nA : cA + (size_t)(t + 2) * kstep; const char* b2 = last ? nB : cB + (size_t)(t + 2) * kstep;
            const char* a3 = a2 + kstep; const char* b3 = b2 + kstep;
            if (last && has_next) S.a_ready(nxt);
            PG8_LDB(B0, 0, 0); PG8_SCHED; PG8_LDA(At, 0, 0); PG8_STAGE(PG8_SA(1, 1), a1 + hstepA, voffA);
            PG8_WAIT_L(8); PG8_BAR; PG8_WAIT_L(0); PG8_MMA(0, 0, At, B0); PG8_BAR; PG8_SCHED;
            PG8_LDB(B1, 0, 1); PG8_STAGE(PG8_SB(0, 0), b2, voffB);
            PG8_BAR; PG8_WAIT_L(0); PG8_MMA(0, 1, At, B1); PG8_BAR;
            PG8_LDA(At, 0, 1); PG8_STAGE(PG8_SA(0, 0), a2, voffA);
            PG8_BAR; PG8_WAIT_L(0); PG8_MMA(1, 0, At, B0); PG8_BAR; PG8_SCHED;
            PG8_STAGE(PG8_SB(0, 1), b2 + hstep, voffB);
            PG8_WAIT_V(6); PG8_BAR; PG8_MMA(1, 1, At, B1); PG8_BAR;
            PG8_LDB(B0, 1, 0); PG8_SCHED; PG8_LDA(At, 1, 0); PG8_STAGE(PG8_SA(0, 1), a2 + hstepA, voffA);
            PG8_WAIT_L(8); PG8_BAR; PG8_WAIT_L(0); PG8_MMA(0, 0, At, B0); PG8_BAR; PG8_SCHED;
            PG8_LDB(B1, 1, 1); PG8_STAGE(PG8_SB(1, 0), b3, voffB);
            PG8_BAR; PG8_WAIT_L(0); PG8_MMA(0, 1, At, B1); PG8_BAR;
            PG8_LDA(At, 1, 1); PG8_STAGE(PG8_SA(1, 0), a3, voffA);
            PG8_BAR; PG8_WAIT_L(0); PG8_MMA(1, 0, At, B0); PG8_BAR; PG8_SCHED;
            PG8_STAGE(PG8_SB(1, 1), b3 + hstep, voffB);
            PG8_WAIT_V(6); PG8_BAR; PG8_MMA(1, 1, At, B1); PG8_BAR;
        }
        PG8_STAMP();
        if constexpr (!Epi::AFTER_DRAIN) { E(acc, cur, wr, wc, fr, fq); S.done(cur); }
        PG8_STAMP();
        if (!has_next) break;
#pragma unroll
        for (int a = 0; a < 2; ++a)
#pragma unroll
            for (int b = 0; b < 2; ++b)
#pragma unroll
                for (int m = 0; m < 4; ++m)
#pragma unroll
                    for (int n = 0; n < 2; ++n) acc[a][b][m][n] = (f32x4){0.f, 0.f, 0.f, 0.f};
        cur = nxt; cA = nA; cB = nB; ++ui;
    }
    PG8_WAIT_V(0);
    if (wr == 0) PG8_BAR;
    PG8_BAR;
    if constexpr (Epi::AFTER_DRAIN) { E.fused(acc, cur, wr, wc, fr, fq, lds, wid, lane); S.done(cur); }
    PG8_STAMP();
    if (STAMP && wid == 0) { stamps[lane] = lane < nts ? (((unsigned long long)(unsigned)ts_hi << 32) | (unsigned)ts_lo) : 0ull;
        if (lane == 62) stamps[62] = rt_entry; if (lane == 63) stamps[63] = (unsigned long long)wall_clock64(); }
#undef PG8_STAMP
#undef PG8_SA
#undef PG8_SB
#undef PG8_STAGE
#undef PG8_LDA
#undef PG8_LDB
#undef PG8_MMA
#undef PG8_WAIT_V
#undef PG8_WAIT_L
#undef PG8_BAR
#undef PG8_SCHED
}
}

#define XB_TMO      128
#define XB_XCNT(j)  (256  + 64 * (j))
#define XB_XSUB(j)  (1280 + 64 * (j))
#define XB_XGEN(j)  (2304 + 64 * (j))
#define XB_TOP      3328
#define XB_TOPGEN   3392
#define XCD_BAR_WORDS 3456
#define XB_SPIN_CAP (1u << 18)
#define LAS __attribute__((address_space(3)))

__device__ __forceinline__ unsigned xb_ld(unsigned* p)              { return __hip_atomic_load(p, __ATOMIC_RELAXED, __HIP_MEMORY_SCOPE_AGENT); }
__device__ __forceinline__ unsigned xb_add(unsigned* p, unsigned v) { return __hip_atomic_fetch_add(p, v, __ATOMIC_RELAXED, __HIP_MEMORY_SCOPE_AGENT); }
__device__ __forceinline__ unsigned xb_xcc_id() { return (unsigned)__builtin_amdgcn_s_getreg((3 << 11) | 20) & 0xFu; }
#define XB_SPIN(cond, bar) do { unsigned _sp = 0; while (cond) { __builtin_amdgcn_s_sleep(1); \
    if ((++_sp & 255u) == 0u) { if (xb_ld(&(bar)[XB_TMO])) break; if (_sp > XB_SPIN_CAP) { atomicAdd(&(bar)[XB_TMO], 1u); break; } } } } while (0)

struct XcdBarrier {
    unsigned* bar; unsigned x;
    volatile LAS unsigned* st;
};

__device__ __forceinline__ XcdBarrier xcd_barrier_post(unsigned* bar, volatile LAS unsigned* st) {
    XcdBarrier b; b.bar = bar; b.x = xb_xcc_id(); b.st = st;
    if (threadIdx.x == 0) (void)xb_add(&bar[XB_XCNT(b.x)], 1u);
    return b;
}
__device__ __forceinline__ void xcd_barrier_complete(unsigned* bar, unsigned x, unsigned& nloc, unsigned& nx) {
    const unsigned G = gridDim.x * gridDim.y * gridDim.z;
    unsigned sum, cnt, mine, sp = 0u;
    for (;;) {
        sum = 0u; cnt = 0u; mine = 0u;
#pragma unroll
        for (unsigned j = 0; j < 16; ++j) { const unsigned c = xb_ld(&bar[XB_XCNT(j)]); sum += c; cnt += (c > 0u) ? 1u : 0u; mine = (j == x) ? c : mine; }
        if (sum == G) break;
        __builtin_amdgcn_s_sleep(1);
        if ((++sp & 255u) == 0u) { if (xb_ld(&bar[XB_TMO])) break; if (sp > XB_SPIN_CAP) { atomicAdd(&bar[XB_TMO], 1u); break; } }
    }
    nloc = mine > 0u ? mine : 1u; nx = cnt > 0u ? cnt : 1u;
}

__device__ __forceinline__ void xcd_barrier(const XcdBarrier& b) {
    asm volatile("s_waitcnt vmcnt(0)" ::: "memory");
    __syncthreads();
    if (threadIdx.x == 0) {
        unsigned* bar = b.bar;
        __builtin_amdgcn_s_waitcnt(0);
        unsigned nloc = b.st[0], nx = b.st[1];
        if (nloc == 0u) { xcd_barrier_complete(bar, b.x, nloc, nx); b.st[0] = nloc; b.st[1] = nx; }
        const unsigned old = xb_add(&bar[XB_XSUB(b.x)], 1u);
        const unsigned gen = old / nloc;
        if (old + 1u == (gen + 1u) * nloc) {
            __builtin_amdgcn_fence(__ATOMIC_RELEASE, "agent");
            asm volatile("s_waitcnt vmcnt(0)" ::: "memory");
            const unsigned og = xb_add(&bar[XB_TOP], 1u);
            const unsigned tg = og / nx;
            if (og + 1u == (tg + 1u) * nx) xb_add(&bar[XB_TOPGEN], 1u);
            else XB_SPIN(xb_ld(&bar[XB_TOPGEN]) == tg, bar);
            __builtin_amdgcn_fence(__ATOMIC_ACQUIRE, "agent");
            xb_add(&bar[XB_XGEN(b.x)], 1u);
            asm volatile("s_waitcnt vmcnt(0)" ::: "memory");
        } else {
            XB_SPIN(xb_ld(&bar[XB_XGEN(b.x)]) == gen, bar);
            __builtin_amdgcn_fence(__ATOMIC_ACQUIRE, "agent");
            asm volatile("s_waitcnt vmcnt(0)" ::: "memory");
        }
    }
    __syncthreads();
}

namespace mk {
using pg8::bf16_t; using pg8::bf16x8; using pg8::f32x4; using pg8::u32x4; using pg8::Unit; using pg8::cvt_pk_bf16;
typedef float f32x16 __attribute__((ext_vector_type(16)));
typedef short s16x4 __attribute__((ext_vector_type(4)));
typedef unsigned u32x2 __attribute__((ext_vector_type(2)));

constexpr int NTOK = 33024, NP = 32768, DM = 1024, SEQ = 16384, DFF = 2816;
constexpr float EPS = 1e-6f;
constexpr int NPHASE = 26;
constexpr int LDS_MAIN = 141312, LDS_TOTAL = LDS_MAIN + 16;
constexpr size_t OUT_RETP = 33816576, OUT_RETS = 35913728, OUT_POOLP = 52690944, OUT_POOLS = 52752384;
constexpr size_t WS_WRI = 0, WS_WRO = 12582912, WS_WPL = 16777216, WS_WFI = 18874368, WS_WFO = 30408704, WS_XB = 36175872,
                 WS_QKV = 103809024, WS_T = 374341632, WS_COS = 441450496, WS_SIN = 449839104, WS_RSS = 458227712, WS_GSS = 477249536, WS_BAR = 494157824, WS_END = 494174208;

struct Params {
    const float *x_prompt, *x_sample, *state_ret, *state_pool, *norm_mix, *w_ret_in, *w_ret_out, *w_pool, *pool_scale, *norm_ffn, *w_ffn_in, *w_ffn_out, *norm_final;
    float* out; unsigned char* ws; int ph_lo, ph_hi;
};

__device__ __forceinline__ float lg2gamma(int h) { return h == 0 ? -0.04580368961312479f : h == 1 ? -0.02272007650008353f : h == 2 ? -0.011315313227834146f : -0.005646563141142063f; }
__device__ __forceinline__ float sum16(const float* p) {
    const float4 a = *(const float4*)p, b = *(const float4*)(p + 4), c = *(const float4*)(p + 8), d = *(const float4*)(p + 12);
    return (((a.x + a.y) + (a.z + a.w)) + ((b.x + b.y) + (b.z + b.w))) + (((c.x + c.y) + (c.z + c.w)) + ((d.x + d.y) + (d.z + d.w)));
}
__device__ __forceinline__ float rs_row(const float* rssrow) { return __builtin_amdgcn_rsqf(sum16(rssrow) * (1.0f / 1024.0f) + EPS); }
__device__ __forceinline__ float silu_f(float v) { return v * __builtin_amdgcn_rcpf(1.0f + __builtin_amdgcn_exp2f(v * -1.4426950408889634f)); }
__device__ __forceinline__ bf16_t f2bf(float f) { unsigned u = __float_as_uint(f); u += 0x7FFFu + ((u >> 16) & 1u); return (bf16_t)(u >> 16); }
__device__ __forceinline__ float bf2f(unsigned short b) { return __uint_as_float(((unsigned)b) << 16); }

__device__ __forceinline__ void row_scales(float (&r)[8], const float* rss, int row0, int fq) {
    float4 q[8];
#pragma unroll
    for (int i = 0; i < 8; ++i) q[i] = *(const float4*)(rss + (size_t)(row0 + (i >> 2) * 128 + (i & 3) * 16) * 16 + fq * 4);
#pragma unroll
    for (int i = 0; i < 8; ++i) { float t = (q[i].x + q[i].y) + (q[i].z + q[i].w); t += __shfl_xor(t, 16); t += __shfl_xor(t, 32); r[i] = __builtin_amdgcn_rsqf(t * (1.0f / 1024.0f) + EPS); }
}
struct EpiQKV {
    static constexpr bool PERM = true, AFTER_DRAIN = false;
    bf16_t* O; const float* rss; const float* cosT; const float* sinT;
    __device__ __forceinline__ void operator()(const f32x4 (&acc)[2][2][4][2], const Unit& u, int wr, int wc, int fr_, int fq_) const {
        const int tl_ = opaque_tid(), fr = tl_ & 15, fq = (tl_ >> 4) & 3; (void)fr_; (void)fq_;
        const int row0 = u.pm * 256 + wr * 64 + fr, cin = wc * 32 + 8 * fq;
        const bool rot = u.pn < 8; const float lg = lg2gamma(u.pn & 3);
        float rr[8]; row_scales(rr, rss, row0, fq);
        u32x4 wout[8][2];
#pragma unroll
        for (int am = 0; am < 4; ++am) {
            const int ai = am >> 1;
            f32x4 ct[2][2], st[2][2];
            if (rot) {
#pragma unroll
                for (int mm = 0; mm < 2; ++mm) {
                    const int row = row0 + ai * 128 + ((am & 1) * 2 + mm) * 16; const int pos = (row < NP) ? (row & (SEQ - 1)) : 1024 + ((row - NP) & 15);
#pragma unroll
                    for (int n = 0; n < 2; ++n) { ct[mm][n] = *(const f32x4*)(cosT + (size_t)pos * 128 + cin + 4 * n); st[mm][n] = *(const f32x4*)(sinT + (size_t)pos * 128 + cin + 4 * n); }
                }
            }
#pragma unroll
            for (int mm = 0; mm < 2; ++mm) {
                const int m = (am & 1) * 2 + mm;
                const int row = row0 + ai * 128 + m * 16;
                const float r = rr[ai * 4 + m];
                int l, Lc;
                if (row < NP) { l = row & 63; Lc = 64; } else { l = (row - NP) & 15; Lc = 16; }
                f32x4 o1[2], o2[2];
                if (rot) {
                    const float e = (u.pn < 4) ? (float)(l + 1) : (float)(Lc - 1 - l);
                    const float dec = exp2f(e * lg) * r;
#pragma unroll
                    for (int n = 0; n < 2; ++n) {
                        const f32x4 c4 = ct[mm][n], s4 = st[mm][n];
                        const f32x4 x1 = acc[ai][0][m][n] * dec, x2 = acc[ai][1][m][n] * dec;
                        o1[n] = x1 * c4 - x2 * s4; o2[n] = x1 * s4 + x2 * c4;
                    }
                } else {
#pragma unroll
                    for (int n = 0; n < 2; ++n) { o1[n] = acc[ai][0][m][n] * r; o2[n] = acc[ai][1][m][n] * r; }
                }
                u32x4 w; w.x = cvt_pk_bf16(o1[0][0], o1[0][1]); w.y = cvt_pk_bf16(o1[0][2], o1[0][3]); w.z = cvt_pk_bf16(o1[1][0], o1[1][1]); w.w = cvt_pk_bf16(o1[1][2], o1[1][3]);
                wout[ai * 4 + m][0] = w;
                w.x = cvt_pk_bf16(o2[0][0], o2[0][1]); w.y = cvt_pk_bf16(o2[0][2], o2[0][3]); w.z = cvt_pk_bf16(o2[1][0], o2[1][1]); w.w = cvt_pk_bf16(o2[1][2], o2[1][3]);
                wout[ai * 4 + m][1] = w;
            }
        }
#pragma unroll
        for (int i = 0; i < 8; ++i) {
            bf16_t* rowp = O + (size_t)(row0 + (i >> 2) * 128 + (i & 3) * 16) * 4096 + u.pn * 256 + cin;
            *(u32x4*)rowp = wout[i][0]; *(u32x4*)(rowp + 128) = wout[i][1];
        }
    }
};
struct EpiGate {
    static constexpr bool PERM = true, AFTER_DRAIN = false;
    bf16_t* QKV; const float* rss; const float* gss;
    __device__ __forceinline__ void operator()(const f32x4 (&acc)[2][2][4][2], const Unit& u, int wr, int wc, int fr_, int fq_) const {
        const int tl_ = opaque_tid(), fr = tl_ & 15, fq = (tl_ >> 4) & 3; (void)fr_; (void)fq_;
        const int row0 = u.pm * 256 + wr * 64 + fr, cin = wc * 32 + 8 * fq, head = u.pn >> 1;
        float rr[8]; row_scales(rr, rss, row0, fq);
        u32x4 wout[8][2];
#pragma unroll
        for (int ai = 0; ai < 2; ++ai) {
            u32x4 ovs[4][2]; float2 gps[4];
#pragma unroll
            for (int i = 0; i < 4; ++i) {
                const int row = row0 + ai * 128 + i * 16; const bf16_t* rp = QKV + (size_t)row * 4096 + 2048 + u.pn * 256 + cin;
                ovs[i][0] = *(const u32x4*)rp; ovs[i][1] = *(const u32x4*)(rp + 128); gps[i] = *(const float2*)(gss + ((size_t)row * 4 + head) * 2);
            }
#pragma unroll
            for (int m = 0; m < 4; ++m) {
                const float r = rr[ai * 4 + m];
                const float rn = __builtin_amdgcn_rsqf((gps[m].x + gps[m].y) * (1.0f / 512.0f) + EPS);
#pragma unroll
                for (int bj = 0; bj < 2; ++bj) {
                    const u32x4 ov = ovs[m][bj];
                    float g[8], o[8];
#pragma unroll
                    for (int j = 0; j < 4; ++j) { g[j] = acc[ai][bj][m][0][j] * r; g[4 + j] = acc[ai][bj][m][1][j] * r; }
                    o[0] = __uint_as_float(ov.x << 16); o[1] = __uint_as_float(ov.x & 0xffff0000u); o[2] = __uint_as_float(ov.y << 16); o[3] = __uint_as_float(ov.y & 0xffff0000u);
                    o[4] = __uint_as_float(ov.z << 16); o[5] = __uint_as_float(ov.z & 0xffff0000u); o[6] = __uint_as_float(ov.w << 16); o[7] = __uint_as_float(ov.w & 0xffff0000u);
                    float y[8];
#pragma unroll
                    for (int j = 0; j < 8; ++j) y[j] = silu_f(g[j]) * o[j] * rn;
                    u32x4 w; w.x = cvt_pk_bf16(y[0], y[1]); w.y = cvt_pk_bf16(y[2], y[3]); w.z = cvt_pk_bf16(y[4], y[5]); w.w = cvt_pk_bf16(y[6], y[7]);
                    wout[ai * 4 + m][bj] = w;
                }
            }
        }
#pragma unroll
        for (int i = 0; i < 8; ++i) {
            bf16_t* rowp = QKV + (size_t)(row0 + (i >> 2) * 128 + (i & 3) * 16) * 4096 + 2048 + u.pn * 256 + cin;
            *(u32x4*)rowp = wout[i][0]; *(u32x4*)(rowp + 128) = wout[i][1];
        }
    }
};
struct EpiFfn {
    static constexpr bool PERM = true, AFTER_DRAIN = false;
    bf16_t* ACT; const float* rss;
    __device__ __forceinline__ void operator()(const f32x4 (&acc)[2][2][4][2], const Unit& u, int wr, int wc, int fr_, int fq_) const {
        const int tl_ = opaque_tid(), fr = tl_ & 15, fq = (tl_ >> 4) & 3; (void)fr_; (void)fq_;
        const int row0 = u.pm * 256 + wr * 64 + fr, cout = u.pn * 128 + wc * 16 + 4 * fq;
        float rr[8]; row_scales(rr, rss, row0, fq);
#pragma unroll
        for (int ai = 0; ai < 2; ++ai)
#pragma unroll
            for (int m = 0; m < 4; ++m) {
                const int row = row0 + ai * 128 + m * 16;
                const float r = rr[ai * 4 + m];
                bf16_t* rowp = ACT + (size_t)row * DFF + cout;
#pragma unroll
                for (int bj = 0; bj < 2; ++bj) {
                    const f32x4 a = acc[ai][bj][m][0] * r, b = acc[ai][bj][m][1] * r;
                    u32x2 w; w.x = cvt_pk_bf16(silu_f(a[0]) * b[0], silu_f(a[1]) * b[1]); w.y = cvt_pk_bf16(silu_f(a[2]) * b[2], silu_f(a[3]) * b[3]);
                    *(u32x2*)(rowp + bj * 64) = w;
                }
            }
    }
};
struct EpiRes {
    static constexpr bool PERM = false, AFTER_DRAIN = false;
    const float* base_p; const float* base_s; float* xres; bf16_t* xb; float* rss_next;
    __device__ __forceinline__ void operator()(const f32x4 (&acc)[2][2][4][2], const Unit& u, int wr, int wc, int fr_, int fq_) const {
        const int tl_ = opaque_tid(), fr = tl_ & 15, fq = (tl_ >> 4) & 3; (void)fr_; (void)fq_;
        const int row0 = u.pm * 256 + wr * 64 + fr, col0 = u.pn * 256 + wc * 32 + 4 * fq;
#pragma unroll
        for (int ai = 0; ai < 2; ++ai) {
            f32x4 bv[4][4];
#pragma unroll
            for (int m = 0; m < 4; ++m) {
                const int row = row0 + ai * 128 + m * 16;
                const float* bp = (row < NP) ? base_p + (size_t)row * DM : base_s + (size_t)(row - NP) * DM;
#pragma unroll
                for (int q = 0; q < 4; ++q) bv[m][q] = *(const f32x4*)(bp + col0 + (q >> 1) * 128 + (q & 1) * 16);
            }
#pragma unroll
            for (int m = 0; m < 4; ++m) {
                const int row = row0 + ai * 128 + m * 16;
                float ss = 0.f;
#pragma unroll
                for (int bj = 0; bj < 2; ++bj)
#pragma unroll
                    for (int n = 0; n < 2; ++n) {
                        const int c = col0 + bj * 128 + n * 16;
                        const f32x4 v = bv[m][bj * 2 + n] + acc[ai][bj][m][n];
                        *(f32x4*)(xres + (size_t)row * DM + c) = v;
                        u32x2 w; w.x = cvt_pk_bf16(v[0], v[1]); w.y = cvt_pk_bf16(v[2], v[3]);
                        *(u32x2*)(xb + (size_t)row * DM + c) = w;
                        ss += (v[0] * v[0] + v[1] * v[1]) + (v[2] * v[2] + v[3] * v[3]);
                    }
                ss += __shfl_xor(ss, 16); ss += __shfl_xor(ss, 32);
                if (fq == 0) rss_next[(size_t)row * 16 + u.pn * 4 + wc] = ss;
            }
        }
    }
};

struct MapId { __device__ __forceinline__ float scale(int) const { return 1.f; } __device__ __forceinline__ int drow(int n) const { return n; } };
struct MapRetIn { __device__ __forceinline__ float scale(int n) const { return (n >= 1024 && n < 2048) ? 0.0625f : 1.f; } __device__ __forceinline__ int drow(int n) const { return n; } };
struct MapFfnIn { __device__ __forceinline__ float scale(int) const { return 1.f; }
    __device__ __forceinline__ int drow(int n) const { const int isb = n >= DFF, j = n - isb * DFF; return (j >> 2) * 8 + isb * 4 + (j & 3); } };
struct MapPool { const float* cs; __device__ __forceinline__ float scale(int n) const { return cs[n]; } __device__ __forceinline__ int drow(int n) const { return n; } };

template <class MapF>
__device__ __forceinline__ void conv_T(LAS unsigned char* lds, const float* src, int K, int Nsrc, int ldsrc, bf16_t* dst, int lddst, const float* gain, const MapF map) {
    const int tid = opaque_tid(), tk = K >> 6, tn = Nsrc >> 8, ntile = tk * tn;
    LAS bf16_t* tile = (LAS bf16_t*)lds;
    for (int t = blockIdx.x; t < ntile; t += gridDim.x) {
        const int k0 = (t % tk) << 6, n0 = (t / tk) << 8;
        {
            const int kk = tid >> 3, nn = (tid & 7) * 8; const float* sp = src + (size_t)(k0 + kk) * ldsrc + n0 + nn;
            const float gk = gain ? gain[k0 + kk] : 1.f;
            float4 a[4], b[4];
#pragma unroll
            for (int q = 0; q < 4; ++q) { a[q] = *(const float4*)(sp + q * 64); b[q] = *(const float4*)(sp + q * 64 + 4); }
#pragma unroll
            for (int q = 0; q < 4; ++q) {
                const int nb = q * 64 + nn; LAS bf16_t* tp = tile + nb * 72 + kk;
                tp[0 * 72] = f2bf(a[q].x * gk * map.scale(n0 + nb + 0)); tp[1 * 72] = f2bf(a[q].y * gk * map.scale(n0 + nb + 1));
                tp[2 * 72] = f2bf(a[q].z * gk * map.scale(n0 + nb + 2)); tp[3 * 72] = f2bf(a[q].w * gk * map.scale(n0 + nb + 3));
                tp[4 * 72] = f2bf(b[q].x * gk * map.scale(n0 + nb + 4)); tp[5 * 72] = f2bf(b[q].y * gk * map.scale(n0 + nb + 5));
                tp[6 * 72] = f2bf(b[q].z * gk * map.scale(n0 + nb + 6)); tp[7 * 72] = f2bf(b[q].w * gk * map.scale(n0 + nb + 7));
            }
        }
        __syncthreads();
        {
            const int nn = tid >> 3, kc = (tid & 7) * 8;
#pragma unroll
            for (int q = 0; q < 4; ++q) {
                const u32x4 raw = *(const LAS u32x4*)(tile + (q * 64 + nn) * 72 + kc);
                *(u32x4*)(dst + (size_t)map.drow(n0 + q * 64 + nn) * lddst + k0 + kc) = raw;
            }
        }
        __syncthreads();
    }
}
__device__ __forceinline__ void convert_ret(const Params& p, LAS unsigned char* lds, int j) {
    conv_T(lds, p.w_ret_in + (size_t)j * 1024 * 6144, 1024, 6144, 6144, (bf16_t*)(p.ws + WS_WRI), 1024, p.norm_mix + (size_t)(2 * j) * DM, MapRetIn{});
    conv_T(lds, p.w_ret_out + (size_t)j * 2048 * 1024, 2048, 1024, 1024, (bf16_t*)(p.ws + WS_WRO), 2048, nullptr, MapId{});
}
__device__ __forceinline__ void convert_pool(const Params& p, LAS unsigned char* lds, int j) {
    bf16_t* W = (bf16_t*)(p.ws + WS_WPL);
    for (size_t i = (size_t)blockIdx.x * blockDim.x + opaque_tid(); i < (size_t)1024 * 128; i += (size_t)gridDim.x * blockDim.x) {
        const int n = (int)(i >> 7), k = (int)(i & 127) * 8;
        if ((n >> 8) != (k >> 8)) { unsigned z = 0u; asm volatile("" : "+v"(z)); *(u32x4*)(W + (size_t)n * 1024 + k) = (u32x4){z, z, z, z}; }
    }
    for (int g = 0; g < 4; ++g)
        conv_T(lds, p.w_pool + ((size_t)j * 4 + g) * 65536, 256, 256, 256, W + (size_t)(g * 256) * 1024 + g * 256, 1024, nullptr, MapPool{p.pool_scale + (size_t)j * DM + g * 256});
}
__device__ __forceinline__ void convert_ffn(const Params& p, LAS unsigned char* lds, int i) {
    conv_T(lds, p.w_ffn_in + (size_t)i * 1024 * 5632, 1024, 5632, 5632, (bf16_t*)(p.ws + WS_WFI), 1024, p.norm_ffn + (size_t)i * DM, MapFfnIn{});
    conv_T(lds, p.w_ffn_out + (size_t)i * DFF * 1024, DFF, 1024, 1024, (bf16_t*)(p.ws + WS_WFO), DFF, nullptr, MapId{});
}
__device__ __forceinline__ void convert_mixer(const Params& p, LAS unsigned char* lds, int layer) { if (layer & 1) convert_pool(p, lds, layer >> 1); else convert_ret(p, lds, layer >> 1); }

__device__ __forceinline__ void phase0(const Params& p, LAS unsigned char* lds) {
    const int tid = opaque_tid(), lane = tid & 63, wid = tid >> 6;
    bf16_t* xb = (bf16_t*)(p.ws + WS_XB); float* rss = (float*)(p.ws + WS_RSS);
    for (int rb = (blockIdx.x * 8 + wid) * 4; rb < NTOK; rb += gridDim.x * 8 * 4) {
        float4 v[4][4];
#pragma unroll
        for (int q = 0; q < 4; ++q) {
            const int row = rb + q; const float* src = (row < NP) ? p.x_prompt + (size_t)row * DM : p.x_sample + (size_t)(row - NP) * DM;
#pragma unroll
            for (int i = 0; i < 4; ++i) v[q][i] = *(const float4*)(src + i * 256 + lane * 4);
        }
#pragma unroll
        for (int q = 0; q < 4; ++q) {
            const int row = rb + q; float ss = 0.f;
#pragma unroll
            for (int i = 0; i < 4; ++i) {
                const float4 x = v[q][i];
                ss += (x.x * x.x + x.y * x.y) + (x.z * x.z + x.w * x.w);
                u32x2 w; w.x = cvt_pk_bf16(x.x, x.y); w.y = cvt_pk_bf16(x.z, x.w);
                *(u32x2*)(xb + (size_t)row * DM + i * 256 + lane * 4) = w;
            }
#pragma unroll
            for (int o = 32; o >= 1; o >>= 1) ss += __shfl_xor(ss, o);
            if (lane < 16) rss[(size_t)row * 16 + lane] = (lane == 0) ? ss : 0.f;
        }
    }
    const size_t gt = (size_t)blockIdx.x * blockDim.x + tid, nth = (size_t)gridDim.x * blockDim.x;
    float* cosT = (float*)(p.ws + WS_COS); float* sinT = (float*)(p.ws + WS_SIN);
    for (size_t i = gt; i < (size_t)SEQ * 128; i += nth) {
        const int pos = (int)(i >> 7), j = (int)(i & 127);
        const double inv = exp2(-(double)j * 0.10381025296523007), t = (double)pos * inv * 0.31830988618379067154;
        double s, c; sincospi(t, &s, &c);
        cosT[i] = (float)c; sinT[i] = (float)s;
    }
    convert_mixer(p, lds, 0); convert_mixer(p, lds, 1); convert_ffn(p, lds, 0);
}

template <int W>
__device__ __forceinline__ void pool_unit(const float* xres, const float* sp, const LAS float* rl, bf16_t* dbuf, float* po, int rowbase, int t0, int c0, float g0, float g1, bool isS, bool lastu) {
    float2 hv[15 + W];
#pragma unroll
    for (int i = 0; i < 15 + W; ++i) {
        const int t = t0 - (W - 1) + i;
        float2 v = make_float2(0.f, 0.f);
        if (t >= 0) { const float2 x = *(const float2*)(xres + (size_t)(rowbase + t) * DM + c0); const float r = rl[i + 16 - W]; v = make_float2(x.x * r * g0, x.y * r * g1); }
        else if (isS) v = *(const float2*)(sp + (size_t)(15 + t) * DM + c0);
        hv[i] = v;
    }
    float2 s = make_float2(0.f, 0.f);
#pragma unroll
    for (int i = 0; i < W - 1; ++i) { s.x += hv[i].x; s.y += hv[i].y; }
#pragma unroll
    for (int k = 0; k < 16; ++k) {
        const float2 h = hv[W - 1 + k];
        s.x += h.x; s.y += h.y;
        const float inv = 1.0f / (isS ? (float)W : (float)min(t0 + k + 1, W));
        *(unsigned*)(dbuf + (size_t)(rowbase + t0 + k) * DM + c0) = cvt_pk_bf16(s.x * inv - h.x, s.y * inv - h.y);
        if (lastu && k >= 1) *(float2*)(po + (size_t)(k - 1) * DM + c0) = h;
        s.x -= hv[k].x; s.y -= hv[k].y;
    }
}
__device__ __forceinline__ void phase_pool_prep(const Params& p, LAS unsigned char* lds, int layer) {
    const int j = layer >> 1, tid = opaque_tid(), c0 = tid * 2, gi = __builtin_amdgcn_readfirstlane(tid >> 7);
    const float* xres = p.out; const float* rssc = (const float*)(p.ws + WS_RSS) + (size_t)(2 * layer) * NTOK * 16;
    const float g0 = p.norm_mix[(size_t)layer * DM + c0], g1 = p.norm_mix[(size_t)layer * DM + c0 + 1];
    bf16_t* dbuf = (bf16_t*)(p.ws + WS_QKV);
    LAS float* rl = (LAS float*)lds;
    for (int u = blockIdx.x; u < 2064; u += gridDim.x) {
        int t0, rowbase; bool isS, lastu; const float* sp = nullptr; float* po;
        if (u < 2048) { const int b = u >> 10; t0 = (u & 1023) * 16; rowbase = b * SEQ; isS = false; lastu = (u & 1023) == 1023; po = p.out + OUT_POOLP + ((size_t)(j * 2 + b) * 15) * DM; }
        else { const int sb = u - 2048; t0 = 0; rowbase = NP + sb * 16; isS = true; lastu = true; sp = p.state_pool + ((size_t)(j * 16 + sb) * 15) * DM; po = p.out + OUT_POOLS + ((size_t)(j * 16 + sb) * 15) * DM; }
        __syncthreads();
        if (tid < 31) { const int t = t0 - 15 + tid; rl[tid] = (t >= 0) ? rs_row(rssc + (size_t)(rowbase + t) * 16) : 0.f; }
        __syncthreads();
        if (gi == 0) pool_unit<2>(xres, sp, rl, dbuf, po, rowbase, t0, c0, g0, g1, isS, lastu);
        else if (gi == 1) pool_unit<4>(xres, sp, rl, dbuf, po, rowbase, t0, c0, g0, g1, isS, lastu);
        else if (gi == 2) pool_unit<8>(xres, sp, rl, dbuf, po, rowbase, t0, c0, g0, g1, isS, lastu);
        else pool_unit<16>(xres, sp, rl, dbuf, po, rowbase, t0, c0, g0, g1, isS, lastu);
    }
}

__device__ __forceinline__ void phase_final(const Params& p) {
    const float* rssc = (const float*)(p.ws + WS_RSS) + (size_t)8 * NTOK * 16;
    const int tid = opaque_tid(), lane = tid & 63, wid = tid >> 6;
    float4 g[4];
#pragma unroll
    for (int i = 0; i < 4; ++i) g[i] = *(const float4*)(p.norm_final + i * 256 + lane * 4);
    for (int rb = (blockIdx.x * 8 + wid) * 4; rb < NTOK; rb += gridDim.x * 8 * 4) {
        float4 v[4][4]; float t[4];
#pragma unroll
        for (int q = 0; q < 4; ++q) {
            t[q] = (lane < 16) ? rssc[(size_t)(rb + q) * 16 + lane] : 0.f;
#pragma unroll
            for (int i = 0; i < 4; ++i) v[q][i] = *(const float4*)(p.out + (size_t)(rb + q) * DM + i * 256 + lane * 4);
        }
#pragma unroll
        for (int q = 0; q < 4; ++q) {
            float ts = t[q];
#pragma unroll
            for (int o = 8; o >= 1; o >>= 1) ts += __shfl_xor(ts, o);
            const float r = __builtin_amdgcn_rsqf(__shfl(ts, 0) * (1.0f / 1024.0f) + EPS);
#pragma unroll
            for (int i = 0; i < 4; ++i) { float4 x = v[q][i]; x.x *= r * g[i].x; x.y *= r * g[i].y; x.z *= r * g[i].z; x.w *= r * g[i].w; *(float4*)(p.out + (size_t)(rb + q) * DM + i * 256 + lane * 4) = x; }
        }
    }
}

__device__ __forceinline__ unsigned offb(unsigned row, unsigned ch) { return 256u * row + 16u * (ch ^ (((row & 3u) << 2) | ((row >> 2) & 3u))); }
__device__ __forceinline__ unsigned img_off(unsigned row, unsigned ch32) { return (ch32 >> 4) * 16384u + offb(row, ch32 & 15u); }
constexpr unsigned IMG_Q = 0, IMG_K = 32768, IMG_V = 65536, IMG_P = 98304, IMG_O = 107520;

__device__ __forceinline__ void tile_load(u32x4 (&r)[4], const bf16_t* g, int ld, int nvalid, int tid_) {
    int tid = tid_; asm volatile("" : "+v"(tid));
    const int r0 = (tid >> 5) & 15, ch = tid & 31;
    const bf16_t* gp = g + (size_t)r0 * ld + ch * 8;
    if (nvalid >= 64) {
#pragma unroll
        for (int i = 0; i < 4; ++i) r[i] = *(const u32x4*)(gp + (size_t)(16 * i) * ld);
    } else {
        r[0] = *(const u32x4*)gp;
        unsigned z = 0u; asm volatile("" : "+v"(z));
#pragma unroll
        for (int i = 1; i < 4; ++i) r[i] = (u32x4){z, z, z, z};
    }
}
__device__ __forceinline__ void tile_store(LAS unsigned char* img, const u32x4 (&r)[4], int tid_) {
    int tid = tid_; asm volatile("" : "+v"(tid));
    const unsigned r0 = (tid >> 5) & 15, ch = tid & 31;
    LAS unsigned char* bp = img + img_off(r0, ch);
#pragma unroll
    for (int i = 0; i < 4; ++i) *(LAS u32x4*)(bp + 4096 * i) = r[i];
}
__device__ __forceinline__ bf16x8 tr_frag(LAS unsigned char* img, int lane, int cblk  , int ks) {
    const unsigned h = lane >> 5, blk = (lane >> 4) & 1, q = (lane & 15) >> 2, pp = lane & 3;
    const unsigned c = cblk & 3;
    const unsigned lowc = 2 * blk + (pp >> 1);
    const unsigned chx0 = ((c ^ q) << 2) | (lowc ^ (2 * h)), chx1 = chx0 ^ 1u;
    const unsigned rb = 256u * (8 * h + q) + 8 * (pp & 1);
    const unsigned a0 = rb + 16u * chx0, a1 = rb + 1024u + 16u * chx1;
    LAS unsigned char* base = img + (cblk >> 2) * 16384 + ks * 4096;
    const s16x4 lo = __builtin_amdgcn_ds_read_tr16_b64_v4i16((LAS s16x4*)(base + a0));
    const s16x4 hi = __builtin_amdgcn_ds_read_tr16_b64_v4i16((LAS s16x4*)(base + a1));
    return __builtin_shufflevector(lo, hi, 0, 1, 2, 3, 4, 5, 6, 7);
}
__device__ __forceinline__ bf16x8 pack8(const f32x16& s, int base) {
    u32x4 w; w.x = cvt_pk_bf16(s[base + 0], s[base + 1]); w.y = cvt_pk_bf16(s[base + 2], s[base + 3]); w.z = cvt_pk_bf16(s[base + 4], s[base + 5]); w.w = cvt_pk_bf16(s[base + 6], s[base + 7]);
    return __builtin_bit_cast(bf16x8, w);
}

__device__ __forceinline__ void state_update(f32x16 (&S)[8], LAS unsigned char* kimg, const bf16x8 (&Vf)[4], int lane) {
#pragma unroll
    for (int dt = 0; dt < 8; ++dt)
#pragma unroll
        for (int ks = 0; ks < 4; ++ks) {
            const bf16x8 a = tr_frag(kimg, lane, dt, ks);
            S[dt] = __builtin_amdgcn_mfma_f32_32x32x16_bf16(a, Vf[ks], S[dt], 0, 0, 0);
        }
}

__device__ __forceinline__ void phase_scan_local(const Params& p, LAS unsigned char* lds) {
    const int tid = opaque_tid(), lane_ = tid & 63, wid = __builtin_amdgcn_readfirstlane(tid >> 6);
    const bf16_t* qkv = (const bf16_t*)(p.ws + WS_QKV); float* T = (float*)(p.ws + WS_T);
    for (int u_ = blockIdx.x; u_ < 256; u_ += gridDim.x) {
        const int u = (gridDim.x == 256) ? (((u_ >> 4) << 4) | ((u_ & 7) << 1) | ((u_ >> 3) & 1)) : u_;
        const int eh = u & 1, seg = (u >> 1) & 15, h = (u >> 5) & 3, b = u >> 7;
        const size_t row0 = (size_t)b * SEQ + (size_t)seg * 1024;
        const bf16_t* kb = qkv + row0 * 4096 + 1024 + h * 256; const bf16_t* vb = qkv + row0 * 4096 + 2048 + h * 512 + eh * 256;
        const float gC = exp2f(64.f * lg2gamma(h));
        f32x16 S[8];
#pragma unroll
        for (int i = 0; i < 8; ++i)
#pragma unroll
            for (int r = 0; r < 16; ++r) S[i][r] = 0.f;
        u32x4 rk0[4], rv0[4], rk1[4], rv1[4];
        tile_load(rk0, kb, 4096, 64, tid); tile_load(rv0, vb, 4096, 64, tid);
        tile_load(rk1, kb + (size_t)64 * 4096, 4096, 64, tid); tile_load(rv1, vb + (size_t)64 * 4096, 4096, 64, tid);
        LDS_BARRIER();
        tile_store(lds, rk0, tid); tile_store(lds + 32768, rv0, tid);
        LDS_BARRIER();
        tile_load(rk0, kb + (size_t)2 * 64 * 4096, 4096, 64, tid); tile_load(rv0, vb + (size_t)2 * 64 * 4096, 4096, 64, tid);
        for (int c = 0; c < 16; c += 2) {
            {
                int lane = lane_; asm volatile("" : "+v"(lane));
                tile_store(lds + 65536, rk1, tid); tile_store(lds + 98304, rv1, tid);
#pragma unroll
                for (int i = 0; i < 8; ++i) S[i] *= gC;
                bf16x8 Vf[4];
#pragma unroll
                for (int ks = 0; ks < 4; ++ks) Vf[ks] = tr_frag(lds + 32768, lane, wid, ks);
                state_update(S, lds, Vf, lane);
                LDS_BARRIER();
                if (c + 3 < 16) { tile_load(rk1, kb + (size_t)(c + 3) * 64 * 4096, 4096, 64, tid); tile_load(rv1, vb + (size_t)(c + 3) * 64 * 4096, 4096, 64, tid); }
            }
            {
                int lane = lane_; asm volatile("" : "+v"(lane));
                if (c + 2 < 16) { tile_store(lds, rk0, tid); tile_store(lds + 32768, rv0, tid); }
#pragma unroll
                for (int i = 0; i < 8; ++i) S[i] *= gC;
                bf16x8 Vf[4];
#pragma unroll
                for (int ks = 0; ks < 4; ++ks) Vf[ks] = tr_frag(lds + 98304, lane, wid, ks);
                state_update(S, lds + 65536, Vf, lane);
                LDS_BARRIER();
                if (c + 4 < 16) { tile_load(rk0, kb + (size_t)(c + 4) * 64 * 4096, 4096, 64, tid); tile_load(rv0, vb + (size_t)(c + 4) * 64 * 4096, 4096, 64, tid); }
            }
        }
        float* Tu = T + (size_t)u * 65536;
        int lz = lane_; asm volatile("" : "+v"(lz));
        const int hl = lz >> 5, e = wid * 32 + (lz & 31);
#pragma unroll
        for (int dt = 0; dt < 8; ++dt)
#pragma unroll
            for (int r = 0; r < 16; ++r) Tu[(size_t)(32 * dt + (r & 3) + 8 * (r >> 2) + 4 * hl) * 256 + e] = S[dt][r];
    }
}

__device__ __forceinline__ void phase_scan_prefix(const Params& p, int jl) {
    float* T = (float*)(p.ws + WS_T);
    const int gt = blockIdx.x * 512 + opaque_tid(), nth = gridDim.x * 512;
    for (int i = gt; i < 262144; i += nth) {
        const int grp = i >> 14, pos = (i & 16383) * 4, eh = grp & 1, bh = grp >> 1, h = bh & 3;
        const float gS = exp2f(1024.f * lg2gamma(h));
        float* base = T + ((size_t)(bh * 16) * 2 + eh) * 65536 + pos;
        float4 t[16];
#pragma unroll
        for (int j = 0; j < 16; ++j) t[j] = *(const float4*)(base + (size_t)j * 131072);
        float zf = 0.f; asm volatile("" : "+v"(zf));
        float4 run = make_float4(zf, zf, zf, zf);
#pragma unroll
        for (int j = 0; j < 16; ++j) {
            *(float4*)(base + (size_t)j * 131072) = run;
            run.x = run.x * gS + t[j].x; run.y = run.y * gS + t[j].y; run.z = run.z * gS + t[j].z; run.w = run.w * gS + t[j].w;
        }
        const int d = pos >> 8, e = pos & 255;
        *(float4*)(p.out + OUT_RETP + ((size_t)((jl * 2 + (bh >> 2)) * 4 + h) * 256 + d) * 512 + eh * 256 + e) = run;
    }
}

__device__ __forceinline__ void phase_scan(const Params& p, LAS unsigned char* lds, int jl) {
    const int tid = opaque_tid(), lane_ = tid & 63, wid = __builtin_amdgcn_readfirstlane(tid >> 6);
    bf16_t* qkv = (bf16_t*)(p.ws + WS_QKV); const float* T = (const float*)(p.ws + WS_T);
    float* gss = (float*)(p.ws + WS_GSS) + (size_t)jl * NTOK * 8;
    for (int v_ = blockIdx.x; v_ < 384; v_ += gridDim.x) {
        const int v = (gridDim.x == 256) ? ((v_ & 256) | (((v_ & 255) >> 4) << 4) | ((v_ & 7) << 1) | ((v_ >> 3) & 1)) : v_;
        int eh, h, Lc, nch; size_t row0; float* Sout = nullptr;
        f32x16 S[8];
        if (v < 256) {
            eh = v & 1; const int seg = (v >> 1) & 15; h = (v >> 5) & 3; const int b = v >> 7;
            row0 = (size_t)b * SEQ + (size_t)seg * 1024; Lc = 64; nch = 16;
            {
                int lz = lane_; asm volatile("" : "+v"(lz)); const int hl_ = lz >> 5, ecol_ = wid * 32 + (lz & 31);
                const float* Tu = T + (size_t)v * 65536;
#pragma unroll
                for (int dt = 0; dt < 8; ++dt)
#pragma unroll
                    for (int r = 0; r < 16; ++r) S[dt][r] = Tu[(size_t)(32 * dt + (r & 3) + 8 * (r >> 2) + 4 * hl_) * 256 + ecol_];
            }
        } else {
            const int su = v - 256; eh = su & 1; h = (su >> 1) & 3; const int sb = su >> 3;
            row0 = (size_t)NP + (size_t)sb * 16; Lc = 16; nch = 1;
            Sout = p.out + OUT_RETS + ((size_t)((jl * 16 + sb) * 4 + h) * 256) * 512 + eh * 256;
            int lz = lane_; asm volatile("" : "+v"(lz)); const int hl_ = lz >> 5, ecol_ = wid * 32 + (lz & 31);
            const float* Sin = p.state_ret + ((size_t)((jl * 16 + sb) * 4 + h) * 256) * 512 + eh * 256;
#pragma unroll
            for (int dt = 0; dt < 8; ++dt)
#pragma unroll
                for (int r = 0; r < 16; ++r) S[dt][r] = Sin[(size_t)(32 * dt + (r & 3) + 8 * (r >> 2) + 4 * hl_) * 512 + ecol_];
        }
        const float lg = lg2gamma(h), gC = exp2f((float)Lc * lg), gCinv = exp2f(-(float)Lc * lg);
        bf16_t* qb = qkv + row0 * 4096 + h * 256; bf16_t* kb = qkv + row0 * 4096 + 1024 + h * 256; bf16_t* vb = qkv + row0 * 4096 + 2048 + h * 512 + eh * 256;
        u32x4 rq[4], rk[4], rv[4];
        tile_load(rq, qb, 4096, Lc, tid); tile_load(rk, kb, 4096, Lc, tid); tile_load(rv, vb, 4096, Lc, tid);
        LDS_BARRIER();
        tile_store(lds + IMG_Q, rq, tid); tile_store(lds + IMG_K, rk, tid); tile_store(lds + IMG_V, rv, tid);
        LDS_BARRIER();
        for (int c = 0; c < nch; ++c) {
            int lane = lane_; asm volatile("" : "+v"(lane)); const int hl = lane >> 5, ecol = wid * 32 + (lane & 31);
            {
                const int mi = wid >> 1, nj0 = 2 * (wid & 1), l15 = lane & 15, l4 = lane >> 4;
                f32x4 sc[2] = {(f32x4){0.f, 0.f, 0.f, 0.f}, (f32x4){0.f, 0.f, 0.f, 0.f}};
#pragma unroll
                for (int s = 0; s < 8; ++s) {
                    const bf16x8 a = *(const LAS bf16x8*)(lds + IMG_K + img_off(16 * mi + l15, 4 * s + l4));
#pragma unroll
                    for (int t = 0; t < 2; ++t) {
                        const bf16x8 bq = *(const LAS bf16x8*)(lds + IMG_Q + img_off(16 * (nj0 + t) + l15, 4 * s + l4));
                        sc[t] = __builtin_amdgcn_mfma_f32_16x16x32_bf16(a, bq, sc[t], 0, 0, 0);
                    }
                }
#pragma unroll
                for (int t = 0; t < 2; ++t) {
                    const int n = 16 * (nj0 + t) + l15, m0 = 16 * mi + 4 * l4;
                    float pv[4];
#pragma unroll
                    for (int r = 0; r < 4; ++r) pv[r] = (n >= m0 + r) ? sc[t][r] * gCinv : 0.f;
                    u32x2 w; w.x = cvt_pk_bf16(pv[0], pv[1]); w.y = cvt_pk_bf16(pv[2], pv[3]);
                    *(LAS u32x2*)(lds + IMG_P + n * 144 + m0 * 2) = w;
                }
            }
            LDS_BARRIER();
            f32x16 o[2];
#pragma unroll
            for (int nt = 0; nt < 2; ++nt)
#pragma unroll
                for (int r = 0; r < 16; ++r) o[nt][r] = 0.f;
#pragma unroll
            for (int s = 0; s < 16; ++s) {
                const bf16x8 bs = pack8(S[s >> 1], 8 * (s & 1));
#pragma unroll
                for (int nt = 0; nt < 2; ++nt) {
                    const unsigned rown = 32 * nt + (lane & 31);
                    const u32x2 lo = *(const LAS u32x2*)(lds + IMG_Q + img_off(rown, 2 * s) + 8 * hl);
                    const u32x2 hi = *(const LAS u32x2*)(lds + IMG_Q + img_off(rown, 2 * s + 1) + 8 * hl);
                    const u32x4 aw = (u32x4){lo.x, lo.y, hi.x, hi.y};
                    o[nt] = __builtin_amdgcn_mfma_f32_32x32x16_bf16(__builtin_bit_cast(bf16x8, aw), bs, o[nt], 0, 0, 0);
                }
            }
            bf16x8 Vf[4];
#pragma unroll
            for (int ks = 0; ks < 4; ++ks) Vf[ks] = tr_frag(lds + IMG_V, lane, wid, ks);
#pragma unroll
            for (int ks = 0; ks < 4; ++ks)
#pragma unroll
                for (int nt = 0; nt < 2; ++nt) {
                    const bf16x8 a = *(const LAS bf16x8*)(lds + IMG_P + (32 * nt + (lane & 31)) * 144 + (16 * ks + 8 * hl) * 2);
                    o[nt] = __builtin_amdgcn_mfma_f32_32x32x16_bf16(a, Vf[ks], o[nt], 0, 0, 0);
                }
            {
                LAS unsigned char* oi = lds + IMG_O + (4 * hl) * 528 + ecol * 2;
#pragma unroll
                for (int nt = 0; nt < 2; ++nt)
#pragma unroll
                    for (int r = 0; r < 16; ++r) *(LAS bf16_t*)(oi + (32 * nt + (r & 3) + 8 * (r >> 2)) * 528) = (bf16_t)cvt_pk_bf16(o[nt][r], o[nt][r]);
            }
            if (c + 1 < nch) { tile_load(rk, kb + (size_t)(c + 1) * 64 * 4096, 4096, 64, tid); tile_load(rv, vb + (size_t)(c + 1) * 64 * 4096, 4096, 64, tid); }
#pragma unroll
            for (int i = 0; i < 8; ++i) S[i] *= gC;
            {
                int lane2 = lane_; asm volatile("" : "+v"(lane2));
                bf16x8 Vg[4];
#pragma unroll
                for (int ks = 0; ks < 4; ++ks) Vg[ks] = tr_frag(lds + IMG_V, lane2, wid, ks);
                state_update(S, lds + IMG_K, Vg, lane2);
            }
            __builtin_amdgcn_sched_barrier(0);
            LDS_BARRIER();
            if (c + 1 < nch) { tile_load(rq, qb + (size_t)(c + 1) * 64 * 4096, 4096, 64, tid); tile_store(lds + IMG_K, rk, tid); tile_store(lds + IMG_V, rv, tid); tile_store(lds + IMG_Q, rq, tid); }
            {
                int t2 = tid; asm volatile("" : "+v"(t2));
                const int r0 = (t2 >> 5) & 15, ch = t2 & 31;
                bf16_t* og = vb + (size_t)c * 64 * 4096 + (size_t)r0 * 4096 + ch * 8;
#pragma unroll
                for (int i = 0; i < 4; ++i) {
                    if (i == 0 || Lc == 64) {
                        const u32x4 w = *(const LAS u32x4*)(lds + IMG_O + (r0 + 16 * i) * 528 + ch * 16);
                        *(u32x4*)(og + (size_t)(16 * i) * 4096) = w;
                        const float a0 = __uint_as_float(w.x << 16), a1 = __uint_as_float(w.x & 0xffff0000u), a2 = __uint_as_float(w.y << 16), a3 = __uint_as_float(w.y & 0xffff0000u);
                        const float a4 = __uint_as_float(w.z << 16), a5 = __uint_as_float(w.z & 0xffff0000u), a6 = __uint_as_float(w.w << 16), a7 = __uint_as_float(w.w & 0xffff0000u);
                        float ss = ((a0 * a0 + a1 * a1) + (a2 * a2 + a3 * a3)) + ((a4 * a4 + a5 * a5) + (a6 * a6 + a7 * a7));
                        ss += __shfl_xor(ss, 16); ss += __shfl_xor(ss, 8); ss += __shfl_xor(ss, 4); ss += __shfl_xor(ss, 2); ss += __shfl_xor(ss, 1);
                        if (ch == 0) gss[((row0 + (size_t)c * 64 + r0 + 16 * i) * 4 + h) * 2 + eh] = ss;
                    }
                }
            }
            LDS_BARRIER();
        }
        if (Sout) {
            int lz = lane_; asm volatile("" : "+v"(lz)); const int hl_ = lz >> 5, ecol_ = wid * 32 + (lz & 31);
#pragma unroll
            for (int dt = 0; dt < 8; ++dt)
#pragma unroll
                for (int r = 0; r < 16; ++r) Sout[(size_t)(32 * dt + (r & 3) + 8 * (r >> 2) + 4 * hl_) * 512 + ecol_] = S[dt][r];
        }
    }
}

struct PoolOrder : pg8::StaticOrder {
    __device__ __forceinline__ bool next(int i, Unit& u) const { const bool ok = pg8::StaticOrder::next(i, u); if (ok) u.kofs = u.pn * 256; return ok; }
};
template <class Epi>
__device__ __forceinline__ void run_gemm(LAS unsigned char* lds, const bf16_t* A, int lda, const bf16_t* Bt, int N, int K, const Epi& E, int M = NTOK) {
    pg8::Gemm g{A, Bt, M, N, K, lda, K}; pg8::StaticOrder S; S.init(M, N, (int)gridDim.x, (int)blockIdx.x);
    pg8::gemm_phase<Epi, pg8::StaticOrder, false>(lds, g, S, E, nullptr);
}

__device__ __forceinline__ void narrow_core(LAS unsigned char* lds, const bf16_t* ag, int lda, const bf16_t* bg0, const bf16_t* bg1, int K, f32x16& acc0, f32x16& acc1, int tid, int lane, int wid) {
    const int lr = tid >> 4, lc = tid & 15, hl = lane >> 5, l31 = lane & 31;
#pragma unroll
    for (int i = 0; i < 16; ++i) { acc0[i] = 0.f; acc1[i] = 0.f; }
    u32x4 ra0[8], rb0[2], ra1[8], rb1[2];
#define NR_LOAD(RA, RB, KO) do { int ko_ = (KO); asm volatile("" : "+s"(ko_)); const bf16_t* agp = ag + ko_; const bf16_t* b0p = bg0 + ko_; const bf16_t* b1p = bg1 + ko_; \
        _Pragma("unroll") for (int q = 0; q < 8; ++q) { RA[q] = *(const u32x4*)agp; agp += (size_t)32 * lda; } \
        RB[0] = *(const u32x4*)b0p; RB[1] = *(const u32x4*)b1p; } while (0)
#define NR_STORE(RA, RB) do { _Pragma("unroll") for (int q = 0; q < 8; ++q) *(LAS u32x4*)(lds + (q >> 1) * 16384 + offb((q & 1) * 32 + lr, lc)) = RA[q]; \
        *(LAS u32x4*)(lds + 65536 + offb(lr, lc)) = RB[0]; *(LAS u32x4*)(lds + 65536 + offb(32 + lr, lc)) = RB[1]; } while (0)
#define NR_COMPUTE() do { LAS unsigned char* ai = lds + (wid >> 1) * 16384; const unsigned arow = (wid & 1) * 32 + l31; \
        _Pragma("unroll") for (int q = 0; q < 8; ++q) { \
            const bf16x8 a = *(const LAS bf16x8*)(ai + offb(arow, 2 * q + hl)); \
            const bf16x8 x0 = *(const LAS bf16x8*)(lds + 65536 + offb(l31, 2 * q + hl)); \
            const bf16x8 x1 = *(const LAS bf16x8*)(lds + 65536 + offb(32 + l31, 2 * q + hl)); \
            acc0 = __builtin_amdgcn_mfma_f32_32x32x16_bf16(a, x0, acc0, 0, 0, 0); acc1 = __builtin_amdgcn_mfma_f32_32x32x16_bf16(a, x1, acc1, 0, 0, 0); } } while (0)
    NR_LOAD(ra0, rb0, 0); NR_LOAD(ra1, rb1, 128);
    LDS_BARRIER();
    for (int k = 0; k < K; k += 256) {
        NR_STORE(ra0, rb0); LDS_BARRIER();
        if (k + 256 < K) NR_LOAD(ra0, rb0, k + 256);
        NR_COMPUTE(); LDS_BARRIER();
        NR_STORE(ra1, rb1); LDS_BARRIER();
        if (k + 384 < K) NR_LOAD(ra1, rb1, k + 384);
        NR_COMPUTE(); LDS_BARRIER();
    }
#undef NR_LOAD
#undef NR_STORE
#undef NR_COMPUTE
}
__device__ __forceinline__ void narrow_scales(LAS unsigned char* lds, const float* rss, int tid) {
    if (tid < 256) ((LAS float*)(lds + 81920))[tid] = rs_row(rss + (size_t)(NP + tid) * 16);
}
__device__ __forceinline__ void narrow_ffn(LAS unsigned char* lds, const bf16_t* xb, const bf16_t* Wfi, bf16_t* act, const float* rss) {
    const int tid = opaque_tid(), lane = tid & 63, wid = __builtin_amdgcn_readfirstlane(tid >> 6), lr = tid >> 4, lc = tid & 15;
    for (int j = blockIdx.x; j < 88; j += gridDim.x) {
        const int jj = 32 * j + lr, dra = (jj >> 2) * 8 + (jj & 3);
        f32x16 acc0, acc1;
        __syncthreads(); narrow_scales(lds, rss, tid);
        narrow_core(lds, xb + (size_t)(NP + lr) * DM + lc * 8, DM, Wfi + (size_t)dra * DM + lc * 8, Wfi + (size_t)(dra + 4) * DM + lc * 8, DM, acc0, acc1, tid, lane, wid);
        int lz = lane; asm volatile("" : "+v"(lz)); const int hl = lz >> 5, l31 = lz & 31;
#pragma unroll
        for (int i = 0; i < 16; ++i) {
            const int rs = 32 * wid + (i & 3) + 8 * (i >> 2) + 4 * hl; const float r = ((const LAS float*)(lds + 81920))[rs];
            act[(size_t)(NP + rs) * DFF + 32 * j + l31] = f2bf(silu_f(acc0[i] * r) * (acc1[i] * r));
        }
    }
}
__device__ __forceinline__ void narrow_qkv(LAS unsigned char* lds, const bf16_t* xb, const bf16_t* Wri, bf16_t* qkv, const float* rss, const float* cosT, const float* sinT) {
    const int tid = opaque_tid(), lane = tid & 63, wid = __builtin_amdgcn_readfirstlane(tid >> 6), lr = tid >> 4, lc = tid & 15;
    for (int j = blockIdx.x; j < 64; j += gridDim.x) {
        const bool rot = j < 32; const int hd = j >> 2, j0 = (j & 3) * 32;
        const int cA = rot ? hd * 256 + j0 : 2048 + (j - 32) * 64, cB = rot ? cA + 128 : cA + 32;
        f32x16 acc0, acc1;
        __syncthreads(); narrow_scales(lds, rss, tid);
        narrow_core(lds, xb + (size_t)(NP + lr) * DM + lc * 8, DM, Wri + (size_t)(cA + lr) * DM + lc * 8, Wri + (size_t)(cB + lr) * DM + lc * 8, DM, acc0, acc1, tid, lane, wid);
        int lz = lane; asm volatile("" : "+v"(lz)); const int hl = lz >> 5, l31 = lz & 31;
        const float lg = lg2gamma(hd & 3);
        float cs[16], sn_[16];
        if (rot) {
#pragma unroll
            for (int i = 0; i < 16; ++i) { const int l = (32 * wid + (i & 3) + 8 * (i >> 2) + 4 * hl) & 15; cs[i] = cosT[(size_t)(1024 + l) * 128 + j0 + l31]; sn_[i] = sinT[(size_t)(1024 + l) * 128 + j0 + l31]; }
        }
#pragma unroll
        for (int i = 0; i < 16; ++i) {
            const int rs = 32 * wid + (i & 3) + 8 * (i >> 2) + 4 * hl; const float r = ((const LAS float*)(lds + 81920))[rs];
            bf16_t* op = qkv + (size_t)(NP + rs) * 4096;
            if (rot) {
                const int l = rs & 15; const float e = (hd < 4) ? (float)(l + 1) : (float)(15 - l);
                const float dec = exp2f(e * lg) * r, x1 = acc0[i] * dec, x2 = acc1[i] * dec;
                const float c = cs[i], sn = sn_[i];
                op[cA + l31] = f2bf(x1 * c - x2 * sn); op[cB + l31] = f2bf(x1 * sn + x2 * c);
            } else { op[cA + l31] = f2bf(acc0[i] * r); op[cB + l31] = f2bf(acc1[i] * r); }
        }
    }
}
__device__ __forceinline__ void narrow_gate(LAS unsigned char* lds, const bf16_t* xb, const bf16_t* Wg, bf16_t* qkv, const float* rss, const float* gss) {
    const int tid = opaque_tid(), lane = tid & 63, wid = __builtin_amdgcn_readfirstlane(tid >> 6), lr = tid >> 4, lc = tid & 15;
    for (int j = blockIdx.x; j < 32; j += gridDim.x) {
        const int cA = j * 64, head = j >> 3;
        f32x16 acc0, acc1;
        __syncthreads(); narrow_scales(lds, rss, tid);
        if (tid < 256) { const float2 gp = *(const float2*)(gss + ((size_t)(NP + tid) * 4 + head) * 2); ((LAS float*)(lds + 81920 + 1024))[tid] = __builtin_amdgcn_rsqf((gp.x + gp.y) * (1.0f / 512.0f) + EPS); }
        narrow_core(lds, xb + (size_t)(NP + lr) * DM + lc * 8, DM, Wg + (size_t)(cA + lr) * DM + lc * 8, Wg + (size_t)(cA + 32 + lr) * DM + lc * 8, DM, acc0, acc1, tid, lane, wid);
        int lz = lane; asm volatile("" : "+v"(lz)); const int hl = lz >> 5, l31 = lz & 31;
        unsigned short ob0[16], ob1[16];
#pragma unroll
        for (int i = 0; i < 16; ++i) { const bf16_t* op = qkv + (size_t)(NP + 32 * wid + (i & 3) + 8 * (i >> 2) + 4 * hl) * 4096 + 2048 + cA + l31; ob0[i] = op[0]; ob1[i] = op[32]; }
#pragma unroll
        for (int i = 0; i < 16; ++i) {
            const int rs = 32 * wid + (i & 3) + 8 * (i >> 2) + 4 * hl; const float r = ((const LAS float*)(lds + 81920))[rs], rn = ((const LAS float*)(lds + 81920 + 1024))[rs];
            bf16_t* op = qkv + (size_t)(NP + rs) * 4096 + 2048 + cA + l31;
            const float o0 = __uint_as_float(((unsigned)ob0[i]) << 16), o1 = __uint_as_float(((unsigned)ob1[i]) << 16);
            op[0] = f2bf(silu_f(acc0[i] * r) * o0 * rn); op[32] = f2bf(silu_f(acc1[i] * r) * o1 * rn);
        }
    }
}
__device__ __forceinline__ void narrow_res(LAS unsigned char* lds, const bf16_t* A, int lda, const bf16_t* Bt, int K, const EpiRes& E) {
    const int tid = opaque_tid(), lane = tid & 63, wid = __builtin_amdgcn_readfirstlane(tid >> 6), lr = tid >> 4, lc = tid & 15;
    for (int j = blockIdx.x; j < 16; j += gridDim.x) {
        const int pn = j >> 2, wc = j & 3, c0 = pn * 256 + wc * 32;
        f32x16 acc0, acc1;
        __syncthreads();
        narrow_core(lds, A + (size_t)(NP + lr) * lda + lc * 8, lda, Bt + (size_t)(c0 + lr) * K + lc * 8, Bt + (size_t)(c0 + 128 + lr) * K + lc * 8, K, acc0, acc1, tid, lane, wid);
        float sq[16];
        int lz = lane; asm volatile("" : "+v"(lz)); const int hl = lz >> 5, l31 = lz & 31;
        float bb0[16], bb1[16];
#pragma unroll
        for (int i = 0; i < 16; ++i) { const float* bp = E.base_s + (size_t)(32 * wid + (i & 3) + 8 * (i >> 2) + 4 * hl) * DM + c0 + l31; bb0[i] = bp[0]; bb1[i] = bp[128]; }
#pragma unroll
        for (int i = 0; i < 16; ++i) {
            const int rs = 32 * wid + (i & 3) + 8 * (i >> 2) + 4 * hl;
            const float v0 = bb0[i] + acc0[i], v1 = bb1[i] + acc1[i];
            float* xo = E.xres + (size_t)(NP + rs) * DM + c0 + l31; xo[0] = v0; xo[128] = v1;
            bf16_t* bo = E.xb + (size_t)(NP + rs) * DM + c0 + l31; bo[0] = f2bf(v0); bo[128] = f2bf(v1);
            sq[i] = v0 * v0 + v1 * v1;
        }
        float s8[8], s4[4], s2[2], s1;
        { const bool bit = (lane & 16) != 0;
#pragma unroll
          for (int i = 0; i < 8; ++i) { const float keep = bit ? sq[i + 8] : sq[i], send = bit ? sq[i] : sq[i + 8]; s8[i] = keep + __shfl_xor(send, 16); } }
        { const bool bit = (lane & 8) != 0;
#pragma unroll
          for (int i = 0; i < 4; ++i) { const float keep = bit ? s8[i + 4] : s8[i], send = bit ? s8[i] : s8[i + 4]; s4[i] = keep + __shfl_xor(send, 8); } }
        { const bool bit = (lane & 4) != 0;
#pragma unroll
          for (int i = 0; i < 2; ++i) { const float keep = bit ? s4[i + 2] : s4[i], send = bit ? s4[i] : s4[i + 2]; s2[i] = keep + __shfl_xor(send, 4); } }
        { const bool bit = (lane & 2) != 0; const float keep = bit ? s2[1] : s2[0], send = bit ? s2[0] : s2[1]; s1 = keep + __shfl_xor(send, 2); }
        s1 += __shfl_xor(s1, 1);
        const int idx = (lane >> 1) & 15, rs = 32 * wid + (idx & 3) + 8 * (idx >> 2) + 4 * hl;
        if ((lane & 1) == 0) E.rss_next[(size_t)(NP + rs) * 16 + pn * 4 + wc] = s1;
    }
}

__device__ __forceinline__ void run_phase(const Params& p_, LAS unsigned char* lds, int ph_) {
    const bool nonarrow = false; const int ph = ph_ >= 100 ? ph_ - 100 : ph_;
    Params p = p_; { size_t z0 = 0, z1 = 0; asm volatile("" : "+s"(z0), "+s"(z1)); p.ws = p_.ws + z0; p.out = p_.out + z1; }
    bf16_t* xb = (bf16_t*)(p.ws + WS_XB); bf16_t* qkv = (bf16_t*)(p.ws + WS_QKV); float* rss = (float*)(p.ws + WS_RSS); float* gss = (float*)(p.ws + WS_GSS);
    const bf16_t* Wri = (const bf16_t*)(p.ws + WS_WRI); const bf16_t* Wro = (const bf16_t*)(p.ws + WS_WRO); const bf16_t* Wpl = (const bf16_t*)(p.ws + WS_WPL);
    const bf16_t* Wfi = (const bf16_t*)(p.ws + WS_WFI); const bf16_t* Wfo = (const bf16_t*)(p.ws + WS_WFO);
    float* xres = p.out;
    if (ph == NPHASE - 1) { phase_final(p); return; }
    int layer, step;
    if (ph < 9) { layer = 0; step = ph - 1; } else if (ph < 13) { layer = 1; step = ph - 9; } else if (ph < 21) { layer = 2; step = ph - 13; } else { layer = 3; step = ph - 21; }
    const int jl = layer >> 1;
    const bool is_ret = (layer & 1) == 0;
    const int fstep = is_ret ? step - 6 : step - 2;
    if (step == 0 && layer >= 1) { convert_ffn(p, lds, layer); if (layer + 1 < 4) convert_mixer(p, lds, layer + 1); __syncthreads(); }
    if (fstep == 0) { EpiFfn E{qkv, rss + (size_t)(2 * layer + 1) * NTOK * 16}; run_gemm(lds, xb, 1024, Wfi, 5632, 1024, E, NP); if (!nonarrow) narrow_ffn(lds, xb, Wfi, qkv, rss + (size_t)(2 * layer + 1) * NTOK * 16); return; }
    if (fstep == 1) { EpiRes E{xres, xres + (size_t)NP * DM, xres, xb, rss + (size_t)(2 * layer + 2) * NTOK * 16}; run_gemm(lds, qkv, DFF, Wfo, 1024, DFF, E, NP); narrow_res(lds, qkv, DFF, Wfo, DFF, E); return; }
    if (is_ret) {
        if (step == 0) { EpiQKV E{qkv, rss + (size_t)(2 * layer) * NTOK * 16, (const float*)(p.ws + WS_COS), (const float*)(p.ws + WS_SIN)}; run_gemm(lds, xb, 1024, Wri, 4096, 1024, E, NP); if (!nonarrow) narrow_qkv(lds, xb, Wri, qkv, rss + (size_t)(2 * layer) * NTOK * 16, (const float*)(p.ws + WS_COS), (const float*)(p.ws + WS_SIN)); }
        else if (step == 1) phase_scan_local(p, lds);
        else if (step == 2) phase_scan_prefix(p, jl);
        else if (step == 3) phase_scan(p, lds, jl);
        else if (step == 4) { EpiGate E{qkv, rss + (size_t)(2 * layer) * NTOK * 16, gss + (size_t)jl * NTOK * 8}; run_gemm(lds, xb, 1024, Wri + (size_t)4096 * 1024, 2048, 1024, E, NP); narrow_gate(lds, xb, Wri + (size_t)4096 * 1024, qkv, rss + (size_t)(2 * layer) * NTOK * 16, gss + (size_t)jl * NTOK * 8); }
        else if (step == 5) {
            const float* bp = layer == 0 ? p.x_prompt : xres; const float* bs = layer == 0 ? p.x_sample : xres + (size_t)NP * DM;
            EpiRes E{bp, bs, xres, xb, rss + (size_t)(2 * layer + 1) * NTOK * 16};
            run_gemm(lds, qkv + 2048, 4096, Wro, 1024, 2048, E, NP); narrow_res(lds, qkv + 2048, 4096, Wro, 2048, E);
        }
    } else {
        if (step == 0) phase_pool_prep(p, lds, layer);
        else if (step == 1) { EpiRes E{xres, xres + (size_t)NP * DM, xres, xb, rss + (size_t)(2 * layer + 1) * NTOK * 16}; pg8::Gemm g{qkv, Wpl, NTOK, 1024, 256, 1024, 1024}; PoolOrder S; S.init(NTOK, 1024, (int)gridDim.x, (int)blockIdx.x);
            pg8::gemm_phase<EpiRes, PoolOrder, false>(lds, g, S, E, nullptr); }
    }
}

__global__ void __launch_bounds__(512) mega(Params p) {
    extern __shared__ __attribute__((aligned(16))) unsigned char lds_raw[];
    LAS unsigned char* lds = (LAS unsigned char*)lds_raw;
    volatile LAS unsigned* bst = (volatile LAS unsigned*)(lds + LDS_MAIN);
    if (threadIdx.x == 0) { bst[0] = 0u; bst[1] = 0u; }
    __syncthreads();
    const XcdBarrier gbar = xcd_barrier_post((unsigned*)(p.ws + WS_BAR), bst);
#define GRID_SYNC() xcd_barrier(gbar)
#ifdef MK_PRE_SYNCS
    for (int i = 0; i < MK_PRE_SYNCS; ++i) GRID_SYNC();
#endif
#ifdef MK_PRE_MASK
#define MK_PRE(PH) if ((MK_PRE_MASK >> PH) & 1) { if (PH == 0) phase0(p, lds); else run_phase(p, lds, PH); GRID_SYNC(); }
    MK_PRE(0) MK_PRE(1) MK_PRE(2) MK_PRE(3) MK_PRE(4) MK_PRE(5) MK_PRE(6) MK_PRE(7) MK_PRE(8) MK_PRE(9) MK_PRE(10) MK_PRE(11) MK_PRE(12) MK_PRE(25)
#endif
    int ph = p.ph_lo;
    if (p.ph_hi < 0) cg::this_grid().sync();
    if (ph == 0) { phase0(p, lds); ++ph; if (ph < p.ph_hi) { GRID_SYNC(); } }
#ifdef MK_PRE_PH
    ph = 1 - MK_PRE_REP;
#endif
    for (; ph < p.ph_hi; ++ph) {
#ifdef MK_PRE_PH
        const int phx = (ph < 1) ? MK_PRE_PH + 100 : ph;
#else
        const int phx = ph;
#endif
        run_phase(p, lds, phx);
        if (ph + 1 < p.ph_hi) { GRID_SYNC(); }
    }
}
}

#ifndef MK_SINGLE
#define MK_SINGLE 1
#endif
extern "C" void kernel_launch(void* const* d_in, const int* in_sizes, int n_in, void* d_out, int out_size, void* d_ws, size_t ws_size, hipStream_t stream) {
    static int grid = 0;
    constexpr int LDS_BYTES = mk::LDS_TOTAL;
    if (grid == 0) {
        int dev = 0, cus = 0, per_cu = 0;
        hipGetDevice(&dev); hipDeviceGetAttribute(&cus, hipDeviceAttributeMultiprocessorCount, dev);
        if (hipFuncSetAttribute((const void*)mk::mega, hipFuncAttributeMaxDynamicSharedMemorySize, LDS_BYTES) != hipSuccess) { fprintf(stderr, "hipFuncSetAttribute failed\n"); }
        if (hipOccupancyMaxActiveBlocksPerMultiprocessor(&per_cu, (const void*)mk::mega, 512, LDS_BYTES) != hipSuccess || per_cu < 1) { fprintf(stderr, "occupancy query: %d\n", per_cu); per_cu = 1; }
        (void)hipGetLastError();
        grid = cus * (per_cu < 1 ? 1 : per_cu);
        if (grid <= 0) grid = 256;
    }
    if (ws_size < mk::WS_END) { fprintf(stderr, "workspace too small: %zu < %zu\n", ws_size, (size_t)mk::WS_END); return; }
    mk::Params p{};
    p.x_prompt = (const float*)d_in[0]; p.x_sample = (const float*)d_in[1]; p.state_ret = (const float*)d_in[2]; p.state_pool = (const float*)d_in[3];
    p.norm_mix = (const float*)d_in[4]; p.w_ret_in = (const float*)d_in[5]; p.w_ret_out = (const float*)d_in[6]; p.w_pool = (const float*)d_in[7];
    p.pool_scale = (const float*)d_in[8]; p.norm_ffn = (const float*)d_in[9]; p.w_ffn_in = (const float*)d_in[10]; p.w_ffn_out = (const float*)d_in[11]; p.norm_final = (const float*)d_in[12];
    p.out = (float*)d_out; p.ws = (unsigned char*)d_ws;
#if MK_SINGLE
    hipMemsetAsync((unsigned char*)d_ws + mk::WS_BAR, 0, XCD_BAR_WORDS * 4, stream);
    p.ph_lo = 0; p.ph_hi = mk::NPHASE;
    void* args[] = {&p};
    hipError_t e = hipLaunchCooperativeKernel((const void*)mk::mega, dim3(grid), dim3(512), args, LDS_BYTES, stream);
    if (e != hipSuccess) fprintf(stderr, "cooperative launch failed: %s (grid %d)\n", hipGetErrorString(e), grid);
#else
#ifndef MK_STOP
#define MK_STOP 23
#endif
    for (int ph = 0; ph < mk::NPHASE; ++ph) {
        p.ph_lo = ph; p.ph_hi = ph + 1;
        hipLaunchKernelGGL(mk::mega, dim3(grid), dim3(512), LDS_BYTES, stream, p);
    }
#endif
}
```

```cpp
#include <hip/hip_runtime.h>
#include <hip/hip_cooperative_groups.h>
#include <cstdio>
namespace cg = cooperative_groups;
#define LDS_BARRIER() asm volatile("s_waitcnt lgkmcnt(0)\n\ts_barrier" ::: "memory")
__device__ __forceinline__ int opaque_tid() { int t = (int)threadIdx.x; asm volatile("" : "+v"(t)); return t; }
namespace pg8 {
#define PG8_LAS __attribute__((address_space(3)))
typedef unsigned short bf16_t;
typedef short bf16x8 __attribute__((ext_vector_type(8)));
typedef float f32x4 __attribute__((ext_vector_type(4)));
typedef unsigned u32x4 __attribute__((ext_vector_type(4)));
constexpr int BM = 256, BK = 64, HALF = 128, HTB = HALF * BK * 2  , STAGE_BYTES = 8 * HTB, NXCD = 8, WGM = 8;

__host__ __device__ __forceinline__ int lds_byte(int r, int c) { const int st = (r >> 4) * 2 + (c >> 5), rr = r & 15, cc = c & 31, ob = rr * 64 + cc * 2; return st * 1024 + (ob ^ (((ob >> 9) & 1) << 5)); }
__host__ __device__ __forceinline__ void stage_rc(int b, int& R, int& C) { const int st = b / 1024, sb = b % 1024, swz = sb ^ (((sb >> 9) & 1) << 5); R = (st >> 1) * 16 + swz / 64; C = (st & 1) * 32 + (swz % 64) / 2; }
__host__ __device__ __forceinline__ int perm32(int rho) { const int n = rho >> 4, i = rho & 15; return 8 * (i >> 2) + 4 * n + (i & 3); }

struct Unit { int pm, pn, kofs; };
struct Gemm { const bf16_t* A; const bf16_t* Bt; int M, N, K, lda, ldb; };

struct StaticOrder {
    int nM, nN, nwg, G, c;
    __host__ __device__ void init(int M, int N, int G_, int c_) { nM = M / BM; nN = N / BM; nwg = nM * nN; G = G_; c = c_; }
    __host__ __device__ bool next(int i, Unit& u) const {
        const long L = (long)i * G + c; if (L >= nwg) return false;
        int wgid = (int)L; { const int q = nwg / NXCD, r = nwg % NXCD, xcd = wgid % NXCD, off = wgid / NXCD; wgid = (xcd < r ? xcd * (q + 1) : r * (q + 1) + (xcd - r) * q) + off; }
        const int nig = WGM * nN, gid = wgid / nig, fm = gid * WGM, gsz = (nM - fm) < WGM ? (nM - fm) : WGM;
        u.pm = fm + ((wgid % nig) % gsz); u.pn = (wgid % nig) / gsz; u.kofs = 0; return true;
    }
    __device__ __forceinline__ void a_ready(const Unit&) const {}
    __device__ __forceinline__ void done(const Unit&) const {}
};
struct CountedOrder : StaticOrder {
    const unsigned* ready; unsigned need; unsigned* tmo;
    __device__ __forceinline__ void a_ready(const Unit& u) const {
        if (threadIdx.x < 64) {
            const unsigned long long t0 = __builtin_amdgcn_s_memrealtime(); unsigned polls = 0;
            while ((unsigned)__builtin_amdgcn_readfirstlane(__hip_atomic_load(ready + 64 * u.pm, __ATOMIC_RELAXED, __HIP_MEMORY_SCOPE_AGENT)) < need) {
                if ((++polls & 255u) == 0u && __builtin_amdgcn_readfirstlane(__hip_atomic_load(tmo, __ATOMIC_RELAXED, __HIP_MEMORY_SCOPE_AGENT)) != 0u) break;
                if (__builtin_amdgcn_s_memrealtime() - t0 > 2000000ull) {
                    if (threadIdx.x == 0) { unsigned expect = 0u; __hip_atomic_compare_exchange_strong(tmo + 1, &expect, 0x600u | (unsigned)(u.pm & 0xff), __ATOMIC_RELAXED, __ATOMIC_RELAXED, __HIP_MEMORY_SCOPE_AGENT); __hip_atomic_store(tmo, 1u, __ATOMIC_RELAXED, __HIP_MEMORY_SCOPE_AGENT); }
                    break; }
                __builtin_amdgcn_s_sleep(2); }
            __builtin_amdgcn_fence(__ATOMIC_ACQUIRE, "agent");
            asm volatile("s_waitcnt vmcnt(0)" ::: "memory");
        }
#if !defined(BROKEN_HOOK_NO_BARRIER)
        asm volatile("" ::: "memory"); __builtin_amdgcn_s_barrier(); asm volatile("" ::: "memory");
#endif
    }
};

__device__ __forceinline__ unsigned cvt_pk_bf16(float lo, float hi) { unsigned r; asm volatile("v_cvt_pk_bf16_f32 %0, %1, %2" : "=v"(r) : "v"(lo), "v"(hi)); return r; }
typedef float f32x2 __attribute__((ext_vector_type(2)));
__device__ __forceinline__ f32x2 gelu_pk(f32x2 v) {
    const f32x2 av = __builtin_elementwise_abs(v), d = av * 0.2316418882f + 1.0f;
    f32x2 t; t.x = __builtin_amdgcn_rcpf(d.x); t.y = __builtin_amdgcn_rcpf(d.y);
    f32x2 q = t * 0.5307027145f + (-0.7265760135f); q = q * t + 0.7107068705f; q = q * t + (-0.142248368f); q = q * t + 0.127414796f; q = q * t;
    const f32x2 s = (v * v) * (-0.72134752044f);
    f32x2 e; e.x = __builtin_amdgcn_exp2f(s.x); e.y = __builtin_amdgcn_exp2f(s.y);
    const f32x2 m = v * (q * e), r = v - m;
    f32x2 o; o.x = v.x < 0.f ? m.x : r.x; o.y = v.y < 0.f ? m.y : r.y; return o;
}

struct EpiF32 {
    static constexpr bool PERM = false, AFTER_DRAIN = false;
    float* C; int ldc; const float* bias;
    __device__ __forceinline__ void operator()(const f32x4 (&acc)[2][2][4][2], const Unit& u, int wr, int wc, int fr_, int fq_) const {
        const int tl_ = opaque_tid(), fr = tl_ & 15, fq = (tl_ >> 4) & 3; (void)fr_; (void)fq_;
        const int row0 = u.pm * BM + wr * 64 + fr, col0 = u.pn * BM + wc * 32 + 4 * fq;
        f32x4 bv[2][2];
#pragma unroll
        for (int bj = 0; bj < 2; ++bj)
#pragma unroll
            for (int n = 0; n < 2; ++n) bv[bj][n] = bias ? *(const f32x4*)(bias + col0 + bj * HALF + n * 16) : (f32x4){0.f, 0.f, 0.f, 0.f};
#pragma unroll
        for (int ai = 0; ai < 2; ++ai)
#pragma unroll
            for (int m = 0; m < 4; ++m) { float* rowp = C + (size_t)(row0 + ai * HALF + m * 16) * ldc + col0;
#pragma unroll
                for (int bj = 0; bj < 2; ++bj)
#pragma unroll
                    for (int n = 0; n < 2; ++n) *(f32x4*)(rowp + bj * HALF + n * 16) = acc[ai][bj][m][n] + bv[bj][n]; }
    }
};
template <int ACT  > struct EpiBf16 {
    static constexpr bool PERM = true, AFTER_DRAIN = false;
    bf16_t* O; int ldc; const float* bias; int split_cols; size_t split_stride;
    __device__ __forceinline__ void operator()(const f32x4 (&acc)[2][2][4][2], const Unit& u, int wr, int wc, int fr_, int fq_) const {
        const int tl_ = opaque_tid(), fr = tl_ & 15, fq = (tl_ >> 4) & 3; (void)fr_; (void)fq_;
        const int row0 = u.pm * BM + wr * 64 + fr; int colt = u.pn * BM; bf16_t* base = O;
        if (split_cols) { const int t = colt / split_cols; base += (size_t)t * split_stride; colt -= t * split_cols; }
        const int col0 = colt + wc * 32 + 8 * fq, bcol0 = u.pn * BM + wc * 32 + 8 * fq;
        f32x4 bv[2][2];
#pragma unroll
        for (int bj = 0; bj < 2; ++bj)
#pragma unroll
            for (int n = 0; n < 2; ++n) bv[bj][n] = bias ? *(const f32x4*)(bias + bcol0 + bj * HALF + 4 * n) : (f32x4){0.f, 0.f, 0.f, 0.f};
#pragma unroll
        for (int ai = 0; ai < 2; ++ai)
#pragma unroll
            for (int m = 0; m < 4; ++m) { bf16_t* rowp = base + (size_t)(row0 + ai * HALF + m * 16) * ldc + col0;
#pragma unroll
                for (int bj = 0; bj < 2; ++bj) { f32x4 v0 = acc[ai][bj][m][0] + bv[bj][0], v1 = acc[ai][bj][m][1] + bv[bj][1];
                    if (ACT == 1) { f32x2 a = gelu_pk((f32x2){v0[0], v0[1]}), b = gelu_pk((f32x2){v0[2], v0[3]}), c = gelu_pk((f32x2){v1[0], v1[1]}), d = gelu_pk((f32x2){v1[2], v1[3]});
                        v0 = (f32x4){a.x, a.y, b.x, b.y}; v1 = (f32x4){c.x, c.y, d.x, d.y}; }
                    if (ACT == 2) {
#pragma unroll
                        for (int j = 0; j < 4; ++j) { v0[j] = 0.5f * v0[j] * (1.0f + erff(v0[j] * 0.70710678f)); v1[j] = 0.5f * v1[j] * (1.0f + erff(v1[j] * 0.70710678f)); } }
                    u32x4 w; w.x = cvt_pk_bf16(v0[0], v0[1]); w.y = cvt_pk_bf16(v0[2], v0[3]); w.z = cvt_pk_bf16(v1[0], v1[1]); w.w = cvt_pk_bf16(v1[2], v1[3]);
                    *(u32x4*)(rowp + bj * HALF) = w; } }
    }
};

template <class Epi, class Sched, bool STAMP = false>
__device__ __forceinline__ void gemm_phase(PG8_LAS unsigned char* lds, const Gemm g, const Sched& S, const Epi& E, unsigned long long* stamps) {
    const int tid = opaque_tid(), wid = __builtin_amdgcn_readfirstlane(tid >> 6), lane = tid & 63, wr = wid >> 2, wc = wid & 3, fr = lane & 15, fq = lane >> 4;
    const int K = g.K, nt = K / BK, lda = g.lda, ldb = g.ldb;
    int ts_lo = 0, ts_hi = 0, nts = 0; const unsigned long long rt_entry = STAMP ? (unsigned long long)wall_clock64() : 0ull;
#define PG8_STAMP() do { if (STAMP && wid == 0 && nts < 64) { const unsigned long long _c = (unsigned long long)clock64(); \
        ts_lo = (lane == nts) ? (int)(unsigned)_c : ts_lo; ts_hi = (lane == nts) ? (int)(unsigned)(_c >> 32) : ts_hi; ++nts; } } while (0)
    PG8_STAMP();
    unsigned voffA[2], voffB[2];
#pragma unroll
    for (int i = 0; i < 2; ++i) { int R, C; stage_rc(tid * 16 + i * 8192, R, C); const int Rb = Epi::PERM ? ((R & ~31) + perm32(R & 31)) : R;
        voffA[i] = (unsigned)(R * lda + C) * 2u; voffB[i] = (unsigned)(Rb * ldb + C) * 2u; }
    const size_t kstep = (size_t)(BK * 2);
    const size_t hstep = (size_t)HALF * ldb * 2;
    const size_t tstep = 2 * hstep; const size_t hstepA = (size_t)HALF * lda * 2, tstepA = 2 * hstepA;
    const unsigned ldsw = (unsigned)wid * 1024u;
    const int aoff = lds_byte(wr * 64 + fr, fq * 8), boff = lds_byte(wc * 32 + fr, fq * 8);
#define PG8_SA(b, h) (((b) * 2 + (h)) * HTB)
#define PG8_SB(b, h) ((4 + (b) * 2 + (h)) * HTB)
#define PG8_STAGE(bufoff, gbase, voff) do { _Pragma("unroll") for (int _i = 0; _i < 2; ++_i) \
        __builtin_amdgcn_global_load_lds((const unsigned*)((const char*)(gbase) + (voff)[_i]), (PG8_LAS unsigned*)(lds + (bufoff) + ldsw + _i * 8192), 16, 0, 0); } while (0)
#define PG8_LDA(dst, b, h) do { _Pragma("unroll") for (int m = 0; m < 4; ++m) _Pragma("unroll") for (int k = 0; k < 2; ++k) dst[m][k] = *(const PG8_LAS bf16x8*)(lds + PG8_SA(b, h) + aoff + m * 2048 + k * 1024); } while (0)
#define PG8_LDB(dst, b, h) do { _Pragma("unroll") for (int n = 0; n < 2; ++n) _Pragma("unroll") for (int k = 0; k < 2; ++k) dst[n][k] = *(const PG8_LAS bf16x8*)(lds + PG8_SB(b, h) + boff + n * 2048 + k * 1024); } while (0)
#define PG8_MMA(ai, bj, At, Bt) do { __builtin_amdgcn_s_setprio(1); _Pragma("unroll") for (int m = 0; m < 4; ++m) _Pragma("unroll") for (int n = 0; n < 2; ++n) _Pragma("unroll") for (int k = 0; k < 2; ++k) \
        acc[ai][bj][m][n] = __builtin_amdgcn_mfma_f32_16x16x32_bf16(Bt[n][k], At[m][k], acc[ai][bj][m][n], 0, 0, 0); __builtin_amdgcn_s_setprio(0); } while (0)
#define PG8_WAIT_V(n) asm volatile("s_waitcnt vmcnt(" #n ")" ::: "memory")
#define PG8_WAIT_L(n) asm volatile("s_waitcnt lgkmcnt(" #n ")" ::: "memory")
#define PG8_BAR __builtin_amdgcn_s_barrier()
#define PG8_SCHED __builtin_amdgcn_sched_barrier(0)
    Unit cur, nxt; int ui = 0;
    if (!S.next(0, cur)) return;
    f32x4 acc[2][2][4][2];
#pragma unroll
    for (int a = 0; a < 2; ++a)
#pragma unroll
        for (int b = 0; b < 2; ++b)
#pragma unroll
            for (int m = 0; m < 4; ++m)
#pragma unroll
                for (int n = 0; n < 2; ++n) acc[a][b][m][n] = (f32x4){0.f, 0.f, 0.f, 0.f};
    bf16x8 At[4][2], B0[2][2], B1[2][2];
    const char* cA = (const char*)g.A + (size_t)cur.pm * tstepA + (size_t)cur.kofs * 2; const char* cB = (const char*)g.Bt + (size_t)cur.pn * tstep + (size_t)cur.kofs * 2;
    S.a_ready(cur);
    PG8_STAGE(PG8_SB(0, 0), cB, voffB); PG8_STAGE(PG8_SA(0, 0), cA, voffA); PG8_STAGE(PG8_SB(0, 1), cB + hstep, voffB); PG8_STAGE(PG8_SA(0, 1), cA + hstepA, voffA);
    if (wr == 1) PG8_BAR;
    PG8_WAIT_V(4); PG8_BAR;
    PG8_STAGE(PG8_SB(1, 0), cB + kstep, voffB); PG8_STAGE(PG8_SA(1, 0), cA + kstep, voffA); PG8_STAGE(PG8_SB(1, 1), cB + hstep + kstep, voffB);
    PG8_WAIT_V(6); PG8_BAR;
    PG8_STAMP();
    for (;;) {
        const bool has_next = S.next(ui + 1, nxt);
        const char* nA = has_next ? (const char*)g.A + (size_t)nxt.pm * tstepA + (size_t)nxt.kofs * 2 : cA; const char* nB = has_next ? (const char*)g.Bt + (size_t)nxt.pn * tstep + (size_t)nxt.kofs * 2 : cB;
        for (int t = 0; t < nt; t += 2) {
            const bool last = (t == nt - 2);
            const char* a1 = cA + (size_t)(t + 1) * kstep;
            const char* a2 = last ? nA : cA + (size_t)(t + 2) * kstep; const char* b2 = last ? nB : cB + (size_t)(t + 2) * kstep;
            const char* a3 = a2 + kstep; const char* b3 = b2 + kstep;
            if (last && has_next) S.a_ready(nxt);
            PG8_LDB(B0, 0, 0); PG8_SCHED; PG8_LDA(At, 0, 0); PG8_STAGE(PG8_SA(1, 1), a1 + hstepA, voffA);
            PG8_WAIT_L(8); PG8_BAR; PG8_WAIT_L(0); PG8_MMA(0, 0, At, B0); PG8_BAR; PG8_SCHED;
            PG8_LDB(B1, 0, 1); PG8_STAGE(PG8_SB(0, 0), b2, voffB);
            PG8_BAR; PG8_WAIT_L(0); PG8_MMA(0, 1, At, B1); PG8_BAR;
            PG8_LDA(At, 0, 1); PG8_STAGE(PG8_SA(0, 0), a2, voffA);
            PG8_BAR; PG8_WAIT_L(0); PG8_MMA(1, 0, At, B0); PG8_BAR; PG8_SCHED;
            PG8_STAGE(PG8_SB(0, 1), b2 + hstep, voffB);
            PG8_WAIT_V(6); PG8_BAR; PG8_MMA(1, 1, At, B1); PG8_BAR;
            PG8_LDB(B0, 1, 0); PG8_SCHED; PG8_LDA(At, 1, 0); PG8_STAGE(PG8_SA(0, 1), a2 + hstepA, voffA);
            PG8_WAIT_L(8); PG8_BAR; PG8_WAIT_L(0); PG8_MMA(0, 0, At, B0); PG8_BAR; PG8_SCHED;
            PG8_LDB(B1, 1, 1); PG8_STAGE(PG8_SB(1, 0), b3, voffB);
            PG8_BAR; PG8_WAIT_L(0); PG8_MMA(0, 1, At, B1); PG8_BAR;
            PG8_LDA(At, 1, 1); PG8_STAGE(PG8_SA(1, 0), a3, voffA);
            PG8_BAR; PG8_WAIT_L(0); PG8_MMA(1, 0, At, B0); PG8_BAR; PG8_SCHED;
            PG8_STAGE(PG8_SB(1, 1), b3 + hstep, voffB);
            PG8_WAIT_V(6); PG8_BAR; PG8_MMA(1, 1, At, B1); PG8_BAR;
        }
        PG8_STAMP();
        if constexpr (!Epi::AFTER_DRAIN) { E(acc, cur, wr, wc, fr, fq); S.done(cur); }
        PG8_STAMP();
        if (!has_next) break;
#pragma unroll
        for (int a = 0; a < 2; ++a)
#pragma unroll
            for (int b = 0; b < 2; ++b)
#pragma unroll
                for (int m = 0; m < 4; ++m)
#pragma unroll
                    for (int n = 0; n < 2; ++n) acc[a][b][m][n] = (f32x4){0.f, 0.f, 0.f, 0.f};
        cur = nxt; cA = nA; cB = nB; ++ui;
    }
    PG8_WAIT_V(0);
    if (wr == 0) PG8_BAR;
    PG8_BAR;
    if constexpr (Epi::AFTER_DRAIN) { E.fused(acc, cur, wr, wc, fr, fq, lds, wid, lane); S.done(cur); }
    PG8_STAMP();
    if (STAMP && wid == 0) { stamps[lane] = lane < nts ? (((unsigned long long)(unsigned)ts_hi << 32) | (unsigned)ts_lo) : 0ull;
        if (lane == 62) stamps[62] = rt_entry; if (lane == 63) stamps[63] = (unsigned long long)wall_clock64(); }
#undef PG8_STAMP
#undef PG8_SA
#undef PG8_SB
#undef PG8_STAGE
#undef PG8_LDA
#undef PG8_LDB
#undef PG8_MMA
#undef PG8_WAIT_V
#undef PG8_WAIT_L
#undef PG8_BAR
#undef PG8_SCHED
}
}

#define XB_TMO      128
#define XB_XCNT(j)  (256  + 64 * (j))
#define XB_XSUB(j)  (1280 + 64 * (j))
#define XB_XGEN(j)  (2304 + 64 * (j))
#define XB_TOP      3328
#define XB_TOPGEN   3392
#define XCD_BAR_WORDS 3456
#define XB_SPIN_CAP (1u << 18)
#define LAS __attribute__((address_space(3)))

__device__ __forceinline__ unsigned xb_ld(unsigned* p)              { return __hip_atomic_load(p, __ATOMIC_RELAXED, __HIP_MEMORY_SCOPE_AGENT); }
__device__ __forceinline__ unsigned xb_add(unsigned* p, unsigned v) { return __hip_atomic_fetch_add(p, v, __ATOMIC_RELAXED, __HIP_MEMORY_SCOPE_AGENT); }
__device__ __forceinline__ unsigned xb_xcc_id() { return (unsigned)__builtin_amdgcn_s_getreg((3 << 11) | 20) & 0xFu; }
#define XB_SPIN(cond, bar) do { unsigned _sp = 0; while (cond) { __builtin_amdgcn_s_sleep(1); \
    if ((++_sp & 255u) == 0u) { if (xb_ld(&(bar)[XB_TMO])) break; if (_sp > XB_SPIN_CAP) { atomicAdd(&(bar)[XB_TMO], 1u); break; } } } } while (0)

struct XcdBarrier {
    unsigned* bar; unsigned x;
    volatile LAS unsigned* st;
};

__device__ __forceinline__ XcdBarrier xcd_barrier_post(unsigned* bar, volatile LAS unsigned* st) {
    XcdBarrier b; b.bar = bar; b.x = xb_xcc_id(); b.st = st;
    if (threadIdx.x == 0) (void)xb_add(&bar[XB_XCNT(b.x)], 1u);
    return b;
}
__device__ __forceinline__ void xcd_barrier_complete(unsigned* bar, unsigned x, unsigned& nloc, unsigned& nx) {
    const unsigned G = gridDim.x * gridDim.y * gridDim.z;
    unsigned sum, cnt, mine, sp = 0u;
    for (;;) {
        sum = 0u; cnt = 0u; mine = 0u;
#pragma unroll
        for (unsigned j = 0; j < 16; ++j) { const unsigned c = xb_ld(&bar[XB_XCNT(j)]); sum += c; cnt += (c > 0u) ? 1u : 0u; mine = (j == x) ? c : mine; }
        if (sum == G) break;
        __builtin_amdgcn_s_sleep(1);
        if ((++sp & 255u) == 0u) { if (xb_ld(&bar[XB_TMO])) break; if (sp > XB_SPIN_CAP) { atomicAdd(&bar[XB_TMO], 1u); break; } }
    }
    nloc = mine > 0u ? mine : 1u; nx = cnt > 0u ? cnt : 1u;
}

__device__ __forceinline__ void xcd_barrier(const XcdBarrier& b) {
    asm volatile("s_waitcnt vmcnt(0)" ::: "memory");
    __syncthreads();
    if (threadIdx.x == 0) {
        unsigned* bar = b.bar;
        __builtin_amdgcn_s_waitcnt(0);
        unsigned nloc = b.st[0], nx = b.st[1];
        if (nloc == 0u) { xcd_barrier_complete(bar, b.x, nloc, nx); b.st[0] = nloc; b.st[1] = nx; }
        const unsigned old = xb_add(&bar[XB_XSUB(b.x)], 1u);
        const unsigned gen = old / nloc;
        if (old + 1u == (gen + 1u) * nloc) {
            __builtin_amdgcn_fence(__ATOMIC_RELEASE, "agent");
            asm volatile("s_waitcnt vmcnt(0)" ::: "memory");
            const unsigned og = xb_add(&bar[XB_TOP], 1u);
            const unsigned tg = og / nx;
            if (og + 1u == (tg + 1u) * nx) xb_add(&bar[XB_TOPGEN], 1u);
            else XB_SPIN(xb_ld(&bar[XB_TOPGEN]) == tg, bar);
            __builtin_amdgcn_fence(__ATOMIC_ACQUIRE, "agent");
            xb_add(&bar[XB_XGEN(b.x)], 1u);
            asm volatile("s_waitcnt vmcnt(0)" ::: "memory");
        } else {
            XB_SPIN(xb_ld(&bar[XB_XGEN(b.x)]) == gen, bar);
            __builtin_amdgcn_fence(__ATOMIC_ACQUIRE, "agent");
            asm volatile("s_waitcnt vmcnt(0)" ::: "memory");
        }
    }
    __syncthreads();
}

namespace mk {
using pg8::bf16_t; using pg8::bf16x8; using pg8::f32x4; using pg8::u32x4; using pg8::Unit; using pg8::cvt_pk_bf16;
typedef float f32x16 __attribute__((ext_vector_type(16)));
typedef short s16x4 __attribute__((ext_vector_type(4)));
typedef unsigned u32x2 __attribute__((ext_vector_type(2)));

constexpr int NTOK = 33024, NP = 32768, DM = 1024, SEQ = 16384, DFF = 2816;
constexpr float EPS = 1e-6f;
constexpr int NPHASE = 26;
constexpr int LDS_MAIN = 141312, LDS_TOTAL = LDS_MAIN + 16;
constexpr size_t OUT_RETP = 33816576, OUT_RETS = 35913728, OUT_POOLP = 52690944, OUT_POOLS = 52752384;
constexpr size_t WS_WRI = 0, WS_WRO = 12582912, WS_WPL = 16777216, WS_WFI = 18874368, WS_WFO = 30408704, WS_XB = 36175872,
                 WS_QKV = 103809024, WS_T = 374341632, WS_COS = 441450496, WS_SIN = 449839104, WS_RSS = 458227712, WS_GSS = 477249536, WS_BAR = 494157824, WS_END = 494174208;

struct Params {
    const float *x_prompt, *x_sample, *state_ret, *state_pool, *norm_mix, *w_ret_in, *w_ret_out, *w_pool, *pool_scale, *norm_ffn, *w_ffn_in, *w_ffn_out, *norm_final;
    float* out; unsigned char* ws; int ph_lo, ph_hi;
};

__device__ __forceinline__ float lg2gamma(int h) { return h == 0 ? -0.04580368961312479f : h == 1 ? -0.02272007650008353f : h == 2 ? -0.011315313227834146f : -0.005646563141142063f; }
__device__ __forceinline__ float sum16(const float* p) {
    const float4 a = *(const float4*)p, b = *(const float4*)(p + 4), c = *(const float4*)(p + 8), d = *(const float4*)(p + 12);
    return (((a.x + a.y) + (a.z + a.w)) + ((b.x + b.y) + (b.z + b.w))) + (((c.x + c.y) + (c.z + c.w)) + ((d.x + d.y) + (d.z + d.w)));
}
__device__ __forceinline__ float rs_row(const float* rssrow) { return __builtin_amdgcn_rsqf(sum16(rssrow) * (1.0f / 1024.0f) + EPS); }
__device__ __forceinline__ float silu_f(float v) { return v * __builtin_amdgcn_rcpf(1.0f + __builtin_amdgcn_exp2f(v * -1.4426950408889634f)); }
__device__ __forceinline__ bf16_t f2bf(float f) { unsigned u = __float_as_uint(f); u += 0x7FFFu + ((u >> 16) & 1u); return (bf16_t)(u >> 16); }
__device__ __forceinline__ float bf2f(unsigned short b) { return __uint_as_float(((unsigned)b) << 16); }

__device__ __forceinline__ void row_scales(float (&r)[8], const float* rss, int row0, int fq) {
    float4 q[8];
#pragma unroll
    for (int i = 0; i < 8; ++i) q[i] = *(const float4*)(rss + (size_t)(row0 + (i >> 2) * 128 + (i & 3) * 16) * 16 + fq * 4);
#pragma unroll
    for (int i = 0; i < 8; ++i) { float t = (q[i].x + q[i].y) + (q[i].z + q[i].w); t += __shfl_xor(t, 16); t += __shfl_xor(t, 32); r[i] = __builtin_amdgcn_rsqf(t * (1.0f / 1024.0f) + EPS); }
}
struct EpiQKV {
    static constexpr bool PERM = true, AFTER_DRAIN = false;
    bf16_t* O; const float* rss; const float* cosT; const float* sinT;
    __device__ __forceinline__ void operator()(const f32x4 (&acc)[2][2][4][2], const Unit& u, int wr, int wc, int fr_, int fq_) const {
        const int tl_ = opaque_tid(), fr = tl_ & 15, fq = (tl_ >> 4) & 3; (void)fr_; (void)fq_;
        const int row0 = u.pm * 256 + wr * 64 + fr, cin = wc * 32 + 8 * fq;
        const bool rot = u.pn < 8; const float lg = lg2gamma(u.pn & 3);
        float rr[8]; row_scales(rr, rss, row0, fq);
        u32x4 wout[8][2];
#pragma unroll
        for (int am = 0; am < 4; ++am) {
            const int ai = am >> 1;
            f32x4 ct[2][2], st[2][2];
            if (rot) {
#pragma unroll
                for (int mm = 0; mm < 2; ++mm) {
                    const int row = row0 + ai * 128 + ((am & 1) * 2 + mm) * 16; const int pos = (row < NP) ? (row & (SEQ - 1)) : 1024 + ((row - NP) & 15);
#pragma unroll
                    for (int n = 0; n < 2; ++n) { ct[mm][n] = *(const f32x4*)(cosT + (size_t)pos * 128 + cin + 4 * n); st[mm][n] = *(const f32x4*)(sinT + (size_t)pos * 128 + cin + 4 * n); }
                }
            }
#pragma unroll
            for (int mm = 0; mm < 2; ++mm) {
                const int m = (am & 1) * 2 + mm;
                const int row = row0 + ai * 128 + m * 16;
                const float r = rr[ai * 4 + m];
                int l, Lc;
                if (row < NP) { l = row & 63; Lc = 64; } else { l = (row - NP) & 15; Lc = 16; }
                f32x4 o1[2], o2[2];
                if (rot) {
                    const float e = (u.pn < 4) ? (float)(l + 1) : (float)(Lc - 1 - l);
                    const float dec = exp2f(e * lg) * r;
#pragma unroll
                    for (int n = 0; n < 2; ++n) {
                        const f32x4 c4 = ct[mm][n], s4 = st[mm][n];
                        const f32x4 x1 = acc[ai][0][m][n] * dec, x2 = acc[ai][1][m][n] * dec;
                        o1[n] = x1 * c4 - x2 * s4; o2[n] = x1 * s4 + x2 * c4;
                    }
                } else {
#pragma unroll
                    for (int n = 0; n < 2; ++n) { o1[n] = acc[ai][0][m][n] * r; o2[n] = acc[ai][1][m][n] * r; }
                }
                u32x4 w; w.x = cvt_pk_bf16(o1[0][0], o1[0][1]); w.y = cvt_pk_bf16(o1[0][2], o1[0][3]); w.z = cvt_pk_bf16(o1[1][0], o1[1][1]); w.w = cvt_pk_bf16(o1[1][2], o1[1][3]);
                wout[ai * 4 + m][0] = w;
                w.x = cvt_pk_bf16(o2[0][0], o2[0][1]); w.y = cvt_pk_bf16(o2[0][2], o2[0][3]); w.z = cvt_pk_bf16(o2[1][0], o2[1][1]); w.w = cvt_pk_bf16(o2[1][2], o2[1][3]);
                wout[ai * 4 + m][1] = w;
            }
        }
#pragma unroll
        for (int i = 0; i < 8; ++i) {
            bf16_t* rowp = O + (size_t)(row0 + (i >> 2) * 128 + (i & 3) * 16) * 4096 + u.pn * 256 + cin;
            *(u32x4*)rowp = wout[i][0]; *(u32x4*)(rowp + 128) = wout[i][1];
        }
    }
};
struct EpiGate {
    static constexpr bool PERM = true, AFTER_DRAIN = false;
    bf16_t* QKV; const float* rss; const float* gss;
    __device__ __forceinline__ void operator()(const f32x4 (&acc)[2][2][4][2], const Unit& u, int wr, int wc, int fr_, int fq_) const {
        const int tl_ = opaque_tid(), fr = tl_ & 15, fq = (tl_ >> 4) & 3; (void)fr_; (void)fq_;
        const int row0 = u.pm * 256 + wr * 64 + fr, cin = wc * 32 + 8 * fq, head = u.pn >> 1;
        float rr[8]; row_scales(rr, rss, row0, fq);
        u32x4 wout[8][2];
#pragma unroll
        for (int ai = 0; ai < 2; ++ai) {
            u32x4 ovs[4][2]; float2 gps[4];
#pragma unroll
            for (int i = 0; i < 4; ++i) {
                const int row = row0 + ai * 128 + i * 16; const bf16_t* rp = QKV + (size_t)row * 4096 + 2048 + u.pn * 256 + cin;
                ovs[i][0] = *(const u32x4*)rp; ovs[i][1] = *(const u32x4*)(rp + 128); gps[i] = *(const float2*)(gss + ((size_t)row * 4 + head) * 2);
            }
#pragma unroll
            for (int m = 0; m < 4; ++m) {
                const float r = rr[ai * 4 + m];
                const float rn = __builtin_amdgcn_rsqf((gps[m].x + gps[m].y) * (1.0f / 512.0f) + EPS);
#pragma unroll
                for (int bj = 0; bj < 2; ++bj) {
                    const u32x4 ov = ovs[m][bj];
                    float g[8], o[8];
#pragma unroll
                    for (int j = 0; j < 4; ++j) { g[j] = acc[ai][bj][m][0][j] * r; g[4 + j] = acc[ai][bj][m][1][j] * r; }
                    o[0] = __uint_as_float(ov.x << 16); o[1] = __uint_as_float(ov.x & 0xffff0000u); o[2] = __uint_as_float(ov.y << 16); o[3] = __uint_as_float(ov.y & 0xffff0000u);
                    o[4] = __uint_as_float(ov.z << 16); o[5] = __uint_as_float(ov.z & 0xffff0000u); o[6] = __uint_as_float(ov.w << 16); o[7] = __uint_as_float(ov.w & 0xffff0000u);
                    float y[8];
#pragma unroll
                    for (int j = 0; j < 8; ++j) y[j] = silu_f(g[j]) * o[j] * rn;
                    u32x4 w; w.x = cvt_pk_bf16(y[0], y[1]); w.y = cvt_pk_bf16(y[2], y[3]); w.z = cvt_pk_bf16(y[4], y[5]); w.w = cvt_pk_bf16(y[6], y[7]);
                    wout[ai * 4 + m][bj] = w;
                }
            }
        }
#pragma unroll
        for (int i = 0; i < 8; ++i) {
            bf16_t* rowp = QKV + (size_t)(row0 + (i >> 2) * 128 + (i & 3) * 16) * 4096 + 2048 + u.pn * 256 + cin;
            *(u32x4*)rowp = wout[i][0]; *(u32x4*)(rowp + 128) = wout[i][1];
        }
    }
};
struct EpiFfn {
    static constexpr bool PERM = true, AFTER_DRAIN = false;
    bf16_t* ACT; const float* rss;
    __device__ __forceinline__ void operator()(const f32x4 (&acc)[2][2][4][2], const Unit& u, int wr, int wc, int fr_, int fq_) const {
        const int tl_ = opaque_tid(), fr = tl_ & 15, fq = (tl_ >> 4) & 3; (void)fr_; (void)fq_;
        const int row0 = u.pm * 256 + wr * 64 + fr, cout = u.pn * 128 + wc * 16 + 4 * fq;
        float rr[8]; row_scales(rr, rss, row0, fq);
#pragma unroll
        for (int ai = 0; ai < 2; ++ai)
#pragma unroll
            for (int m = 0; m < 4; ++m) {
                const int row = row0 + ai * 128 + m * 16;
                const float r = rr[ai * 4 + m];
                bf16_t* rowp = ACT + (size_t)row * DFF + cout;
#pragma unroll
                for (int bj = 0; bj < 2; ++bj) {
                    const f32x4 a = acc[ai][bj][m][0] * r, b = acc[ai][bj][m][1] * r;
                    u32x2 w; w.x = cvt_pk_bf16(silu_f(a[0]) * b[0], silu_f(a[1]) * b[1]); w.y = cvt_pk_bf16(silu_f(a[2]) * b[2], silu_f(a[3]) * b[3]);
                    *(u32x2*)(rowp + bj * 64) = w;
                }
            }
    }
};
struct EpiRes {
    static constexpr bool PERM = false, AFTER_DRAIN = false;
    const float* base_p; const float* base_s; float* xres; bf16_t* xb; float* rss_next;
    __device__ __forceinline__ void operator()(const f32x4 (&acc)[2][2][4][2], const Unit& u, int wr, int wc, int fr_, int fq_) const {
        const int tl_ = opaque_tid(), fr = tl_ & 15, fq = (tl_ >> 4) & 3; (void)fr_; (void)fq_;
        const int row0 = u.pm * 256 + wr * 64 + fr, col0 = u.pn * 256 + wc * 32 + 4 * fq;
#pragma unroll
        for (int ai = 0; ai < 2; ++ai) {
            f32x4 bv[4][4];
#pragma unroll
            for (int m = 0; m < 4; ++m) {
                const int row = row0 + ai * 128 + m * 16;
                const float* bp = (row < NP) ? base_p + (size_t)row * DM : base_s + (size_t)(row - NP) * DM;
#pragma unroll
                for (int q = 0; q < 4; ++q) bv[m][q] = *(const f32x4*)(bp + col0 + (q >> 1) * 128 + (q & 1) * 16);
            }
#pragma unroll
            for (int m = 0; m < 4; ++m) {
                const int row = row0 + ai * 128 + m * 16;
                float ss = 0.f;
#pragma unroll
                for (int bj = 0; bj < 2; ++bj)
#pragma unroll
                    for (int n = 0; n < 2; ++n) {
                        const int c = col0 + bj * 128 + n * 16;
                        const f32x4 v = bv[m][bj * 2 + n] + acc[ai][bj][m][n];
                        *(f32x4*)(xres + (size_t)row * DM + c) = v;
                        u32x2 w; w.x = cvt_pk_bf16(v[0], v[1]); w.y = cvt_pk_bf16(v[2], v[3]);
                        *(u32x2*)(xb + (size_t)row * DM + c) = w;
                        ss += (v[0] * v[0] + v[1] * v[1]) + (v[2] * v[2] + v[3] * v[3]);
                    }
                ss += __shfl_xor(ss, 16); ss += __shfl_xor(ss, 32);
                if (fq == 0) rss_next[(size_t)row * 16 + u.pn * 4 + wc] = ss;
            }
        }
    }
};

struct MapId { __device__ __forceinline__ float scale(int) const { return 1.f; } __device__ __forceinline__ int drow(int n) const { return n; } };
struct MapRetIn { __device__ __forceinline__ float scale(int n) const { return (n >= 1024 && n < 2048) ? 0.0625f : 1.f; } __device__ __forceinline__ int drow(int n) const { return n; } };
struct MapFfnIn { __device__ __forceinline__ float scale(int) const { return 1.f; }
    __device__ __forceinline__ int drow(int n) const { const int isb = n >= DFF, j = n - isb * DFF; return (j >> 2) * 8 + isb * 4 + (j & 3); } };
struct MapPool { const float* cs; __device__ __forceinline__ float scale(int n) const { return cs[n]; } __device__ __forceinline__ int drow(int n) const { return n; } };

template <class MapF>
__device__ __forceinline__ void conv_T(LAS unsigned char* lds, const float* src, int K, int Nsrc, int ldsrc, bf16_t* dst, int lddst, const float* gain, const MapF map) {
    const int tid = opaque_tid(), tk = K >> 6, tn = Nsrc >> 8, ntile = tk * tn;
    LAS bf16_t* tile = (LAS bf16_t*)lds;
    for (int t = blockIdx.x; t < ntile; t += gridDim.x) {
        const int k0 = (t % tk) << 6, n0 = (t / tk) << 8;
        {
            const int kk = tid >> 3, nn = (tid & 7) * 8; const float* sp = src + (size_t)(k0 + kk) * ldsrc + n0 + nn;
            const float gk = gain ? gain[k0 + kk] : 1.f;
            float4 a[4], b[4];
#pragma unroll
            for (int q = 0; q < 4; ++q) { a[q] = *(const float4*)(sp + q * 64); b[q] = *(const float4*)(sp + q * 64 + 4); }
#pragma unroll
            for (int q = 0; q < 4; ++q) {
                const int nb = q * 64 + nn; LAS bf16_t* tp = tile + nb * 72 + kk;
                tp[0 * 72] = f2bf(a[q].x * gk * map.scale(n0 + nb + 0)); tp[1 * 72] = f2bf(a[q].y * gk * map.scale(n0 + nb + 1));
                tp[2 * 72] = f2bf(a[q].z * gk * map.scale(n0 + nb + 2)); tp[3 * 72] = f2bf(a[q].w * gk * map.scale(n0 + nb + 3));
                tp[4 * 72] = f2bf(b[q].x * gk * map.scale(n0 + nb + 4)); tp[5 * 72] = f2bf(b[q].y * gk * map.scale(n0 + nb + 5));
                tp[6 * 72] = f2bf(b[q].z * gk * map.scale(n0 + nb + 6)); tp[7 * 72] = f2bf(b[q].w * gk * map.scale(n0 + nb + 7));
            }
        }
        __syncthreads();
        {
            const int nn = tid >> 3, kc = (tid & 7) * 8;
#pragma unroll
            for (int q = 0; q < 4; ++q) {
                const u32x4 raw = *(const LAS u32x4*)(tile + (q * 64 + nn) * 72 + kc);
                *(u32x4*)(dst + (size_t)map.drow(n0 + q * 64 + nn) * lddst + k0 + kc) = raw;
            }
        }
        __syncthreads();
    }
}
__device__ __forceinline__ void convert_ret(const Params& p, LAS unsigned char* lds, int j) {
    conv_T(lds, p.w_ret_in + (size_t)j * 1024 * 6144, 1024, 6144, 6144, (bf16_t*)(p.ws + WS_WRI), 1024, p.norm_mix + (size_t)(2 * j) * DM, MapRetIn{});
    conv_T(lds, p.w_ret_out + (size_t)j * 2048 * 1024, 2048, 1024, 1024, (bf16_t*)(p.ws + WS_WRO), 2048, nullptr, MapId{});
}
__device__ __forceinline__ void convert_pool(const Params& p, LAS unsigned char* lds, int j) {
    bf16_t* W = (bf16_t*)(p.ws + WS_WPL);
    for (size_t i = (size_t)blockIdx.x * blockDim.x + opaque_tid(); i < (size_t)1024 * 128; i += (size_t)gridDim.x * blockDim.x) {
        const int n = (int)(i >> 7), k = (int)(i & 127) * 8;
        if ((n >> 8) != (k >> 8)) { unsigned z = 0u; asm volatile("" : "+v"(z)); *(u32x4*)(W + (size_t)n * 1024 + k) = (u32x4){z, z, z, z}; }
    }
    for (int g = 0; g < 4; ++g)
        conv_T(lds, p.w_pool + ((size_t)j * 4 + g) * 65536, 256, 256, 256, W + (size_t)(g * 256) * 1024 + g * 256, 1024, nullptr, MapPool{p.pool_scale + (size_t)j * DM + g * 256});
}
__device__ __forceinline__ void convert_ffn(const Params& p, LAS unsigned char* lds, int i) {
    conv_T(lds, p.w_ffn_in + (size_t)i * 1024 * 5632, 1024, 5632, 5632, (bf16_t*)(p.ws + WS_WFI), 1024, p.norm_ffn + (size_t)i * DM, MapFfnIn{});
    conv_T(lds, p.w_ffn_out + (size_t)i * DFF * 1024, DFF, 1024, 1024, (bf16_t*)(p.ws + WS_WFO), DFF, nullptr, MapId{});
}
__device__ __forceinline__ void convert_mixer(const Params& p, LAS unsigned char* lds, int layer) { if (layer & 1) convert_pool(p, lds, layer >> 1); else convert_ret(p, lds, layer >> 1); }

__device__ __forceinline__ void phase0(const Params& p, LAS unsigned char* lds) {
    const int tid = opaque_tid(), lane = tid & 63, wid = tid >> 6;
    bf16_t* xb = (bf16_t*)(p.ws + WS_XB); float* rss = (float*)(p.ws + WS_RSS);
    for (int row = blockIdx.x * 8 + wid; row < NTOK; row += gridDim.x * 8) {
        const float* src = (row < NP) ? p.x_prompt + (size_t)row * DM : p.x_sample + (size_t)(row - NP) * DM;
        float ss = 0.f;
#pragma unroll
        for (int i = 0; i < 4; ++i) {
            const float4 v = *(const float4*)(src + i * 256 + lane * 4);
            ss += (v.x * v.x + v.y * v.y) + (v.z * v.z + v.w * v.w);
            u32x2 w; w.x = cvt_pk_bf16(v.x, v.y); w.y = cvt_pk_bf16(v.z, v.w);
            *(u32x2*)(xb + (size_t)row * DM + i * 256 + lane * 4) = w;
        }
#pragma unroll
        for (int o = 32; o >= 1; o >>= 1) ss += __shfl_xor(ss, o);
        if (lane < 16) rss[(size_t)row * 16 + lane] = (lane == 0) ? ss : 0.f;
    }
    const size_t gt = (size_t)blockIdx.x * blockDim.x + tid, nth = (size_t)gridDim.x * blockDim.x;
    float* cosT = (float*)(p.ws + WS_COS); float* sinT = (float*)(p.ws + WS_SIN);
    for (size_t i = gt; i < (size_t)SEQ * 128; i += nth) {
        const int pos = (int)(i >> 7), j = (int)(i & 127);
        const double inv = exp2(-(double)j * 0.10381025296523007), t = (double)pos * inv * 0.31830988618379067154;
        double s, c; sincospi(t, &s, &c);
        cosT[i] = (float)c; sinT[i] = (float)s;
    }
    convert_mixer(p, lds, 0); convert_mixer(p, lds, 1); convert_ffn(p, lds, 0);
}

template <int W>
__device__ __forceinline__ void pool_unit(const float* xres, const float* sp, const LAS float* rl, bf16_t* dbuf, float* po, int rowbase, int t0, int c0, float g0, float g1, bool isS, bool lastu) {
    float2 hv[15 + W];
#pragma unroll
    for (int i = 0; i < 15 + W; ++i) {
        const int t = t0 - (W - 1) + i;
        float2 v = make_float2(0.f, 0.f);
        if (t >= 0) { const float2 x = *(const float2*)(xres + (size_t)(rowbase + t) * DM + c0); const float r = rl[i + 16 - W]; v = make_float2(x.x * r * g0, x.y * r * g1); }
        else if (isS) v = *(const float2*)(sp + (size_t)(15 + t) * DM + c0);
        hv[i] = v;
    }
    float2 s = make_float2(0.f, 0.f);
#pragma unroll
    for (int i = 0; i < W - 1; ++i) { s.x += hv[i].x; s.y += hv[i].y; }
#pragma unroll
    for (int k = 0; k < 16; ++k) {
        const float2 h = hv[W - 1 + k];
        s.x += h.x; s.y += h.y;
        const float inv = 1.0f / (isS ? (float)W : (float)min(t0 + k + 1, W));
        *(unsigned*)(dbuf + (size_t)(rowbase + t0 + k) * DM + c0) = cvt_pk_bf16(s.x * inv - h.x, s.y * inv - h.y);
        if (lastu && k >= 1) *(float2*)(po + (size_t)(k - 1) * DM + c0) = h;
        s.x -= hv[k].x; s.y -= hv[k].y;
    }
}
__device__ __forceinline__ void phase_pool_prep(const Params& p, LAS unsigned char* lds, int layer) {
    const int j = layer >> 1, tid = opaque_tid(), c0 = tid * 2, gi = __builtin_amdgcn_readfirstlane(tid >> 7);
    const float* xres = p.out; const float* rssc = (const float*)(p.ws + WS_RSS) + (size_t)(2 * layer) * NTOK * 16;
    const float g0 = p.norm_mix[(size_t)layer * DM + c0], g1 = p.norm_mix[(size_t)layer * DM + c0 + 1];
    bf16_t* dbuf = (bf16_t*)(p.ws + WS_QKV);
    LAS float* rl = (LAS float*)lds;
    for (int u = blockIdx.x; u < 2064; u += gridDim.x) {
        int t0, rowbase; bool isS, lastu; const float* sp = nullptr; float* po;
        if (u < 2048) { const int b = u >> 10; t0 = (u & 1023) * 16; rowbase = b * SEQ; isS = false; lastu = (u & 1023) == 1023; po = p.out + OUT_POOLP + ((size_t)(j * 2 + b) * 15) * DM; }
        else { const int sb = u - 2048; t0 = 0; rowbase = NP + sb * 16; isS = true; lastu = true; sp = p.state_pool + ((size_t)(j * 16 + sb) * 15) * DM; po = p.out + OUT_POOLS + ((size_t)(j * 16 + sb) * 15) * DM; }
        __syncthreads();
        if (tid < 31) { const int t = t0 - 15 + tid; rl[tid] = (t >= 0) ? rs_row(rssc + (size_t)(rowbase + t) * 16) : 0.f; }
        __syncthreads();
        if (gi == 0) pool_unit<2>(xres, sp, rl, dbuf, po, rowbase, t0, c0, g0, g1, isS, lastu);
        else if (gi == 1) pool_unit<4>(xres, sp, rl, dbuf, po, rowbase, t0, c0, g0, g1, isS, lastu);
        else if (gi == 2) pool_unit<8>(xres, sp, rl, dbuf, po, rowbase, t0, c0, g0, g1, isS, lastu);
        else pool_unit<16>(xres, sp, rl, dbuf, po, rowbase, t0, c0, g0, g1, isS, lastu);
    }
}

__device__ __forceinline__ void phase_final(const Params& p) {
    const float* rssc = (const float*)(p.ws + WS_RSS) + (size_t)8 * NTOK * 16;
    for (size_t i = (size_t)blockIdx.x * blockDim.x + opaque_tid(); i < (size_t)NTOK * 256; i += (size_t)gridDim.x * blockDim.x) {
        const int row = (int)(i >> 8), c = (int)(i & 255) * 4;
        const float r = rs_row(rssc + (size_t)row * 16);
        const float4 g = *(const float4*)(p.norm_final + c);
        float4 v = *(const float4*)(p.out + (size_t)row * DM + c);
        v.x *= r * g.x; v.y *= r * g.y; v.z *= r * g.z; v.w *= r * g.w;
        *(float4*)(p.out + (size_t)row * DM + c) = v;
    }
}

__device__ __forceinline__ unsigned offb(unsigned row, unsigned ch) { return 256u * row + 16u * (ch ^ (((row & 3u) << 2) | ((row >> 2) & 3u))); }
__device__ __forceinline__ unsigned img_off(unsigned row, unsigned ch32) { return (ch32 >> 4) * 16384u + offb(row, ch32 & 15u); }
constexpr unsigned IMG_Q = 0, IMG_K = 32768, IMG_V = 65536, IMG_P = 98304, IMG_O = 107520;

__device__ __forceinline__ void tile_load(u32x4 (&r)[4], const bf16_t* g, int ld, int nvalid, int tid_) {
    int tid = tid_; asm volatile("" : "+v"(tid));
    const int r0 = (tid >> 5) & 15, ch = tid & 31;
    const bf16_t* gp = g + (size_t)r0 * ld + ch * 8;
    if (nvalid >= 64) {
#pragma unroll
        for (int i = 0; i < 4; ++i) r[i] = *(const u32x4*)(gp + (size_t)(16 * i) * ld);
    } else {
        r[0] = *(const u32x4*)gp;
        unsigned z = 0u; asm volatile("" : "+v"(z));
#pragma unroll
        for (int i = 1; i < 4; ++i) r[i] = (u32x4){z, z, z, z};
    }
}
__device__ __forceinline__ void tile_store(LAS unsigned char* img, const u32x4 (&r)[4], int tid_) {
    int tid = tid_; asm volatile("" : "+v"(tid));
    const unsigned r0 = (tid >> 5) & 15, ch = tid & 31;
    LAS unsigned char* bp = img + img_off(r0, ch);
#pragma unroll
    for (int i = 0; i < 4; ++i) *(LAS u32x4*)(bp + 4096 * i) = r[i];
}
__device__ __forceinline__ bf16x8 tr_frag(LAS unsigned char* img, int lane, int cblk  , int ks) {
    const unsigned h = lane >> 5, blk = (lane >> 4) & 1, q = (lane & 15) >> 2, pp = lane & 3;
    const unsigned c = cblk & 3;
    const unsigned lowc = 2 * blk + (pp >> 1);
    const unsigned chx0 = ((c ^ q) << 2) | (lowc ^ (2 * h)), chx1 = chx0 ^ 1u;
    const unsigned rb = 256u * (8 * h + q) + 8 * (pp & 1);
    const unsigned a0 = rb + 16u * chx0, a1 = rb + 1024u + 16u * chx1;
    LAS unsigned char* base = img + (cblk >> 2) * 16384 + ks * 4096;
    const s16x4 lo = __builtin_amdgcn_ds_read_tr16_b64_v4i16((LAS s16x4*)(base + a0));
    const s16x4 hi = __builtin_amdgcn_ds_read_tr16_b64_v4i16((LAS s16x4*)(base + a1));
    return __builtin_shufflevector(lo, hi, 0, 1, 2, 3, 4, 5, 6, 7);
}
__device__ __forceinline__ bf16x8 pack8(const f32x16& s, int base) {
    u32x4 w; w.x = cvt_pk_bf16(s[base + 0], s[base + 1]); w.y = cvt_pk_bf16(s[base + 2], s[base + 3]); w.z = cvt_pk_bf16(s[base + 4], s[base + 5]); w.w = cvt_pk_bf16(s[base + 6], s[base + 7]);
    return __builtin_bit_cast(bf16x8, w);
}

__device__ __forceinline__ void state_update(f32x16 (&S)[8], LAS unsigned char* kimg, const bf16x8 (&Vf)[4], int lane) {
#pragma unroll
    for (int dt = 0; dt < 8; ++dt)
#pragma unroll
        for (int ks = 0; ks < 4; ++ks) {
            const bf16x8 a = tr_frag(kimg, lane, dt, ks);
            S[dt] = __builtin_amdgcn_mfma_f32_32x32x16_bf16(a, Vf[ks], S[dt], 0, 0, 0);
        }
}

__device__ __forceinline__ void phase_scan_local(const Params& p, LAS unsigned char* lds) {
    const int tid = opaque_tid(), lane_ = tid & 63, wid = __builtin_amdgcn_readfirstlane(tid >> 6);
    const bf16_t* qkv = (const bf16_t*)(p.ws + WS_QKV); float* T = (float*)(p.ws + WS_T);
    for (int u_ = blockIdx.x; u_ < 256; u_ += gridDim.x) {
        const int u = (gridDim.x == 256) ? (((u_ >> 4) << 4) | ((u_ & 7) << 1) | ((u_ >> 3) & 1)) : u_;
        const int eh = u & 1, seg = (u >> 1) & 15, h = (u >> 5) & 3, b = u >> 7;
        const size_t row0 = (size_t)b * SEQ + (size_t)seg * 1024;
        const bf16_t* kb = qkv + row0 * 4096 + 1024 + h * 256; const bf16_t* vb = qkv + row0 * 4096 + 2048 + h * 512 + eh * 256;
        const float gC = exp2f(64.f * lg2gamma(h));
        f32x16 S[8];
#pragma unroll
        for (int i = 0; i < 8; ++i)
#pragma unroll
            for (int r = 0; r < 16; ++r) S[i][r] = 0.f;
        u32x4 rk0[4], rv0[4], rk1[4], rv1[4];
        tile_load(rk0, kb, 4096, 64, tid); tile_load(rv0, vb, 4096, 64, tid);
        tile_load(rk1, kb + (size_t)64 * 4096, 4096, 64, tid); tile_load(rv1, vb + (size_t)64 * 4096, 4096, 64, tid);
        LDS_BARRIER();
        tile_store(lds, rk0, tid); tile_store(lds + 32768, rv0, tid);
        LDS_BARRIER();
        tile_load(rk0, kb + (size_t)2 * 64 * 4096, 4096, 64, tid); tile_load(rv0, vb + (size_t)2 * 64 * 4096, 4096, 64, tid);
        for (int c = 0; c < 16; c += 2) {
            {
                int lane = lane_; asm volatile("" : "+v"(lane));
                tile_store(lds + 65536, rk1, tid); tile_store(lds + 98304, rv1, tid);
#pragma unroll
                for (int i = 0; i < 8; ++i) S[i] *= gC;
                bf16x8 Vf[4];
#pragma unroll
                for (int ks = 0; ks < 4; ++ks) Vf[ks] = tr_frag(lds + 32768, lane, wid, ks);
                state_update(S, lds, Vf, lane);
                LDS_BARRIER();
                if (c + 3 < 16) { tile_load(rk1, kb + (size_t)(c + 3) * 64 * 4096, 4096, 64, tid); tile_load(rv1, vb + (size_t)(c + 3) * 64 * 4096, 4096, 64, tid); }
            }
            {
                int lane = lane_; asm volatile("" : "+v"(lane));
                if (c + 2 < 16) { tile_store(lds, rk0, tid); tile_store(lds + 32768, rv0, tid); }
#pragma unroll
                for (int i = 0; i < 8; ++i) S[i] *= gC;
                bf16x8 Vf[4];
#pragma unroll
                for (int ks = 0; ks < 4; ++ks) Vf[ks] = tr_frag(lds + 98304, lane, wid, ks);
                state_update(S, lds + 65536, Vf, lane);
                LDS_BARRIER();
                if (c + 4 < 16) { tile_load(rk0, kb + (size_t)(c + 4) * 64 * 4096, 4096, 64, tid); tile_load(rv0, vb + (size_t)(c + 4) * 64 * 4096, 4096, 64, tid); }
            }
        }
        float* Tu = T + (size_t)u * 65536;
        int lz = lane_; asm volatile("" : "+v"(lz));
        const int hl = lz >> 5, e = wid * 32 + (lz & 31);
#pragma unroll
        for (int dt = 0; dt < 8; ++dt)
#pragma unroll
            for (int r = 0; r < 16; ++r) Tu[(size_t)(32 * dt + (r & 3) + 8 * (r >> 2) + 4 * hl) * 256 + e] = S[dt][r];
    }
}

__device__ __forceinline__ void phase_scan_prefix(const Params& p, int jl) {
    float* T = (float*)(p.ws + WS_T);
    const int gt = blockIdx.x * 512 + opaque_tid(), nth = gridDim.x * 512;
    for (int i = gt; i < 262144; i += nth) {
        const int grp = i >> 14, pos = (i & 16383) * 4, eh = grp & 1, bh = grp >> 1, h = bh & 3;
        const float gS = exp2f(1024.f * lg2gamma(h));
        float* base = T + ((size_t)(bh * 16) * 2 + eh) * 65536 + pos;
        float4 t[16];
#pragma unroll
        for (int j = 0; j < 16; ++j) t[j] = *(const float4*)(base + (size_t)j * 131072);
        float zf = 0.f; asm volatile("" : "+v"(zf));
        float4 run = make_float4(zf, zf, zf, zf);
#pragma unroll
        for (int j = 0; j < 16; ++j) {
            *(float4*)(base + (size_t)j * 131072) = run;
            run.x = run.x * gS + t[j].x; run.y = run.y * gS + t[j].y; run.z = run.z * gS + t[j].z; run.w = run.w * gS + t[j].w;
        }
        const int d = pos >> 8, e = pos & 255;
        *(float4*)(p.out + OUT_RETP + ((size_t)((jl * 2 + (bh >> 2)) * 4 + h) * 256 + d) * 512 + eh * 256 + e) = run;
    }
}

__device__ __forceinline__ void phase_scan(const Params& p, LAS unsigned char* lds, int jl) {
    const int tid = opaque_tid(), lane_ = tid & 63, wid = __builtin_amdgcn_readfirstlane(tid >> 6);
    bf16_t* qkv = (bf16_t*)(p.ws + WS_QKV); const float* T = (const float*)(p.ws + WS_T);
    float* gss = (float*)(p.ws + WS_GSS) + (size_t)jl * NTOK * 8;
    for (int v_ = blockIdx.x; v_ < 384; v_ += gridDim.x) {
        const int v = (gridDim.x == 256) ? ((v_ & 256) | (((v_ & 255) >> 4) << 4) | ((v_ & 7) << 1) | ((v_ >> 3) & 1)) : v_;
        int eh, h, Lc, nch; size_t row0; float* Sout = nullptr;
        f32x16 S[8];
        if (v < 256) {
            eh = v & 1; const int seg = (v >> 1) & 15; h = (v >> 5) & 3; const int b = v >> 7;
            row0 = (size_t)b * SEQ + (size_t)seg * 1024; Lc = 64; nch = 16;
            {
                int lz = lane_; asm volatile("" : "+v"(lz)); const int hl_ = lz >> 5, ecol_ = wid * 32 + (lz & 31);
                const float* Tu = T + (size_t)v * 65536;
#pragma unroll
                for (int dt = 0; dt < 8; ++dt)
#pragma unroll
                    for (int r = 0; r < 16; ++r) S[dt][r] = Tu[(size_t)(32 * dt + (r & 3) + 8 * (r >> 2) + 4 * hl_) * 256 + ecol_];
            }
        } else {
            const int su = v - 256; eh = su & 1; h = (su >> 1) & 3; const int sb = su >> 3;
            row0 = (size_t)NP + (size_t)sb * 16; Lc = 16; nch = 1;
            Sout = p.out + OUT_RETS + ((size_t)((jl * 16 + sb) * 4 + h) * 256) * 512 + eh * 256;
            int lz = lane_; asm volatile("" : "+v"(lz)); const int hl_ = lz >> 5, ecol_ = wid * 32 + (lz & 31);
            const float* Sin = p.state_ret + ((size_t)((jl * 16 + sb) * 4 + h) * 256) * 512 + eh * 256;
#pragma unroll
            for (int dt = 0; dt < 8; ++dt)
#pragma unroll
                for (int r = 0; r < 16; ++r) S[dt][r] = Sin[(size_t)(32 * dt + (r & 3) + 8 * (r >> 2) + 4 * hl_) * 512 + ecol_];
        }
        const float lg = lg2gamma(h), gC = exp2f((float)Lc * lg), gCinv = exp2f(-(float)Lc * lg);
        bf16_t* qb = qkv + row0 * 4096 + h * 256; bf16_t* kb = qkv + row0 * 4096 + 1024 + h * 256; bf16_t* vb = qkv + row0 * 4096 + 2048 + h * 512 + eh * 256;
        u32x4 rq[4], rk[4], rv[4];
        tile_load(rq, qb, 4096, Lc, tid); tile_load(rk, kb, 4096, Lc, tid); tile_load(rv, vb, 4096, Lc, tid);
        LDS_BARRIER();
        tile_store(lds + IMG_Q, rq, tid); tile_store(lds + IMG_K, rk, tid); tile_store(lds + IMG_V, rv, tid);
        LDS_BARRIER();
        for (int c = 0; c < nch; ++c) {
            int lane = lane_; asm volatile("" : "+v"(lane)); const int hl = lane >> 5, ecol = wid * 32 + (lane & 31);
            {
                const int mi = wid >> 1, nj0 = 2 * (wid & 1), l15 = lane & 15, l4 = lane >> 4;
                f32x4 sc[2] = {(f32x4){0.f, 0.f, 0.f, 0.f}, (f32x4){0.f, 0.f, 0.f, 0.f}};
#pragma unroll
                for (int s = 0; s < 8; ++s) {
                    const bf16x8 a = *(const LAS bf16x8*)(lds + IMG_K + img_off(16 * mi + l15, 4 * s + l4));
#pragma unroll
                    for (int t = 0; t < 2; ++t) {
                        const bf16x8 bq = *(const LAS bf16x8*)(lds + IMG_Q + img_off(16 * (nj0 + t) + l15, 4 * s + l4));
                        sc[t] = __builtin_amdgcn_mfma_f32_16x16x32_bf16(a, bq, sc[t], 0, 0, 0);
                    }
                }
#pragma unroll
                for (int t = 0; t < 2; ++t) {
                    const int n = 16 * (nj0 + t) + l15, m0 = 16 * mi + 4 * l4;
                    float pv[4];
#pragma unroll
                    for (int r = 0; r < 4; ++r) pv[r] = (n >= m0 + r) ? sc[t][r] * gCinv : 0.f;
                    u32x2 w; w.x = cvt_pk_bf16(pv[0], pv[1]); w.y = cvt_pk_bf16(pv[2], pv[3]);
                    *(LAS u32x2*)(lds + IMG_P + n * 144 + m0 * 2) = w;
                }
            }
            LDS_BARRIER();
            f32x16 o[2];
#pragma unroll
            for (int nt = 0; nt < 2; ++nt)
#pragma unroll
                for (int r = 0; r < 16; ++r) o[nt][r] = 0.f;
#pragma unroll
            for (int s = 0; s < 16; ++s) {
                const bf16x8 bs = pack8(S[s >> 1], 8 * (s & 1));
#pragma unroll
                for (int nt = 0; nt < 2; ++nt) {
                    const unsigned rown = 32 * nt + (lane & 31);
                    const u32x2 lo = *(const LAS u32x2*)(lds + IMG_Q + img_off(rown, 2 * s) + 8 * hl);
                    const u32x2 hi = *(const LAS u32x2*)(lds + IMG_Q + img_off(rown, 2 * s + 1) + 8 * hl);
                    const u32x4 aw = (u32x4){lo.x, lo.y, hi.x, hi.y};
                    o[nt] = __builtin_amdgcn_mfma_f32_32x32x16_bf16(__builtin_bit_cast(bf16x8, aw), bs, o[nt], 0, 0, 0);
                }
            }
            bf16x8 Vf[4];
#pragma unroll
            for (int ks = 0; ks < 4; ++ks) Vf[ks] = tr_frag(lds + IMG_V, lane, wid, ks);
#pragma unroll
            for (int ks = 0; ks < 4; ++ks)
#pragma unroll
                for (int nt = 0; nt < 2; ++nt) {
                    const bf16x8 a = *(const LAS bf16x8*)(lds + IMG_P + (32 * nt + (lane & 31)) * 144 + (16 * ks + 8 * hl) * 2);
                    o[nt] = __builtin_amdgcn_mfma_f32_32x32x16_bf16(a, Vf[ks], o[nt], 0, 0, 0);
                }
            {
                LAS unsigned char* oi = lds + IMG_O + (4 * hl) * 528 + ecol * 2;
#pragma unroll
                for (int nt = 0; nt < 2; ++nt)
#pragma unroll
                    for (int r = 0; r < 16; ++r) *(LAS bf16_t*)(oi + (32 * nt + (r & 3) + 8 * (r >> 2)) * 528) = (bf16_t)cvt_pk_bf16(o[nt][r], o[nt][r]);
            }
            if (c + 1 < nch) { tile_load(rk, kb + (size_t)(c + 1) * 64 * 4096, 4096, 64, tid); tile_load(rv, vb + (size_t)(c + 1) * 64 * 4096, 4096, 64, tid); }
#pragma unroll
            for (int i = 0; i < 8; ++i) S[i] *= gC;
            {
                int lane2 = lane_; asm volatile("" : "+v"(lane2));
                bf16x8 Vg[4];
#pragma unroll
                for (int ks = 0; ks < 4; ++ks) Vg[ks] = tr_frag(lds + IMG_V, lane2, wid, ks);
                state_update(S, lds + IMG_K, Vg, lane2);
            }
            __builtin_amdgcn_sched_barrier(0);
            LDS_BARRIER();
            if (c + 1 < nch) { tile_load(rq, qb + (size_t)(c + 1) * 64 * 4096, 4096, 64, tid); tile_store(lds + IMG_K, rk, tid); tile_store(lds + IMG_V, rv, tid); tile_store(lds + IMG_Q, rq, tid); }
            {
                int t2 = tid; asm volatile("" : "+v"(t2));
                const int r0 = (t2 >> 5) & 15, ch = t2 & 31;
                bf16_t* og = vb + (size_t)c * 64 * 4096 + (size_t)r0 * 4096 + ch * 8;
#pragma unroll
                for (int i = 0; i < 4; ++i) {
                    if (i == 0 || Lc == 64) {
                        const u32x4 w = *(const LAS u32x4*)(lds + IMG_O + (r0 + 16 * i) * 528 + ch * 16);
                        *(u32x4*)(og + (size_t)(16 * i) * 4096) = w;
                        const float a0 = __uint_as_float(w.x << 16), a1 = __uint_as_float(w.x & 0xffff0000u), a2 = __uint_as_float(w.y << 16), a3 = __uint_as_float(w.y & 0xffff0000u);
                        const float a4 = __uint_as_float(w.z << 16), a5 = __uint_as_float(w.z & 0xffff0000u), a6 = __uint_as_float(w.w << 16), a7 = __uint_as_float(w.w & 0xffff0000u);
                        float ss = ((a0 * a0 + a1 * a1) + (a2 * a2 + a3 * a3)) + ((a4 * a4 + a5 * a5) + (a6 * a6 + a7 * a7));
                        ss += __shfl_xor(ss, 16); ss += __shfl_xor(ss, 8); ss += __shfl_xor(ss, 4); ss += __shfl_xor(ss, 2); ss += __shfl_xor(ss, 1);
                        if (ch == 0) gss[((row0 + (size_t)c * 64 + r0 + 16 * i) * 4 + h) * 2 + eh] = ss;
                    }
                }
            }
            LDS_BARRIER();
        }
        if (Sout) {
            int lz = lane_; asm volatile("" : "+v"(lz)); const int hl_ = lz >> 5, ecol_ = wid * 32 + (lz & 31);
#pragma unroll
            for (int dt = 0; dt < 8; ++dt)
#pragma unroll
                for (int r = 0; r < 16; ++r) Sout[(size_t)(32 * dt + (r & 3) + 8 * (r >> 2) + 4 * hl_) * 512 + ecol_] = S[dt][r];
        }
    }
}

struct PoolOrder : pg8::StaticOrder {
    __device__ __forceinline__ bool next(int i, Unit& u) const { const bool ok = pg8::StaticOrder::next(i, u); if (ok) u.kofs = u.pn * 256; return ok; }
};
template <class Epi>
__device__ __forceinline__ void run_gemm(LAS unsigned char* lds, const bf16_t* A, int lda, const bf16_t* Bt, int N, int K, const Epi& E, int M = NTOK) {
    pg8::Gemm g{A, Bt, M, N, K, lda, K}; pg8::StaticOrder S; S.init(M, N, (int)gridDim.x, (int)blockIdx.x);
    pg8::gemm_phase<Epi, pg8::StaticOrder, false>(lds, g, S, E, nullptr);
}

__device__ __forceinline__ void narrow_core(LAS unsigned char* lds, const bf16_t* ag, int lda, const bf16_t* bg0, const bf16_t* bg1, int K, f32x16& acc0, f32x16& acc1, int tid, int lane, int wid) {
    const int lr = tid >> 4, lc = tid & 15, hl = lane >> 5, l31 = lane & 31;
#pragma unroll
    for (int i = 0; i < 16; ++i) { acc0[i] = 0.f; acc1[i] = 0.f; }
    u32x4 ra0[8], rb0[2], ra1[8], rb1[2];
#define NR_LOAD(RA, RB, KO) do { int ko_ = (KO); asm volatile("" : "+s"(ko_)); const bf16_t* agp = ag + ko_; const bf16_t* b0p = bg0 + ko_; const bf16_t* b1p = bg1 + ko_; \
        _Pragma("unroll") for (int q = 0; q < 8; ++q) { RA[q] = *(const u32x4*)agp; agp += (size_t)32 * lda; } \
        RB[0] = *(const u32x4*)b0p; RB[1] = *(const u32x4*)b1p; } while (0)
#define NR_STORE(RA, RB) do { _Pragma("unroll") for (int q = 0; q < 8; ++q) *(LAS u32x4*)(lds + (q >> 1) * 16384 + offb((q & 1) * 32 + lr, lc)) = RA[q]; \
        *(LAS u32x4*)(lds + 65536 + offb(lr, lc)) = RB[0]; *(LAS u32x4*)(lds + 65536 + offb(32 + lr, lc)) = RB[1]; } while (0)
#define NR_COMPUTE() do { LAS unsigned char* ai = lds + (wid >> 1) * 16384; const unsigned arow = (wid & 1) * 32 + l31; \
        _Pragma("unroll") for (int q = 0; q < 8; ++q) { \
            const bf16x8 a = *(const LAS bf16x8*)(ai + offb(arow, 2 * q + hl)); \
            const bf16x8 x0 = *(const LAS bf16x8*)(lds + 65536 + offb(l31, 2 * q + hl)); \
            const bf16x8 x1 = *(const LAS bf16x8*)(lds + 65536 + offb(32 + l31, 2 * q + hl)); \
            acc0 = __builtin_amdgcn_mfma_f32_32x32x16_bf16(a, x0, acc0, 0, 0, 0); acc1 = __builtin_amdgcn_mfma_f32_32x32x16_bf16(a, x1, acc1, 0, 0, 0); } } while (0)
    NR_LOAD(ra0, rb0, 0); NR_LOAD(ra1, rb1, 128);
    LDS_BARRIER();
    for (int k = 0; k < K; k += 256) {
        NR_STORE(ra0, rb0); LDS_BARRIER();
        if (k + 256 < K) NR_LOAD(ra0, rb0, k + 256);
        NR_COMPUTE(); LDS_BARRIER();
        NR_STORE(ra1, rb1); LDS_BARRIER();
        if (k + 384 < K) NR_LOAD(ra1, rb1, k + 384);
        NR_COMPUTE(); LDS_BARRIER();
    }
#undef NR_LOAD
#undef NR_STORE
#undef NR_COMPUTE
}
__device__ __forceinline__ void narrow_scales(LAS unsigned char* lds, const float* rss, int tid) {
    if (tid < 256) ((LAS float*)(lds + 81920))[tid] = rs_row(rss + (size_t)(NP + tid) * 16);
}
__device__ __forceinline__ void narrow_ffn(LAS unsigned char* lds, const bf16_t* xb, const bf16_t* Wfi, bf16_t* act, const float* rss) {
    const int tid = opaque_tid(), lane = tid & 63, wid = __builtin_amdgcn_readfirstlane(tid >> 6), lr = tid >> 4, lc = tid & 15;
    for (int j = blockIdx.x; j < 88; j += gridDim.x) {
        const int jj = 32 * j + lr, dra = (jj >> 2) * 8 + (jj & 3);
        f32x16 acc0, acc1;
        __syncthreads(); narrow_scales(lds, rss, tid);
        narrow_core(lds, xb + (size_t)(NP + lr) * DM + lc * 8, DM, Wfi + (size_t)dra * DM + lc * 8, Wfi + (size_t)(dra + 4) * DM + lc * 8, DM, acc0, acc1, tid, lane, wid);
        int lz = lane; asm volatile("" : "+v"(lz)); const int hl = lz >> 5, l31 = lz & 31;
#pragma unroll
        for (int i = 0; i < 16; ++i) {
            const int rs = 32 * wid + (i & 3) + 8 * (i >> 2) + 4 * hl; const float r = ((const LAS float*)(lds + 81920))[rs];
            act[(size_t)(NP + rs) * DFF + 32 * j + l31] = f2bf(silu_f(acc0[i] * r) * (acc1[i] * r));
        }
    }
}
__device__ __forceinline__ void narrow_qkv(LAS unsigned char* lds, const bf16_t* xb, const bf16_t* Wri, bf16_t* qkv, const float* rss, const float* cosT, const float* sinT) {
    const int tid = opaque_tid(), lane = tid & 63, wid = __builtin_amdgcn_readfirstlane(tid >> 6), lr = tid >> 4, lc = tid & 15;
    for (int j = blockIdx.x; j < 64; j += gridDim.x) {
        const bool rot = j < 32; const int hd = j >> 2, j0 = (j & 3) * 32;
        const int cA = rot ? hd * 256 + j0 : 2048 + (j - 32) * 64, cB = rot ? cA + 128 : cA + 32;
        f32x16 acc0, acc1;
        __syncthreads(); narrow_scales(lds, rss, tid);
        narrow_core(lds, xb + (size_t)(NP + lr) * DM + lc * 8, DM, Wri + (size_t)(cA + lr) * DM + lc * 8, Wri + (size_t)(cB + lr) * DM + lc * 8, DM, acc0, acc1, tid, lane, wid);
        int lz = lane; asm volatile("" : "+v"(lz)); const int hl = lz >> 5, l31 = lz & 31;
        const float lg = lg2gamma(hd & 3);
        float cs[16], sn_[16];
        if (rot) {
#pragma unroll
            for (int i = 0; i < 16; ++i) { const int l = (32 * wid + (i & 3) + 8 * (i >> 2) + 4 * hl) & 15; cs[i] = cosT[(size_t)(1024 + l) * 128 + j0 + l31]; sn_[i] = sinT[(size_t)(1024 + l) * 128 + j0 + l31]; }
        }
#pragma unroll
        for (int i = 0; i < 16; ++i) {
            const int rs = 32 * wid + (i & 3) + 8 * (i >> 2) + 4 * hl; const float r = ((const LAS float*)(lds + 81920))[rs];
            bf16_t* op = qkv + (size_t)(NP + rs) * 4096;
            if (rot) {
                const int l = rs & 15; const float e = (hd < 4) ? (float)(l + 1) : (float)(15 - l);
                const float dec = exp2f(e * lg) * r, x1 = acc0[i] * dec, x2 = acc1[i] * dec;
                const float c = cs[i], sn = sn_[i];
                op[cA + l31] = f2bf(x1 * c - x2 * sn); op[cB + l31] = f2bf(x1 * sn + x2 * c);
            } else { op[cA + l31] = f2bf(acc0[i] * r); op[cB + l31] = f2bf(acc1[i] * r); }
        }
    }
}
__device__ __forceinline__ void narrow_gate(LAS unsigned char* lds, const bf16_t* xb, const bf16_t* Wg, bf16_t* qkv, const float* rss, const float* gss) {
    const int tid = opaque_tid(), lane = tid & 63, wid = __builtin_amdgcn_readfirstlane(tid >> 6), lr = tid >> 4, lc = tid & 15;
    for (int j = blockIdx.x; j < 32; j += gridDim.x) {
        const int cA = j * 64, head = j >> 3;
        f32x16 acc0, acc1;
        __syncthreads(); narrow_scales(lds, rss, tid);
        if (tid < 256) { const float2 gp = *(const float2*)(gss + ((size_t)(NP + tid) * 4 + head) * 2); ((LAS float*)(lds + 81920 + 1024))[tid] = __builtin_amdgcn_rsqf((gp.x + gp.y) * (1.0f / 512.0f) + EPS); }
        narrow_core(lds, xb + (size_t)(NP + lr) * DM + lc * 8, DM, Wg + (size_t)(cA + lr) * DM + lc * 8, Wg + (size_t)(cA + 32 + lr) * DM + lc * 8, DM, acc0, acc1, tid, lane, wid);
        int lz = lane; asm volatile("" : "+v"(lz)); const int hl = lz >> 5, l31 = lz & 31;
        unsigned short ob0[16], ob1[16];
#pragma unroll
        for (int i = 0; i < 16; ++i) { const bf16_t* op = qkv + (size_t)(NP + 32 * wid + (i & 3) + 8 * (i >> 2) + 4 * hl) * 4096 + 2048 + cA + l31; ob0[i] = op[0]; ob1[i] = op[32]; }
#pragma unroll
        for (int i = 0; i < 16; ++i) {
            const int rs = 32 * wid + (i & 3) + 8 * (i >> 2) + 4 * hl; const float r = ((const LAS float*)(lds + 81920))[rs], rn = ((const LAS float*)(lds + 81920 + 1024))[rs];
            bf16_t* op = qkv + (size_t)(NP + rs) * 4096 + 2048 + cA + l31;
            const float o0 = __uint_as_float(((unsigned)ob0[i]) << 16), o1 = __uint_as_float(((unsigned)ob1[i]) << 16);
            op[0] = f2bf(silu_f(acc0[i] * r) * o0 * rn); op[32] = f2bf(silu_f(acc1[i] * r) * o1 * rn);
        }
    }
}
__device__ __forceinline__ void narrow_res(LAS unsigned char* lds, const bf16_t* A, int lda, const bf16_t* Bt, int K, const EpiRes& E, int ldb = 0, int kstep = 0) {
    const int tid = opaque_tid(), lane = tid & 63, wid = __builtin_amdgcn_readfirstlane(tid >> 6), lr = tid >> 4, lc = tid & 15;
    for (int j = blockIdx.x; j < 16; j += gridDim.x) {
        const int pn = j >> 2, wc = j & 3, c0 = pn * 256 + wc * 32;
        f32x16 acc0, acc1;
        __syncthreads();
        const int ldb_ = ldb ? ldb : K, ko = pn * kstep;
        narrow_core(lds, A + (size_t)(NP + lr) * lda + ko + lc * 8, lda, Bt + (size_t)(c0 + lr) * ldb_ + ko + lc * 8, Bt + (size_t)(c0 + 128 + lr) * ldb_ + ko + lc * 8, K, acc0, acc1, tid, lane, wid);
        float sq[16];
        int lz = lane; asm volatile("" : "+v"(lz)); const int hl = lz >> 5, l31 = lz & 31;
        float bb0[16], bb1[16];
#pragma unroll
        for (int i = 0; i < 16; ++i) { const float* bp = E.base_s + (size_t)(32 * wid + (i & 3) + 8 * (i >> 2) + 4 * hl) * DM + c0 + l31; bb0[i] = bp[0]; bb1[i] = bp[128]; }
#pragma unroll
        for (int i = 0; i < 16; ++i) {
            const int rs = 32 * wid + (i & 3) + 8 * (i >> 2) + 4 * hl;
            const float v0 = bb0[i] + acc0[i], v1 = bb1[i] + acc1[i];
            float* xo = E.xres + (size_t)(NP + rs) * DM + c0 + l31; xo[0] = v0; xo[128] = v1;
            bf16_t* bo = E.xb + (size_t)(NP + rs) * DM + c0 + l31; bo[0] = f2bf(v0); bo[128] = f2bf(v1);
            sq[i] = v0 * v0 + v1 * v1;
        }
        float s8[8], s4[4], s2[2], s1;
        { const bool bit = (lane & 16) != 0;
#pragma unroll
          for (int i = 0; i < 8; ++i) { const float keep = bit ? sq[i + 8] : sq[i], send = bit ? sq[i] : sq[i + 8]; s8[i] = keep + __shfl_xor(send, 16); } }
        { const bool bit = (lane & 8) != 0;
#pragma unroll
          for (int i = 0; i < 4; ++i) { const float keep = bit ? s8[i + 4] : s8[i], send = bit ? s8[i] : s8[i + 4]; s4[i] = keep + __shfl_xor(send, 8); } }
        { const bool bit = (lane & 4) != 0;
#pragma unroll
          for (int i = 0; i < 2; ++i) { const float keep = bit ? s4[i + 2] : s4[i], send = bit ? s4[i] : s4[i + 2]; s2[i] = keep + __shfl_xor(send, 4); } }
        { const bool bit = (lane & 2) != 0; const float keep = bit ? s2[1] : s2[0], send = bit ? s2[0] : s2[1]; s1 = keep + __shfl_xor(send, 2); }
        s1 += __shfl_xor(s1, 1);
        const int idx = (lane >> 1) & 15, rs = 32 * wid + (idx & 3) + 8 * (idx >> 2) + 4 * hl;
        if ((lane & 1) == 0) E.rss_next[(size_t)(NP + rs) * 16 + pn * 4 + wc] = s1;
    }
}

__device__ __forceinline__ void run_phase(const Params& p_, LAS unsigned char* lds, int ph_) {
    const bool nonarrow = false; const int ph = ph_ >= 100 ? ph_ - 100 : ph_;
    Params p = p_; { size_t z0 = 0, z1 = 0; asm volatile("" : "+s"(z0), "+s"(z1)); p.ws = p_.ws + z0; p.out = p_.out + z1; }
    bf16_t* xb = (bf16_t*)(p.ws + WS_XB); bf16_t* qkv = (bf16_t*)(p.ws + WS_QKV); float* rss = (float*)(p.ws + WS_RSS); float* gss = (float*)(p.ws + WS_GSS);
    const bf16_t* Wri = (const bf16_t*)(p.ws + WS_WRI); const bf16_t* Wro = (const bf16_t*)(p.ws + WS_WRO); const bf16_t* Wpl = (const bf16_t*)(p.ws + WS_WPL);
    const bf16_t* Wfi = (const bf16_t*)(p.ws + WS_WFI); const bf16_t* Wfo = (const bf16_t*)(p.ws + WS_WFO);
    float* xres = p.out;
    if (ph == NPHASE - 1) { phase_final(p); return; }
    int layer, step;
    if (ph < 9) { layer = 0; step = ph - 1; } else if (ph < 13) { layer = 1; step = ph - 9; } else if (ph < 21) { layer = 2; step = ph - 13; } else { layer = 3; step = ph - 21; }
    const int jl = layer >> 1;
    const bool is_ret = (layer & 1) == 0;
    const int fstep = is_ret ? step - 6 : step - 2;
    if (step == 0 && layer >= 1) { convert_ffn(p, lds, layer); if (layer + 1 < 4) convert_mixer(p, lds, layer + 1); __syncthreads(); }
    if (fstep == 0) { EpiFfn E{qkv, rss + (size_t)(2 * layer + 1) * NTOK * 16}; run_gemm(lds, xb, 1024, Wfi, 5632, 1024, E, NP); if (!nonarrow) narrow_ffn(lds, xb, Wfi, qkv, rss + (size_t)(2 * layer + 1) * NTOK * 16); return; }
    if (fstep == 1) { EpiRes E{xres, xres + (size_t)NP * DM, xres, xb, rss + (size_t)(2 * layer + 2) * NTOK * 16}; run_gemm(lds, qkv, DFF, Wfo, 1024, DFF, E, NP); narrow_res(lds, qkv, DFF, Wfo, DFF, E); return; }
    if (is_ret) {
        if (step == 0) { EpiQKV E{qkv, rss + (size_t)(2 * layer) * NTOK * 16, (const float*)(p.ws + WS_COS), (const float*)(p.ws + WS_SIN)}; run_gemm(lds, xb, 1024, Wri, 4096, 1024, E, NP); if (!nonarrow) narrow_qkv(lds, xb, Wri, qkv, rss + (size_t)(2 * layer) * NTOK * 16, (const float*)(p.ws + WS_COS), (const float*)(p.ws + WS_SIN)); }
        else if (step == 1) phase_scan_local(p, lds);
        else if (step == 2) phase_scan_prefix(p, jl);
        else if (step == 3) phase_scan(p, lds, jl);
        else if (step == 4) { EpiGate E{qkv, rss + (size_t)(2 * layer) * NTOK * 16, gss + (size_t)jl * NTOK * 8}; run_gemm(lds, xb, 1024, Wri + (size_t)4096 * 1024, 2048, 1024, E, NP); narrow_gate(lds, xb, Wri + (size_t)4096 * 1024, qkv, rss + (size_t)(2 * layer) * NTOK * 16, gss + (size_t)jl * NTOK * 8); }
        else if (step == 5) {
            const float* bp = layer == 0 ? p.x_prompt : xres; const float* bs = layer == 0 ? p.x_sample : xres + (size_t)NP * DM;
            EpiRes E{bp, bs, xres, xb, rss + (size_t)(2 * layer + 1) * NTOK * 16};
            run_gemm(lds, qkv + 2048, 4096, Wro, 1024, 2048, E, NP); narrow_res(lds, qkv + 2048, 4096, Wro, 2048, E);
        }
    } else {
        if (step == 0) phase_pool_prep(p, lds, layer);
        else if (step == 1) { EpiRes E{xres, xres + (size_t)NP * DM, xres, xb, rss + (size_t)(2 * layer + 1) * NTOK * 16}; pg8::Gemm g{qkv, Wpl, NP, 1024, 256, 1024, 1024}; PoolOrder S; S.init(NP, 1024, (int)gridDim.x, (int)blockIdx.x);
            pg8::gemm_phase<EpiRes, PoolOrder, false>(lds, g, S, E, nullptr); narrow_res(lds, qkv, 1024, Wpl, 256, E, 1024, 256); }
    }
}

__global__ void __launch_bounds__(512) mega(Params p) {
    extern __shared__ __attribute__((aligned(16))) unsigned char lds_raw[];
    LAS unsigned char* lds = (LAS unsigned char*)lds_raw;
    volatile LAS unsigned* bst = (volatile LAS unsigned*)(lds + LDS_MAIN);
    if (threadIdx.x == 0) { bst[0] = 0u; bst[1] = 0u; }
    __syncthreads();
    const XcdBarrier gbar = xcd_barrier_post((unsigned*)(p.ws + WS_BAR), bst);
#define GRID_SYNC() xcd_barrier(gbar)
#ifdef MK_PRE_SYNCS
    for (int i = 0; i < MK_PRE_SYNCS; ++i) GRID_SYNC();
#endif
#ifdef MK_PRE_MASK
#define MK_PRE(PH) if ((MK_PRE_MASK >> PH) & 1) { if (PH == 0) phase0(p, lds); else run_phase(p, lds, PH); GRID_SYNC(); }
    MK_PRE(0) MK_PRE(1) MK_PRE(2) MK_PRE(3) MK_PRE(4) MK_PRE(5) MK_PRE(6) MK_PRE(7) MK_PRE(8) MK_PRE(9) MK_PRE(10) MK_PRE(11) MK_PRE(12) MK_PRE(25)
#endif
    int ph = p.ph_lo;
    if (p.ph_hi < 0) cg::this_grid().sync();
    if (ph == 0) { phase0(p, lds); ++ph; if (ph < p.ph_hi) { GRID_SYNC(); } }
#ifdef MK_PRE_PH
    ph = 1 - MK_PRE_REP;
#endif
    for (; ph < p.ph_hi; ++ph) {
#ifdef MK_PRE_PH
        const int phx = (ph < 1) ? MK_PRE_PH + 100 : ph;
#else
        const int phx = ph;
#endif
        run_phase(p, lds, phx);
        if (ph + 1 < p.ph_hi) { GRID_SYNC(); }
    }
}
}

#ifndef MK_SINGLE
#define MK_SINGLE 1
#endif
extern "C" void kernel_launch(void* const* d_in, const int* in_sizes, int n_in, void* d_out, int out_size, void* d_ws, size_t ws_size, hipStream_t stream) {
    static int grid = 0;
    constexpr int LDS_BYTES = mk::LDS_TOTAL;
    if (grid == 0) {
        int dev = 0, cus = 0, per_cu = 0;
        hipGetDevice(&dev); hipDeviceGetAttribute(&cus, hipDeviceAttributeMultiprocessorCount, dev);
        if (hipFuncSetAttribute((const void*)mk::mega, hipFuncAttributeMaxDynamicSharedMemorySize, LDS_BYTES) != hipSuccess) { fprintf(stderr, "hipFuncSetAttribute failed\n"); }
        if (hipOccupancyMaxActiveBlocksPerMultiprocessor(&per_cu, (const void*)mk::mega, 512, LDS_BYTES) != hipSuccess || per_cu < 1) { fprintf(stderr, "occupancy query: %d\n", per_cu); per_cu = 1; }
        (void)hipGetLastError();
        grid = cus * (per_cu < 1 ? 1 : per_cu);
        if (grid <= 0) grid = 256;
    }
    if (ws_size < mk::WS_END) { fprintf(stderr, "workspace too small: %zu < %zu\n", ws_size, (size_t)mk::WS_END); return; }
    mk::Params p{};
    p.x_prompt = (const float*)d_in[0]; p.x_sample = (const float*)d_in[1]; p.state_ret = (const float*)d_in[2]; p.state_pool = (const float*)d_in[3];
    p.norm_mix = (const float*)d_in[4]; p.w_ret_in = (const float*)d_in[5]; p.w_ret_out = (const float*)d_in[6]; p.w_pool = (const float*)d_in[7];
    p.pool_scale = (const float*)d_in[8]; p.norm_ffn = (const float*)d_in[9]; p.w_ffn_in = (const float*)d_in[10]; p.w_ffn_out = (const float*)d_in[11]; p.norm_final = (const float*)d_in[12];
    p.out = (float*)d_out; p.ws = (unsigned char*)d_ws;
#if MK_SINGLE
    hipMemsetAsync((unsigned char*)d_ws + mk::WS_BAR, 0, XCD_BAR_WORDS * 4, stream);
    p.ph_lo = 0; p.ph_hi = mk::NPHASE;
    void* args[] = {&p};
    hipError_t e = hipLaunchCooperativeKernel((const void*)mk::mega, dim3(grid), dim3(512), args, LDS_BYTES, stream);
    if (e != hipSuccess) fprintf(stderr, "cooperative launch failed: %s (grid %d)\n", hipGetErrorString(e), grid);
#else
#ifndef MK_STOP
#define MK_STOP 23
#endif
    for (int ph = 0; ph < mk::NPHASE; ++ph) {
        p.ph_lo = ph; p.ph_hi = ph + 1;
        hipLaunchKernelGGL(mk::mega, dim3(grid), dim3(512), LDS_BYTES, stream, p);
    }
#endif
}
```

```cpp
#include <hip/hip_runtime.h>
#include <hip/hip_cooperative_groups.h>
#include <cstdio>
namespace cg = cooperative_groups;
#define LDS_BARRIER() asm volatile("s_waitcnt lgkmcnt(0)\n\ts_barrier" ::: "memory")
__device__ __forceinline__ int opaque_tid() { int t = (int)threadIdx.x; asm volatile("" : "+v"(t)); return t; }
namespace pg8 {
#define PG8_LAS __attribute__((address_space(3)))
typedef unsigned short bf16_t;
typedef short bf16x8 __attribute__((ext_vector_type(8)));
typedef float f32x4 __attribute__((ext_vector_type(4)));
typedef unsigned u32x4 __attribute__((ext_vector_type(4)));
constexpr int BM = 256, BK = 64, HALF = 128, HTB = HALF * BK * 2  , STAGE_BYTES = 8 * HTB, NXCD = 8, WGM = 8;

__host__ __device__ __forceinline__ int lds_byte(int r, int c) { const int st = (r >> 4) * 2 + (c >> 5), rr = r & 15, cc = c & 31, ob = rr * 64 + cc * 2; return st * 1024 + (ob ^ (((ob >> 9) & 1) << 5)); }
__host__ __device__ __forceinline__ void stage_rc(int b, int& R, int& C) { const int st = b / 1024, sb = b % 1024, swz = sb ^ (((sb >> 9) & 1) << 5); R = (st >> 1) * 16 + swz / 64; C = (st & 1) * 32 + (swz % 64) / 2; }
__host__ __device__ __forceinline__ int perm32(int rho) { const int n = rho >> 4, i = rho & 15; return 8 * (i >> 2) + 4 * n + (i & 3); }

struct Unit { int pm, pn, kofs; };
struct Gemm { const bf16_t* A; const bf16_t* Bt; int M, N, K, lda, ldb; };

struct StaticOrder {
    int nM, nN, nwg, G, c;
    __host__ __device__ void init(int M, int N, int G_, int c_) { nM = M / BM; nN = N / BM; nwg = nM * nN; G = G_; c = c_; }
    __host__ __device__ bool next(int i, Unit& u) const {
        const long L = (long)i * G + c; if (L >= nwg) return false;
        int wgid = (int)L; { const int q = nwg / NXCD, r = nwg % NXCD, xcd = wgid % NXCD, off = wgid / NXCD; wgid = (xcd < r ? xcd * (q + 1) : r * (q + 1) + (xcd - r) * q) + off; }
        const int nig = WGM * nN, gid = wgid / nig, fm = gid * WGM, gsz = (nM - fm) < WGM ? (nM - fm) : WGM;
        u.pm = fm + ((wgid % nig) % gsz); u.pn = (wgid % nig) / gsz; u.kofs = 0; return true;
    }
    __device__ __forceinline__ void a_ready(const Unit&) const {}
    __device__ __forceinline__ void done(const Unit&) const {}
};
struct CountedOrder : StaticOrder {
    const unsigned* ready; unsigned need; unsigned* tmo;
    __device__ __forceinline__ void a_ready(const Unit& u) const {
        if (threadIdx.x < 64) {
            const unsigned long long t0 = __builtin_amdgcn_s_memrealtime(); unsigned polls = 0;
            while ((unsigned)__builtin_amdgcn_readfirstlane(__hip_atomic_load(ready + 64 * u.pm, __ATOMIC_RELAXED, __HIP_MEMORY_SCOPE_AGENT)) < need) {
                if ((++polls & 255u) == 0u && __builtin_amdgcn_readfirstlane(__hip_atomic_load(tmo, __ATOMIC_RELAXED, __HIP_MEMORY_SCOPE_AGENT)) != 0u) break;
                if (__builtin_amdgcn_s_memrealtime() - t0 > 2000000ull) {
                    if (threadIdx.x == 0) { unsigned expect = 0u; __hip_atomic_compare_exchange_strong(tmo + 1, &expect, 0x600u | (unsigned)(u.pm & 0xff), __ATOMIC_RELAXED, __ATOMIC_RELAXED, __HIP_MEMORY_SCOPE_AGENT); __hip_atomic_store(tmo, 1u, __ATOMIC_RELAXED, __HIP_MEMORY_SCOPE_AGENT); }
                    break; }
                __builtin_amdgcn_s_sleep(2); }
            __builtin_amdgcn_fence(__ATOMIC_ACQUIRE, "agent");
            asm volatile("s_waitcnt vmcnt(0)" ::: "memory");
        }
#if !defined(BROKEN_HOOK_NO_BARRIER)
        asm volatile("" ::: "memory"); __builtin_amdgcn_s_barrier(); asm volatile("" ::: "memory");
#endif
    }
};

__device__ __forceinline__ unsigned cvt_pk_bf16(float lo, float hi) { unsigned r; asm volatile("v_cvt_pk_bf16_f32 %0, %1, %2" : "=v"(r) : "v"(lo), "v"(hi)); return r; }
typedef float f32x2 __attribute__((ext_vector_type(2)));
__device__ __forceinline__ f32x2 gelu_pk(f32x2 v) {
    const f32x2 av = __builtin_elementwise_abs(v), d = av * 0.2316418882f + 1.0f;
    f32x2 t; t.x = __builtin_amdgcn_rcpf(d.x); t.y = __builtin_amdgcn_rcpf(d.y);
    f32x2 q = t * 0.5307027145f + (-0.7265760135f); q = q * t + 0.7107068705f; q = q * t + (-0.142248368f); q = q * t + 0.127414796f; q = q * t;
    const f32x2 s = (v * v) * (-0.72134752044f);
    f32x2 e; e.x = __builtin_amdgcn_exp2f(s.x); e.y = __builtin_amdgcn_exp2f(s.y);
    const f32x2 m = v * (q * e), r = v - m;
    f32x2 o; o.x = v.x < 0.f ? m.x : r.x; o.y = v.y < 0.f ? m.y : r.y; return o;
}

struct EpiF32 {
    static constexpr bool PERM = false, AFTER_DRAIN = false;
    float* C; int ldc; const float* bias;
    __device__ __forceinline__ void operator()(const f32x4 (&acc)[2][2][4][2], const Unit& u, int wr, int wc, int fr_, int fq_) const {
        const int tl_ = opaque_tid(), fr = tl_ & 15, fq = (tl_ >> 4) & 3; (void)fr_; (void)fq_;
        const int row0 = u.pm * BM + wr * 64 + fr, col0 = u.pn * BM + wc * 32 + 4 * fq;
        f32x4 bv[2][2];
#pragma unroll
        for (int bj = 0; bj < 2; ++bj)
#pragma unroll
            for (int n = 0; n < 2; ++n) bv[bj][n] = bias ? *(const f32x4*)(bias + col0 + bj * HALF + n * 16) : (f32x4){0.f, 0.f, 0.f, 0.f};
#pragma unroll
        for (int ai = 0; ai < 2; ++ai)
#pragma unroll
            for (int m = 0; m < 4; ++m) { float* rowp = C + (size_t)(row0 + ai * HALF + m * 16) * ldc + col0;
#pragma unroll
                for (int bj = 0; bj < 2; ++bj)
#pragma unroll
                    for (int n = 0; n < 2; ++n) *(f32x4*)(rowp + bj * HALF + n * 16) = acc[ai][bj][m][n] + bv[bj][n]; }
    }
};
template <int ACT  > struct EpiBf16 {
    static constexpr bool PERM = true, AFTER_DRAIN = false;
    bf16_t* O; int ldc; const float* bias; int split_cols; size_t split_stride;
    __device__ __forceinline__ void operator()(const f32x4 (&acc)[2][2][4][2], const Unit& u, int wr, int wc, int fr_, int fq_) const {
        const int tl_ = opaque_tid(), fr = tl_ & 15, fq = (tl_ >> 4) & 3; (void)fr_; (void)fq_;
        const int row0 = u.pm * BM + wr * 64 + fr; int colt = u.pn * BM; bf16_t* base = O;
        if (split_cols) { const int t = colt / split_cols; base += (size_t)t * split_stride; colt -= t * split_cols; }
        const int col0 = colt + wc * 32 + 8 * fq, bcol0 = u.pn * BM + wc * 32 + 8 * fq;
        f32x4 bv[2][2];
#pragma unroll
        for (int bj = 0; bj < 2; ++bj)
#pragma unroll
            for (int n = 0; n < 2; ++n) bv[bj][n] = bias ? *(const f32x4*)(bias + bcol0 + bj * HALF + 4 * n) : (f32x4){0.f, 0.f, 0.f, 0.f};
#pragma unroll
        for (int ai = 0; ai < 2; ++ai)
#pragma unroll
            for (int m = 0; m < 4; ++m) { bf16_t* rowp = base + (size_t)(row0 + ai * HALF + m * 16) * ldc + col0;
#pragma unroll
                for (int bj = 0; bj < 2; ++bj) { f32x4 v0 = acc[ai][bj][m][0] + bv[bj][0], v1 = acc[ai][bj][m][1] + bv[bj][1];
                    if (ACT == 1) { f32x2 a = gelu_pk((f32x2){v0[0], v0[1]}), b = gelu_pk((f32x2){v0[2], v0[3]}), c = gelu_pk((f32x2){v1[0], v1[1]}), d = gelu_pk((f32x2){v1[2], v1[3]});
                        v0 = (f32x4){a.x, a.y, b.x, b.y}; v1 = (f32x4){c.x, c.y, d.x, d.y}; }
                    if (ACT == 2) {
#pragma unroll
                        for (int j = 0; j < 4; ++j) { v0[j] = 0.5f * v0[j] * (1.0f + erff(v0[j] * 0.70710678f)); v1[j] = 0.5f * v1[j] * (1.0f + erff(v1[j] * 0.70710678f)); } }
                    u32x4 w; w.x = cvt_pk_bf16(v0[0], v0[1]); w.y = cvt_pk_bf16(v0[2], v0[3]); w.z = cvt_pk_bf16(v1[0], v1[1]); w.w = cvt_pk_bf16(v1[2], v1[3]);
                    *(u32x4*)(rowp + bj * HALF) = w; } }
    }
};

template <class Epi, class Sched, bool STAMP = false>
__device__ __forceinline__ void gemm_phase(PG8_LAS unsigned char* lds, const Gemm g, const Sched& S, const Epi& E, unsigned long long* stamps) {
    const int tid = opaque_tid(), wid = __builtin_amdgcn_readfirstlane(tid >> 6), lane = tid & 63, wr = wid >> 2, wc = wid & 3, fr = lane & 15, fq = lane >> 4;
    const int K = g.K, nt = K / BK, lda = g.lda, ldb = g.ldb;
    int ts_lo = 0, ts_hi = 0, nts = 0; const unsigned long long rt_entry = STAMP ? (unsigned long long)wall_clock64() : 0ull;
#define PG8_STAMP() do { if (STAMP && wid == 0 && nts < 64) { const unsigned long long _c = (unsigned long long)clock64(); \
        ts_lo = (lane == nts) ? (int)(unsigned)_c : ts_lo; ts_hi = (lane == nts) ? (int)(unsigned)(_c >> 32) : ts_hi; ++nts; } } while (0)
    PG8_STAMP();
    unsigned voffA[2], voffB[2];
#pragma unroll
    for (int i = 0; i < 2; ++i) { int R, C; stage_rc(tid * 16 + i * 8192, R, C); const int Rb = Epi::PERM ? ((R & ~31) + perm32(R & 31)) : R;
        voffA[i] = (unsigned)(R * lda + C) * 2u; voffB[i] = (unsigned)(Rb * ldb + C) * 2u; }
    const size_t kstep = (size_t)(BK * 2);
    const size_t hstep = (size_t)HALF * ldb * 2;
    const size_t tstep = 2 * hstep; const size_t hstepA = (size_t)HALF * lda * 2, tstepA = 2 * hstepA;
    const unsigned ldsw = (unsigned)wid * 1024u;
    const int aoff = lds_byte(wr * 64 + fr, fq * 8), boff = lds_byte(wc * 32 + fr, fq * 8);
#define PG8_SA(b, h) (((b) * 2 + (h)) * HTB)
#define PG8_SB(b, h) ((4 + (b) * 2 + (h)) * HTB)
#define PG8_STAGE(bufoff, gbase, voff) do { _Pragma("unroll") for (int _i = 0; _i < 2; ++_i) \
        __builtin_amdgcn_global_load_lds((const unsigned*)((const char*)(gbase) + (voff)[_i]), (PG8_LAS unsigned*)(lds + (bufoff) + ldsw + _i * 8192), 16, 0, 0); } while (0)
#define PG8_LDA(dst, b, h) do { _Pragma("unroll") for (int m = 0; m < 4; ++m) _Pragma("unroll") for (int k = 0; k < 2; ++k) dst[m][k] = *(const PG8_LAS bf16x8*)(lds + PG8_SA(b, h) + aoff + m * 2048 + k * 1024); } while (0)
#define PG8_LDB(dst, b, h) do { _Pragma("unroll") for (int n = 0; n < 2; ++n) _Pragma("unroll") for (int k = 0; k < 2; ++k) dst[n][k] = *(const PG8_LAS bf16x8*)(lds + PG8_SB(b, h) + boff + n * 2048 + k * 1024); } while (0)
#define PG8_MMA(ai, bj, At, Bt) do { __builtin_amdgcn_s_setprio(1); _Pragma("unroll") for (int m = 0; m < 4; ++m) _Pragma("unroll") for (int n = 0; n < 2; ++n) _Pragma("unroll") for (int k = 0; k < 2; ++k) \
        acc[ai][bj][m][n] = __builtin_amdgcn_mfma_f32_16x16x32_bf16(Bt[n][k], At[m][k], acc[ai][bj][m][n], 0, 0, 0); __builtin_amdgcn_s_setprio(0); } while (0)
#define PG8_WAIT_V(n) asm volatile("s_waitcnt vmcnt(" #n ")" ::: "memory")
#define PG8_WAIT_L(n) asm volatile("s_waitcnt lgkmcnt(" #n ")" ::: "memory")
#define PG8_BAR __builtin_amdgcn_s_barrier()
#define PG8_SCHED __builtin_amdgcn_sched_barrier(0)
    Unit cur, nxt; int ui = 0;
    if (!S.next(0, cur)) return;
    f32x4 acc[2][2][4][2];
#pragma unroll
    for (int a = 0; a < 2; ++a)
#pragma unroll
        for (int b = 0; b < 2; ++b)
#pragma unroll
            for (int m = 0; m < 4; ++m)
#pragma unroll
                for (int n = 0; n < 2; ++n) acc[a][b][m][n] = (f32x4){0.f, 0.f, 0.f, 0.f};
    bf16x8 At[4][2], B0[2][2], B1[2][2];
    const char* cA = (const char*)g.A + (size_t)cur.pm * tstepA + (size_t)cur.kofs * 2; const char* cB = (const char*)g.Bt + (size_t)cur.pn * tstep + (size_t)cur.kofs * 2;
    S.a_ready(cur);
    PG8_STAGE(PG8_SB(0, 0), cB, voffB); PG8_STAGE(PG8_SA(0, 0), cA, voffA); PG8_STAGE(PG8_SB(0, 1), cB + hstep, voffB); PG8_STAGE(PG8_SA(0, 1), cA + hstepA, voffA);
    if (wr == 1) PG8_BAR;
    PG8_WAIT_V(4); PG8_BAR;
    PG8_STAGE(PG8_SB(1, 0), cB + kstep, voffB); PG8_STAGE(PG8_SA(1, 0), cA + kstep, voffA); PG8_STAGE(PG8_SB(1, 1), cB + hstep + kstep, voffB);
    PG8_WAIT_V(6); PG8_BAR;
    PG8_STAMP();
    for (;;) {
        const bool has_next = S.next(ui + 1, nxt);
        const char* nA = has_next ? (const char*)g.A + (size_t)nxt.pm * tstepA + (size_t)nxt.kofs * 2 : cA; const char* nB = has_next ? (const char*)g.Bt + (size_t)nxt.pn * tstep + (size_t)nxt.kofs * 2 : cB;
        for (int t = 0; t < nt; t += 2) {
            const bool last = (t == nt - 2);
            const char* a1 = cA + (size_t)(t + 1) * kstep;
            const char* a2 = last ? nA : cA + (size_t)(t + 2) * kstep; const char* b2 = last ? nB : cB + (size_t)(t + 2) * kstep;
            const char* a3 = a2 + kstep; const char* b3 = b2 + kstep;
            if (last && has_next) S.a_ready(nxt);
            PG8_LDB(B0, 0, 0); PG8_SCHED; PG8_LDA(At, 0, 0); PG8_STAGE(PG8_SA(1, 1), a1 + hstepA, voffA);
            PG8_WAIT_L(8); PG8_BAR; PG8_WAIT_L(0); PG8_MMA(0, 0, At, B0); PG8_BAR; PG8_SCHED;
            PG8_LDB(B1, 0, 1); PG8_STAGE(PG8_SB(0, 0), b2, voffB);
            PG8_BAR; PG8_WAIT_L(0); PG8_MMA(0, 1, At, B1); PG8_BAR;
            PG8_LDA(At, 0, 1); PG8_STAGE(PG8_SA(0, 0), a2, voffA);
            PG8_BAR; PG8_WAIT_L(0); PG8_MMA(1, 0, At, B0); PG8_BAR; PG8_SCHED;
            PG8_STAGE(PG8_SB(0, 1), b2 + hstep, voffB);
            PG8_WAIT_V(6); PG8_BAR; PG8_MMA(1, 1, At, B1); PG8_BAR;
            PG8_LDB(B0, 1, 0); PG8_SCHED; PG8_LDA(At, 1, 0); PG8_STAGE(PG8_SA(0, 1), a2 + hstepA, voffA);
            PG8_WAIT_L(8); PG8_BAR; PG8_WAIT_L(0); PG8_MMA(0, 0, At, B0); PG8_BAR; PG8_SCHED;
            PG8_LDB(B1, 1, 1); PG8_STAGE(PG8_SB(1, 0), b3, voffB);
            PG8_BAR; PG8_WAIT_L(0); PG8_MMA(0, 1, At, B1); PG8_BAR;
            PG8_LDA(At, 1, 1); PG8_STAGE(PG8_SA(1, 0), a3, voffA);
            PG8_BAR; PG8_WAIT_L(0); PG8_MMA(1, 0, At, B0); PG8_BAR; PG8_SCHED;
            PG8_STAGE(PG8_SB(1, 1), b3 + hstep, voffB);
            PG8_WAIT_V(6); PG8_BAR; PG8_MMA(1, 1, At, B1); PG8_BAR;
        }
        PG8_STAMP();
        if constexpr (!Epi::AFTER_DRAIN) { E(acc, cur, wr, wc, fr, fq); S.done(cur); }
        PG8_STAMP();
        if (!has_next) break;
#pragma unroll
        for (int a = 0; a < 2; ++a)
#pragma unroll
            for (int b = 0; b < 2; ++b)
#pragma unroll
                for (int m = 0; m < 4; ++m)
#pragma unroll
                    for (int n = 0; n < 2; ++n) acc[a][b][m][n] = (f32x4){0.f, 0.f, 0.f, 0.f};
        cur = nxt; cA = nA; cB = nB; ++ui;
    }
    PG8_WAIT_V(0);
    if (wr == 0) PG8_BAR;
    PG8_BAR;
    if constexpr (Epi::AFTER_DRAIN) { E.fused(acc, cur, wr, wc, fr, fq, lds, wid, lane); S.done(cur); }
    PG8_STAMP();
    if (STAMP && wid == 0) { stamps[lane] = lane < nts ? (((unsigned long long)(unsigned)ts_hi << 32) | (unsigned)ts_lo) : 0ull;
        if (lane == 62) stamps[62] = rt_entry; if (lane == 63) stamps[63] = (unsigned long long)wall_clock64(); }
#undef PG8_STAMP
#undef PG8_SA
#undef PG8_SB
#undef PG8_STAGE
#undef PG8_LDA
#undef PG8_LDB
#undef PG8_MMA
#undef PG8_WAIT_V
#undef PG8_WAIT_L
#undef PG8_BAR
#undef PG8_SCHED
}
}

#define XB_TMO      128
#define XB_XCNT(j)  (256  + 64 * (j))
#define XB_XSUB(j)  (1280 + 64 * (j))
#define XB_XGEN(j)  (2304 + 64 * (j))
#define XB_TOP      3328
#define XB_TOPGEN   3392
#define XCD_BAR_WORDS 3456
#define XB_SPIN_CAP (1u << 18)
#define LAS __attribute__((address_space(3)))

__device__ __forceinline__ unsigned xb_ld(unsigned* p)              { return __hip_atomic_load(p, __ATOMIC_RELAXED, __HIP_MEMORY_SCOPE_AGENT); }
__device__ __forceinline__ unsigned xb_add(unsigned* p, unsigned v) { return __hip_atomic_fetch_add(p, v, __ATOMIC_RELAXED, __HIP_MEMORY_SCOPE_AGENT); }
__device__ __forceinline__ unsigned xb_xcc_id() { return (unsigned)__builtin_amdgcn_s_getreg((3 << 11) | 20) & 0xFu; }
#define XB_SPIN(cond, bar) do { unsigned _sp = 0; while (cond) { __builtin_amdgcn_s_sleep(1); \
    if ((++_sp & 255u) == 0u) { if (xb_ld(&(bar)[XB_TMO])) break; if (_sp > XB_SPIN_CAP) { atomicAdd(&(bar)[XB_TMO], 1u); break; } } } } while (0)

struct XcdBarrier {
    unsigned* bar; unsigned x;
    volatile LAS unsigned* st;
};

__device__ __forceinline__ XcdBarrier xcd_barrier_post(unsigned* bar, volatile LAS unsigned* st) {
    XcdBarrier b; b.bar = bar; b.x = xb_xcc_id(); b.st = st;
    if (threadIdx.x == 0) (void)xb_add(&bar[XB_XCNT(b.x)], 1u);
    return b;
}
__device__ __forceinline__ void xcd_barrier_complete(unsigned* bar, unsigned x, unsigned& nloc, unsigned& nx) {
    const unsigned G = gridDim.x * gridDim.y * gridDim.z;
    unsigned sum, cnt, mine, sp = 0u;
    for (;;) {
        sum = 0u; cnt = 0u; mine = 0u;
#pragma unroll
        for (unsigned j = 0; j < 16; ++j) { const unsigned c = xb_ld(&bar[XB_XCNT(j)]); sum += c; cnt += (c > 0u) ? 1u : 0u; mine = (j == x) ? c : mine; }
        if (sum == G) break;
        __builtin_amdgcn_s_sleep(1);
        if ((++sp & 255u) == 0u) { if (xb_ld(&bar[XB_TMO])) break; if (sp > XB_SPIN_CAP) { atomicAdd(&bar[XB_TMO], 1u); break; } }
    }
    nloc = mine > 0u ? mine : 1u; nx = cnt > 0u ? cnt : 1u;
}

__device__ __forceinline__ void xcd_barrier(const XcdBarrier& b) {
    asm volatile("s_waitcnt vmcnt(0)" ::: "memory");
    __syncthreads();
    if (threadIdx.x == 0) {
        unsigned* bar = b.bar;
        __builtin_amdgcn_s_waitcnt(0);
        unsigned nloc = b.st[0], nx = b.st[1];
        if (nloc == 0u) { xcd_barrier_complete(bar, b.x, nloc, nx); b.st[0] = nloc; b.st[1] = nx; }
        const unsigned old = xb_add(&bar[XB_XSUB(b.x)], 1u);
        const unsigned gen = old / nloc;
        if (old + 1u == (gen + 1u) * nloc) {
            __builtin_amdgcn_fence(__ATOMIC_RELEASE, "agent");
            asm volatile("s_waitcnt vmcnt(0)" ::: "memory");
            const unsigned og = xb_add(&bar[XB_TOP], 1u);
            const unsigned tg = og / nx;
            if (og + 1u == (tg + 1u) * nx) xb_add(&bar[XB_TOPGEN], 1u);
            else XB_SPIN(xb_ld(&bar[XB_TOPGEN]) == tg, bar);
            __builtin_amdgcn_fence(__ATOMIC_ACQUIRE, "agent");
            xb_add(&bar[XB_XGEN(b.x)], 1u);
            asm volatile("s_waitcnt vmcnt(0)" ::: "memory");
        } else {
            XB_SPIN(xb_ld(&bar[XB_XGEN(b.x)]) == gen, bar);
            __builtin_amdgcn_fence(__ATOMIC_ACQUIRE, "agent");
            asm volatile("s_waitcnt vmcnt(0)" ::: "memory");
        }
    }
    __syncthreads();
}

namespace mk {
using pg8::bf16_t; using pg8::bf16x8; using pg8::f32x4; using pg8::u32x4; using pg8::Unit; using pg8::cvt_pk_bf16;
typedef float f32x16 __attribute__((ext_vector_type(16)));
typedef short s16x4 __attribute__((ext_vector_type(4)));
typedef unsigned u32x2 __attribute__((ext_vector_type(2)));

constexpr int NTOK = 33024, NP = 32768, DM = 1024, SEQ = 16384, DFF = 2816;
constexpr float EPS = 1e-6f;
constexpr int NPHASE = 26;
constexpr int LDS_MAIN = 141312, LDS_TOTAL = LDS_MAIN + 16;
constexpr size_t OUT_RETP = 33816576, OUT_RETS = 35913728, OUT_POOLP = 52690944, OUT_POOLS = 52752384;
constexpr size_t WS_WRI = 0, WS_WRO = 12582912, WS_WPL = 16777216, WS_WFI = 18874368, WS_WFO = 30408704, WS_XB = 36175872,
                 WS_QKV = 103809024, WS_T = 374341632, WS_COS = 441450496, WS_SIN = 449839104, WS_RSS = 458227712, WS_GSS = 477249536, WS_BAR = 494157824, WS_END = 494174208;

struct Params {
    const float *x_prompt, *x_sample, *state_ret, *state_pool, *norm_mix, *w_ret_in, *w_ret_out, *w_pool, *pool_scale, *norm_ffn, *w_ffn_in, *w_ffn_out, *norm_final;
    float* out; unsigned char* ws; int ph_lo, ph_hi;
};

__device__ __forceinline__ float lg2gamma(int h) { return h == 0 ? -0.04580368961312479f : h == 1 ? -0.02272007650008353f : h == 2 ? -0.011315313227834146f : -0.005646563141142063f; }
__device__ __forceinline__ float sum16(const float* p) {
    const float4 a = *(const float4*)p, b = *(const float4*)(p + 4), c = *(const float4*)(p + 8), d = *(const float4*)(p + 12);
    return (((a.x + a.y) + (a.z + a.w)) + ((b.x + b.y) + (b.z + b.w))) + (((c.x + c.y) + (c.z + c.w)) + ((d.x + d.y) + (d.z + d.w)));
}
__device__ __forceinline__ float rs_row(const float* rssrow) { return __builtin_amdgcn_rsqf(sum16(rssrow) * (1.0f / 1024.0f) + EPS); }
__device__ __forceinline__ float silu_f(float v) { return v * __builtin_amdgcn_rcpf(1.0f + __builtin_amdgcn_exp2f(v * -1.4426950408889634f)); }
__device__ __forceinline__ bf16_t f2bf(float f) { unsigned u = __float_as_uint(f); u += 0x7FFFu + ((u >> 16) & 1u); return (bf16_t)(u >> 16); }
__device__ __forceinline__ float bf2f(unsigned short b) { return __uint_as_float(((unsigned)b) << 16); }

__device__ __forceinline__ void row_scales(float (&r)[8], const float* rss, int row0, int fq) {
    float4 q[8];
#pragma unroll
    for (int i = 0; i < 8; ++i) q[i] = *(const float4*)(rss + (size_t)(row0 + (i >> 2) * 128 + (i & 3) * 16) * 16 + fq * 4);
#pragma unroll
    for (int i = 0; i < 8; ++i) { float t = (q[i].x + q[i].y) + (q[i].z + q[i].w); t += __shfl_xor(t, 16); t += __shfl_xor(t, 32); r[i] = __builtin_amdgcn_rsqf(t * (1.0f / 1024.0f) + EPS); }
}
struct EpiQKV {
    static constexpr bool PERM = true, AFTER_DRAIN = false;
    bf16_t* O; const float* rss; const float* cosT; const float* sinT;
    __device__ __forceinline__ void operator()(const f32x4 (&acc)[2][2][4][2], const Unit& u, int wr, int wc, int fr_, int fq_) const {
        const int tl_ = opaque_tid(), fr = tl_ & 15, fq = (tl_ >> 4) & 3; (void)fr_; (void)fq_;
        const int row0 = u.pm * 256 + wr * 64 + fr, cin = wc * 32 + 8 * fq;
        const bool rot = u.pn < 8; const float lg = lg2gamma(u.pn & 3);
        float rr[8]; row_scales(rr, rss, row0, fq);
        u32x4 wout[8][2];
#pragma unroll
        for (int am = 0; am < 4; ++am) {
            const int ai = am >> 1;
            f32x4 ct[2][2], st[2][2];
            if (rot) {
#pragma unroll
                for (int mm = 0; mm < 2; ++mm) {
                    const int row = row0 + ai * 128 + ((am & 1) * 2 + mm) * 16; const int pos = (row < NP) ? (row & (SEQ - 1)) : 1024 + ((row - NP) & 15);
#pragma unroll
                    for (int n = 0; n < 2; ++n) { ct[mm][n] = *(const f32x4*)(cosT + (size_t)pos * 128 + cin + 4 * n); st[mm][n] = *(const f32x4*)(sinT + (size_t)pos * 128 + cin + 4 * n); }
                }
            }
#pragma unroll
            for (int mm = 0; mm < 2; ++mm) {
                const int m = (am & 1) * 2 + mm;
                const int row = row0 + ai * 128 + m * 16;
                const float r = rr[ai * 4 + m];
                int l, Lc;
                if (row < NP) { l = row & 63; Lc = 64; } else { l = (row - NP) & 15; Lc = 16; }
                f32x4 o1[2], o2[2];
                if (rot) {
                    const float e = (u.pn < 4) ? (float)(l + 1) : (float)(Lc - 1 - l);
                    const float dec = exp2f(e * lg) * r;
#pragma unroll
                    for (int n = 0; n < 2; ++n) {
                        const f32x4 c4 = ct[mm][n], s4 = st[mm][n];
                        const f32x4 x1 = acc[ai][0][m][n] * dec, x2 = acc[ai][1][m][n] * dec;
                        o1[n] = x1 * c4 - x2 * s4; o2[n] = x1 * s4 + x2 * c4;
                    }
                } else {
#pragma unroll
                    for (int n = 0; n < 2; ++n) { o1[n] = acc[ai][0][m][n] * r; o2[n] = acc[ai][1][m][n] * r; }
                }
                u32x4 w; w.x = cvt_pk_bf16(o1[0][0], o1[0][1]); w.y = cvt_pk_bf16(o1[0][2], o1[0][3]); w.z = cvt_pk_bf16(o1[1][0], o1[1][1]); w.w = cvt_pk_bf16(o1[1][2], o1[1][3]);
                wout[ai * 4 + m][0] = w;
                w.x = cvt_pk_bf16(o2[0][0], o2[0][1]); w.y = cvt_pk_bf16(o2[0][2], o2[0][3]); w.z = cvt_pk_bf16(o2[1][0], o2[1][1]); w.w = cvt_pk_bf16(o2[1][2], o2[1][3]);
                wout[ai * 4 + m][1] = w;
            }
        }
#pragma unroll
        for (int i = 0; i < 8; ++i) {
            bf16_t* rowp = O + (size_t)(row0 + (i >> 2) * 128 + (i & 3) * 16) * 4096 + u.pn * 256 + cin;
            *(u32x4*)rowp = wout[i][0]; *(u32x4*)(rowp + 128) = wout[i][1];
        }
    }
};
struct EpiGate {
    static constexpr bool PERM = true, AFTER_DRAIN = false;
    bf16_t* QKV; const float* rss; const float* gss;
    __device__ __forceinline__ void operator()(const f32x4 (&acc)[2][2][4][2], const Unit& u, int wr, int wc, int fr_, int fq_) const {
        const int tl_ = opaque_tid(), fr = tl_ & 15, fq = (tl_ >> 4) & 3; (void)fr_; (void)fq_;
        const int row0 = u.pm * 256 + wr * 64 + fr, cin = wc * 32 + 8 * fq, head = u.pn >> 1;
        float rr[8]; row_scales(rr, rss, row0, fq);
        u32x4 wout[8][2];
#pragma unroll
        for (int ai = 0; ai < 2; ++ai) {
            u32x4 ovs[4][2]; float2 gps[4];
#pragma unroll
            for (int i = 0; i < 4; ++i) {
                const int row = row0 + ai * 128 + i * 16; const bf16_t* rp = QKV + (size_t)row * 4096 + 2048 + u.pn * 256 + cin;
                ovs[i][0] = *(const u32x4*)rp; ovs[i][1] = *(const u32x4*)(rp + 128); gps[i] = *(const float2*)(gss + ((size_t)row * 4 + head) * 2);
            }
#pragma unroll
            for (int m = 0; m < 4; ++m) {
                const float r = rr[ai * 4 + m];
                const float rn = __builtin_amdgcn_rsqf((gps[m].x + gps[m].y) * (1.0f / 512.0f) + EPS);
#pragma unroll
                for (int bj = 0; bj < 2; ++bj) {
                    const u32x4 ov = ovs[m][bj];
                    float g[8], o[8];
#pragma unroll
                    for (int j = 0; j < 4; ++j) { g[j] = acc[ai][bj][m][0][j] * r; g[4 + j] = acc[ai][bj][m][1][j] * r; }
                    o[0] = __uint_as_float(ov.x << 16); o[1] = __uint_as_float(ov.x & 0xffff0000u); o[2] = __uint_as_float(ov.y << 16); o[3] = __uint_as_float(ov.y & 0xffff0000u);
                    o[4] = __uint_as_float(ov.z << 16); o[5] = __uint_as_float(ov.z & 0xffff0000u); o[6] = __uint_as_float(ov.w << 16); o[7] = __uint_as_float(ov.w & 0xffff0000u);
                    float y[8];
#pragma unroll
                    for (int j = 0; j < 8; ++j) y[j] = silu_f(g[j]) * o[j] * rn;
                    u32x4 w; w.x = cvt_pk_bf16(y[0], y[1]); w.y = cvt_pk_bf16(y[2], y[3]); w.z = cvt_pk_bf16(y[4], y[5]); w.w = cvt_pk_bf16(y[6], y[7]);
                    wout[ai * 4 + m][bj] = w;
                }
            }
        }
#pragma unroll
        for (int i = 0; i < 8; ++i) {
            bf16_t* rowp = QKV + (size_t)(row0 + (i >> 2) * 128 + (i & 3) * 16) * 4096 + 2048 + u.pn * 256 + cin;
            *(u32x4*)rowp = wout[i][0]; *(u32x4*)(rowp + 128) = wout[i][1];
        }
    }
};
struct EpiFfn {
    static constexpr bool PERM = true, AFTER_DRAIN = false;
    bf16_t* ACT; const float* rss;
    __device__ __forceinline__ void operator()(const f32x4 (&acc)[2][2][4][2], const Unit& u, int wr, int wc, int fr_, int fq_) const {
        const int tl_ = opaque_tid(), fr = tl_ & 15, fq = (tl_ >> 4) & 3; (void)fr_; (void)fq_;
        const int row0 = u.pm * 256 + wr * 64 + fr, cout = u.pn * 128 + wc * 16 + 4 * fq;
        float rr[8]; row_scales(rr, rss, row0, fq);
#pragma unroll
        for (int ai = 0; ai < 2; ++ai)
#pragma unroll
            for (int m = 0; m < 4; ++m) {
                const int row = row0 + ai * 128 + m * 16;
                const float r = rr[ai * 4 + m];
                bf16_t* rowp = ACT + (size_t)row * DFF + cout;
#pragma unroll
                for (int bj = 0; bj < 2; ++bj) {
                    const f32x4 a = acc[ai][bj][m][0] * r, b = acc[ai][bj][m][1] * r;
                    u32x2 w; w.x = cvt_pk_bf16(silu_f(a[0]) * b[0], silu_f(a[1]) * b[1]); w.y = cvt_pk_bf16(silu_f(a[2]) * b[2], silu_f(a[3]) * b[3]);
                    *(u32x2*)(rowp + bj * 64) = w;
                }
            }
    }
};
struct EpiRes {
    static constexpr bool PERM = false, AFTER_DRAIN = false;
    const float* base_p; const float* base_s; float* xres; bf16_t* xb; float* rss_next;
    __device__ __forceinline__ void operator()(const f32x4 (&acc)[2][2][4][2], const Unit& u, int wr, int wc, int fr_, int fq_) const {
        const int tl_ = opaque_tid(), fr = tl_ & 15, fq = (tl_ >> 4) & 3; (void)fr_; (void)fq_;
        const int row0 = u.pm * 256 + wr * 64 + fr, col0 = u.pn * 256 + wc * 32 + 4 * fq;
#pragma unroll
        for (int ai = 0; ai < 2; ++ai) {
            f32x4 bv[4][4];
#pragma unroll
            for (int m = 0; m < 4; ++m) {
                const int row = row0 + ai * 128 + m * 16;
                const float* bp = (row < NP) ? base_p + (size_t)row * DM : base_s + (size_t)(row - NP) * DM;
#pragma unroll
                for (int q = 0; q < 4; ++q) bv[m][q] = *(const f32x4*)(bp + col0 + (q >> 1) * 128 + (q & 1) * 16);
            }
#pragma unroll
            for (int m = 0; m < 4; ++m) {
                const int row = row0 + ai * 128 + m * 16;
                float ss = 0.f;
#pragma unroll
                for (int bj = 0; bj < 2; ++bj)
#pragma unroll
                    for (int n = 0; n < 2; ++n) {
                        const int c = col0 + bj * 128 + n * 16;
                        const f32x4 v = bv[m][bj * 2 + n] + acc[ai][bj][m][n];
                        *(f32x4*)(xres + (size_t)row * DM + c) = v;
                        u32x2 w; w.x = cvt_pk_bf16(v[0], v[1]); w.y = cvt_pk_bf16(v[2], v[3]);
                        if (xb) *(u32x2*)(xb + (size_t)row * DM + c) = w;
                        ss += (v[0] * v[0] + v[1] * v[1]) + (v[2] * v[2] + v[3] * v[3]);
                    }
                ss += __shfl_xor(ss, 16); ss += __shfl_xor(ss, 32);
                if (fq == 0) rss_next[(size_t)row * 16 + u.pn * 4 + wc] = ss;
            }
        }
    }
};

struct MapId { __device__ __forceinline__ float scale(int) const { return 1.f; } __device__ __forceinline__ int drow(int n) const { return n; } };
struct MapRetIn { __device__ __forceinline__ float scale(int n) const { return (n >= 1024 && n < 2048) ? 0.0625f : 1.f; } __device__ __forceinline__ int drow(int n) const { return n; } };
struct MapFfnIn { __device__ __forceinline__ float scale(int) const { return 1.f; }
    __device__ __forceinline__ int drow(int n) const { const int isb = n >= DFF, j = n - isb * DFF; return (j >> 2) * 8 + isb * 4 + (j & 3); } };
struct MapPool { const float* cs; __device__ __forceinline__ float scale(int n) const { return cs[n]; } __device__ __forceinline__ int drow(int n) const { return n; } };

template <class MapF>
__device__ __forceinline__ void conv_T(LAS unsigned char* lds, const float* src, int K, int Nsrc, int ldsrc, bf16_t* dst, int lddst, const float* gain, const MapF map) {
    const int tid = opaque_tid(), tk = K >> 6, tn = Nsrc >> 8, ntile = tk * tn;
    LAS bf16_t* tile = (LAS bf16_t*)lds;
    for (int t = blockIdx.x; t < ntile; t += gridDim.x) {
        const int k0 = (t % tk) << 6, n0 = (t / tk) << 8;
        {
            const int kk = tid >> 3, nn = (tid & 7) * 8; const float* sp = src + (size_t)(k0 + kk) * ldsrc + n0 + nn;
            const float gk = gain ? gain[k0 + kk] : 1.f;
            float4 a[4], b[4];
#pragma unroll
            for (int q = 0; q < 4; ++q) { a[q] = *(const float4*)(sp + q * 64); b[q] = *(const float4*)(sp + q * 64 + 4); }
#pragma unroll
            for (int q = 0; q < 4; ++q) {
                const int nb = q * 64 + nn; LAS bf16_t* tp = tile + nb * 72 + kk;
                tp[0 * 72] = f2bf(a[q].x * gk * map.scale(n0 + nb + 0)); tp[1 * 72] = f2bf(a[q].y * gk * map.scale(n0 + nb + 1));
                tp[2 * 72] = f2bf(a[q].z * gk * map.scale(n0 + nb + 2)); tp[3 * 72] = f2bf(a[q].w * gk * map.scale(n0 + nb + 3));
                tp[4 * 72] = f2bf(b[q].x * gk * map.scale(n0 + nb + 4)); tp[5 * 72] = f2bf(b[q].y * gk * map.scale(n0 + nb + 5));
                tp[6 * 72] = f2bf(b[q].z * gk * map.scale(n0 + nb + 6)); tp[7 * 72] = f2bf(b[q].w * gk * map.scale(n0 + nb + 7));
            }
        }
        __syncthreads();
        {
            const int nn = tid >> 3, kc = (tid & 7) * 8;
#pragma unroll
            for (int q = 0; q < 4; ++q) {
                const u32x4 raw = *(const LAS u32x4*)(tile + (q * 64 + nn) * 72 + kc);
                *(u32x4*)(dst + (size_t)map.drow(n0 + q * 64 + nn) * lddst + k0 + kc) = raw;
            }
        }
        __syncthreads();
    }
}
__device__ __forceinline__ void convert_ret(const Params& p, LAS unsigned char* lds, int j) {
    conv_T(lds, p.w_ret_in + (size_t)j * 1024 * 6144, 1024, 6144, 6144, (bf16_t*)(p.ws + WS_WRI), 1024, p.norm_mix + (size_t)(2 * j) * DM, MapRetIn{});
    conv_T(lds, p.w_ret_out + (size_t)j * 2048 * 1024, 2048, 1024, 1024, (bf16_t*)(p.ws + WS_WRO), 2048, nullptr, MapId{});
}
__device__ __forceinline__ void convert_pool(const Params& p, LAS unsigned char* lds, int j) {
    bf16_t* W = (bf16_t*)(p.ws + WS_WPL);
    for (size_t i = (size_t)blockIdx.x * blockDim.x + opaque_tid(); i < (size_t)1024 * 128; i += (size_t)gridDim.x * blockDim.x) {
        const int n = (int)(i >> 7), k = (int)(i & 127) * 8;
        if ((n >> 8) != (k >> 8)) { unsigned z = 0u; asm volatile("" : "+v"(z)); *(u32x4*)(W + (size_t)n * 1024 + k) = (u32x4){z, z, z, z}; }
    }
    for (int g = 0; g < 4; ++g)
        conv_T(lds, p.w_pool + ((size_t)j * 4 + g) * 65536, 256, 256, 256, W + (size_t)(g * 256) * 1024 + g * 256, 1024, nullptr, MapPool{p.pool_scale + (size_t)j * DM + g * 256});
}
__device__ __forceinline__ void convert_ffn(const Params& p, LAS unsigned char* lds, int i) {
    conv_T(lds, p.w_ffn_in + (size_t)i * 1024 * 5632, 1024, 5632, 5632, (bf16_t*)(p.ws + WS_WFI), 1024, p.norm_ffn + (size_t)i * DM, MapFfnIn{});
    conv_T(lds, p.w_ffn_out + (size_t)i * DFF * 1024, DFF, 1024, 1024, (bf16_t*)(p.ws + WS_WFO), DFF, nullptr, MapId{});
}
__device__ __forceinline__ void convert_mixer(const Params& p, LAS unsigned char* lds, int layer) { if (layer & 1) convert_pool(p, lds, layer >> 1); else convert_ret(p, lds, layer >> 1); }

__device__ __forceinline__ void phase0(const Params& p, LAS unsigned char* lds) {
    const int tid = opaque_tid(), lane = tid & 63, wid = tid >> 6;
    bf16_t* xb = (bf16_t*)(p.ws + WS_XB); float* rss = (float*)(p.ws + WS_RSS);
    for (int row = blockIdx.x * 8 + wid; row < NTOK; row += gridDim.x * 8) {
        const float* src = (row < NP) ? p.x_prompt + (size_t)row * DM : p.x_sample + (size_t)(row - NP) * DM;
        float ss = 0.f;
#pragma unroll
        for (int i = 0; i < 4; ++i) {
            const float4 v = *(const float4*)(src + i * 256 + lane * 4);
            ss += (v.x * v.x + v.y * v.y) + (v.z * v.z + v.w * v.w);
            u32x2 w; w.x = cvt_pk_bf16(v.x, v.y); w.y = cvt_pk_bf16(v.z, v.w);
            *(u32x2*)(xb + (size_t)row * DM + i * 256 + lane * 4) = w;
        }
#pragma unroll
        for (int o = 32; o >= 1; o >>= 1) ss += __shfl_xor(ss, o);
        if (lane < 16) rss[(size_t)row * 16 + lane] = (lane == 0) ? ss : 0.f;
    }
    const size_t gt = (size_t)blockIdx.x * blockDim.x + tid, nth = (size_t)gridDim.x * blockDim.x;
    float* cosT = (float*)(p.ws + WS_COS); float* sinT = (float*)(p.ws + WS_SIN);
    for (size_t i = gt; i < (size_t)SEQ * 128; i += nth) {
        const int pos = (int)(i >> 7), j = (int)(i & 127);
        const double inv = exp2(-(double)j * 0.10381025296523007), t = (double)pos * inv * 0.31830988618379067154;
        double s, c; sincospi(t, &s, &c);
        cosT[i] = (float)c; sinT[i] = (float)s;
    }
    convert_mixer(p, lds, 0); convert_mixer(p, lds, 1); convert_ffn(p, lds, 0);
}

template <int W>
__device__ __forceinline__ void pool_unit(const float* xres, const float* sp, const LAS float* rl, bf16_t* dbuf, float* po, int rowbase, int t0, int c0, float g0, float g1, bool isS, bool lastu) {
    float2 hv[15 + W];
#pragma unroll
    for (int i = 0; i < 15 + W; ++i) {
        const int t = t0 - (W - 1) + i;
        float2 v = make_float2(0.f, 0.f);
        if (t >= 0) { const float2 x = *(const float2*)(xres + (size_t)(rowbase + t) * DM + c0); const float r = rl[i + 16 - W]; v = make_float2(x.x * r * g0, x.y * r * g1); }
        else if (isS) v = *(const float2*)(sp + (size_t)(15 + t) * DM + c0);
        hv[i] = v;
    }
    float2 s = make_float2(0.f, 0.f);
#pragma unroll
    for (int i = 0; i < W - 1; ++i) { s.x += hv[i].x; s.y += hv[i].y; }
#pragma unroll
    for (int k = 0; k < 16; ++k) {
        const float2 h = hv[W - 1 + k];
        s.x += h.x; s.y += h.y;
        const float inv = 1.0f / (isS ? (float)W : (float)min(t0 + k + 1, W));
        *(unsigned*)(dbuf + (size_t)(rowbase + t0 + k) * DM + c0) = cvt_pk_bf16(s.x * inv - h.x, s.y * inv - h.y);
        if (lastu && k >= 1) *(float2*)(po + (size_t)(k - 1) * DM + c0) = h;
        s.x -= hv[k].x; s.y -= hv[k].y;
    }
}
__device__ __forceinline__ void phase_pool_prep(const Params& p, LAS unsigned char* lds, int layer) {
    const int j = layer >> 1, tid = opaque_tid(), c0 = tid * 2, gi = __builtin_amdgcn_readfirstlane(tid >> 7);
    const float* xres = p.out; const float* rssc = (const float*)(p.ws + WS_RSS) + (size_t)(2 * layer) * NTOK * 16;
    const float g0 = p.norm_mix[(size_t)layer * DM + c0], g1 = p.norm_mix[(size_t)layer * DM + c0 + 1];
    bf16_t* dbuf = (bf16_t*)(p.ws + WS_QKV);
    LAS float* rl = (LAS float*)lds;
    for (int u = blockIdx.x; u < 2064; u += gridDim.x) {
        int t0, rowbase; bool isS, lastu; const float* sp = nullptr; float* po;
        if (u < 2048) { const int b = u >> 10; t0 = (u & 1023) * 16; rowbase = b * SEQ; isS = false; lastu = (u & 1023) == 1023; po = p.out + OUT_POOLP + ((size_t)(j * 2 + b) * 15) * DM; }
        else { const int sb = u - 2048; t0 = 0; rowbase = NP + sb * 16; isS = true; lastu = true; sp = p.state_pool + ((size_t)(j * 16 + sb) * 15) * DM; po = p.out + OUT_POOLS + ((size_t)(j * 16 + sb) * 15) * DM; }
        __syncthreads();
        if (tid < 31) { const int t = t0 - 15 + tid; rl[tid] = (t >= 0) ? rs_row(rssc + (size_t)(rowbase + t) * 16) : 0.f; }
        __syncthreads();
        if (gi == 0) pool_unit<2>(xres, sp, rl, dbuf, po, rowbase, t0, c0, g0, g1, isS, lastu);
        else if (gi == 1) pool_unit<4>(xres, sp, rl, dbuf, po, rowbase, t0, c0, g0, g1, isS, lastu);
        else if (gi == 2) pool_unit<8>(xres, sp, rl, dbuf, po, rowbase, t0, c0, g0, g1, isS, lastu);
        else pool_unit<16>(xres, sp, rl, dbuf, po, rowbase, t0, c0, g0, g1, isS, lastu);
    }
}

__device__ __forceinline__ void phase_final(const Params& p) {
    const float* rssc = (const float*)(p.ws + WS_RSS) + (size_t)8 * NTOK * 16;
    for (size_t i = (size_t)blockIdx.x * blockDim.x + opaque_tid(); i < (size_t)NTOK * 256; i += (size_t)gridDim.x * blockDim.x) {
        const int row = (int)(i >> 8), c = (int)(i & 255) * 4;
        const float r = rs_row(rssc + (size_t)row * 16);
        const float4 g = *(const float4*)(p.norm_final + c);
        float4 v = *(const float4*)(p.out + (size_t)row * DM + c);
        v.x *= r * g.x; v.y *= r * g.y; v.z *= r * g.z; v.w *= r * g.w;
        *(float4*)(p.out + (size_t)row * DM + c) = v;
    }
}

__device__ __forceinline__ unsigned offb(unsigned row, unsigned ch) { return 256u * row + 16u * (ch ^ (((row & 3u) << 2) | ((row >> 2) & 3u))); }
__device__ __forceinline__ unsigned img_off(unsigned row, unsigned ch32) { return (ch32 >> 4) * 16384u + offb(row, ch32 & 15u); }
constexpr unsigned IMG_Q = 0, IMG_K = 32768, IMG_V = 65536, IMG_P = 98304, IMG_O = 107520;

__device__ __forceinline__ void tile_load(u32x4 (&r)[4], const bf16_t* g, int ld, int nvalid, int tid_) {
    int tid = tid_; asm volatile("" : "+v"(tid));
    const int r0 = (tid >> 5) & 15, ch = tid & 31;
    const bf16_t* gp = g + (size_t)r0 * ld + ch * 8;
    if (nvalid >= 64) {
#pragma unroll
        for (int i = 0; i < 4; ++i) r[i] = *(const u32x4*)(gp + (size_t)(16 * i) * ld);
    } else {
        r[0] = *(const u32x4*)gp;
        unsigned z = 0u; asm volatile("" : "+v"(z));
#pragma unroll
        for (int i = 1; i < 4; ++i) r[i] = (u32x4){z, z, z, z};
    }
}
__device__ __forceinline__ void tile_store(LAS unsigned char* img, const u32x4 (&r)[4], int tid_) {
    int tid = tid_; asm volatile("" : "+v"(tid));
    const unsigned r0 = (tid >> 5) & 15, ch = tid & 31;
    LAS unsigned char* bp = img + img_off(r0, ch);
#pragma unroll
    for (int i = 0; i < 4; ++i) *(LAS u32x4*)(bp + 4096 * i) = r[i];
}
__device__ __forceinline__ bf16x8 tr_frag(LAS unsigned char* img, int lane, int cblk  , int ks) {
    const unsigned h = lane >> 5, blk = (lane >> 4) & 1, q = (lane & 15) >> 2, pp = lane & 3;
    const unsigned c = cblk & 3;
    const unsigned lowc = 2 * blk + (pp >> 1);
    const unsigned chx0 = ((c ^ q) << 2) | (lowc ^ (2 * h)), chx1 = chx0 ^ 1u;
    const unsigned rb = 256u * (8 * h + q) + 8 * (pp & 1);
    const unsigned a0 = rb + 16u * chx0, a1 = rb + 1024u + 16u * chx1;
    LAS unsigned char* base = img + (cblk >> 2) * 16384 + ks * 4096;
    const s16x4 lo = __builtin_amdgcn_ds_read_tr16_b64_v4i16((LAS s16x4*)(base + a0));
    const s16x4 hi = __builtin_amdgcn_ds_read_tr16_b64_v4i16((LAS s16x4*)(base + a1));
    return __builtin_shufflevector(lo, hi, 0, 1, 2, 3, 4, 5, 6, 7);
}
__device__ __forceinline__ bf16x8 pack8(const f32x16& s, int base) {
    u32x4 w; w.x = cvt_pk_bf16(s[base + 0], s[base + 1]); w.y = cvt_pk_bf16(s[base + 2], s[base + 3]); w.z = cvt_pk_bf16(s[base + 4], s[base + 5]); w.w = cvt_pk_bf16(s[base + 6], s[base + 7]);
    return __builtin_bit_cast(bf16x8, w);
}

__device__ __forceinline__ void state_update(f32x16 (&S)[8], LAS unsigned char* kimg, const bf16x8 (&Vf)[4], int lane) {
#pragma unroll
    for (int dt = 0; dt < 8; ++dt)
#pragma unroll
        for (int ks = 0; ks < 4; ++ks) {
            const bf16x8 a = tr_frag(kimg, lane, dt, ks);
            S[dt] = __builtin_amdgcn_mfma_f32_32x32x16_bf16(a, Vf[ks], S[dt], 0, 0, 0);
        }
}

__device__ __forceinline__ void phase_scan_local(const Params& p, LAS unsigned char* lds) {
    const int tid = opaque_tid(), lane_ = tid & 63, wid = __builtin_amdgcn_readfirstlane(tid >> 6);
    const bf16_t* qkv = (const bf16_t*)(p.ws + WS_QKV); float* T = (float*)(p.ws + WS_T);
    for (int u_ = blockIdx.x; u_ < 256; u_ += gridDim.x) {
        const int u = (gridDim.x == 256) ? (((u_ >> 4) << 4) | ((u_ & 7) << 1) | ((u_ >> 3) & 1)) : u_;
        const int eh = u & 1, seg = (u >> 1) & 15, h = (u >> 5) & 3, b = u >> 7;
        const size_t row0 = (size_t)b * SEQ + (size_t)seg * 1024;
        const bf16_t* kb = qkv + row0 * 4096 + 1024 + h * 256; const bf16_t* vb = qkv + row0 * 4096 + 2048 + h * 512 + eh * 256;
        const float gC = exp2f(64.f * lg2gamma(h));
        f32x16 S[8];
#pragma unroll
        for (int i = 0; i < 8; ++i)
#pragma unroll
            for (int r = 0; r < 16; ++r) S[i][r] = 0.f;
        u32x4 rk0[4], rv0[4], rk1[4], rv1[4];
        tile_load(rk0, kb, 4096, 64, tid); tile_load(rv0, vb, 4096, 64, tid);
        tile_load(rk1, kb + (size_t)64 * 4096, 4096, 64, tid); tile_load(rv1, vb + (size_t)64 * 4096, 4096, 64, tid);
        LDS_BARRIER();
        tile_store(lds, rk0, tid); tile_store(lds + 32768, rv0, tid);
        LDS_BARRIER();
        tile_load(rk0, kb + (size_t)2 * 64 * 4096, 4096, 64, tid); tile_load(rv0, vb + (size_t)2 * 64 * 4096, 4096, 64, tid);
        for (int c = 0; c < 16; c += 2) {
            {
                int lane = lane_; asm volatile("" : "+v"(lane));
                tile_store(lds + 65536, rk1, tid); tile_store(lds + 98304, rv1, tid);
#pragma unroll
                for (int i = 0; i < 8; ++i) S[i] *= gC;
                bf16x8 Vf[4];
#pragma unroll
                for (int ks = 0; ks < 4; ++ks) Vf[ks] = tr_frag(lds + 32768, lane, wid, ks);
                state_update(S, lds, Vf, lane);
                LDS_BARRIER();
                if (c + 3 < 16) { tile_load(rk1, kb + (size_t)(c + 3) * 64 * 4096, 4096, 64, tid); tile_load(rv1, vb + (size_t)(c + 3) * 64 * 4096, 4096, 64, tid); }
            }
            {
                int lane = lane_; asm volatile("" : "+v"(lane));
                if (c + 2 < 16) { tile_store(lds, rk0, tid); tile_store(lds + 32768, rv0, tid); }
#pragma unroll
                for (int i = 0; i < 8; ++i) S[i] *= gC;
                bf16x8 Vf[4];
#pragma unroll
                for (int ks = 0; ks < 4; ++ks) Vf[ks] = tr_frag(lds + 98304, lane, wid, ks);
                state_update(S, lds + 65536, Vf, lane);
                LDS_BARRIER();
                if (c + 4 < 16) { tile_load(rk0, kb + (size_t)(c + 4) * 64 * 4096, 4096, 64, tid); tile_load(rv0, vb + (size_t)(c + 4) * 64 * 4096, 4096, 64, tid); }
            }
        }
        float* Tu = T + (size_t)u * 65536;
        int lz = lane_; asm volatile("" : "+v"(lz));
        const int hl = lz >> 5, e = wid * 32 + (lz & 31);
#pragma unroll
        for (int dt = 0; dt < 8; ++dt)
#pragma unroll
            for (int r = 0; r < 16; ++r) Tu[(size_t)(32 * dt + (r & 3) + 8 * (r >> 2) + 4 * hl) * 256 + e] = S[dt][r];
    }
}

__device__ __forceinline__ void phase_scan_prefix(const Params& p, int jl) {
    float* T = (float*)(p.ws + WS_T);
    const int gt = blockIdx.x * 512 + opaque_tid(), nth = gridDim.x * 512;
    for (int i = gt; i < 262144; i += nth) {
        const int grp = i >> 14, pos = (i & 16383) * 4, eh = grp & 1, bh = grp >> 1, h = bh & 3;
        const float gS = exp2f(1024.f * lg2gamma(h));
        float* base = T + ((size_t)(bh * 16) * 2 + eh) * 65536 + pos;
        float4 t[16];
#pragma unroll
        for (int j = 0; j < 16; ++j) t[j] = *(const float4*)(base + (size_t)j * 131072);
        float zf = 0.f; asm volatile("" : "+v"(zf));
        float4 run = make_float4(zf, zf, zf, zf);
#pragma unroll
        for (int j = 0; j < 16; ++j) {
            *(float4*)(base + (size_t)j * 131072) = run;
            run.x = run.x * gS + t[j].x; run.y = run.y * gS + t[j].y; run.z = run.z * gS + t[j].z; run.w = run.w * gS + t[j].w;
        }
        const int d = pos >> 8, e = pos & 255;
        *(float4*)(p.out + OUT_RETP + ((size_t)((jl * 2 + (bh >> 2)) * 4 + h) * 256 + d) * 512 + eh * 256 + e) = run;
    }
}

__device__ __forceinline__ void phase_scan(const Params& p, LAS unsigned char* lds, int jl) {
    const int tid = opaque_tid(), lane_ = tid & 63, wid = __builtin_amdgcn_readfirstlane(tid >> 6);
    bf16_t* qkv = (bf16_t*)(p.ws + WS_QKV); const float* T = (const float*)(p.ws + WS_T);
    float* gss = (float*)(p.ws + WS_GSS) + (size_t)jl * NTOK * 8;
    for (int v_ = blockIdx.x; v_ < 384; v_ += gridDim.x) {
        const int v = (gridDim.x == 256) ? ((v_ & 256) | (((v_ & 255) >> 4) << 4) | ((v_ & 7) << 1) | ((v_ >> 3) & 1)) : v_;
        int eh, h, Lc, nch; size_t row0; float* Sout = nullptr;
        f32x16 S[8];
        if (v < 256) {
            eh = v & 1; const int seg = (v >> 1) & 15; h = (v >> 5) & 3; const int b = v >> 7;
            row0 = (size_t)b * SEQ + (size_t)seg * 1024; Lc = 64; nch = 16;
            {
                int lz = lane_; asm volatile("" : "+v"(lz)); const int hl_ = lz >> 5, ecol_ = wid * 32 + (lz & 31);
                const float* Tu = T + (size_t)v * 65536;
#pragma unroll
                for (int dt = 0; dt < 8; ++dt)
#pragma unroll
                    for (int r = 0; r < 16; ++r) S[dt][r] = Tu[(size_t)(32 * dt + (r & 3) + 8 * (r >> 2) + 4 * hl_) * 256 + ecol_];
            }
        } else {
            const int su = v - 256; eh = su & 1; h = (su >> 1) & 3; const int sb = su >> 3;
            row0 = (size_t)NP + (size_t)sb * 16; Lc = 16; nch = 1;
            Sout = p.out + OUT_RETS + ((size_t)((jl * 16 + sb) * 4 + h) * 256) * 512 + eh * 256;
            int lz = lane_; asm volatile("" : "+v"(lz)); const int hl_ = lz >> 5, ecol_ = wid * 32 + (lz & 31);
            const float* Sin = p.state_ret + ((size_t)((jl * 16 + sb) * 4 + h) * 256) * 512 + eh * 256;
#pragma unroll
            for (int dt = 0; dt < 8; ++dt)
#pragma unroll
                for (int r = 0; r < 16; ++r) S[dt][r] = Sin[(size_t)(32 * dt + (r & 3) + 8 * (r >> 2) + 4 * hl_) * 512 + ecol_];
        }
        const float lg = lg2gamma(h), gC = exp2f((float)Lc * lg), gCinv = exp2f(-(float)Lc * lg);
        bf16_t* qb = qkv + row0 * 4096 + h * 256; bf16_t* kb = qkv + row0 * 4096 + 1024 + h * 256; bf16_t* vb = qkv + row0 * 4096 + 2048 + h * 512 + eh * 256;
        u32x4 rq[4], rk[4], rv[4];
        tile_load(rq, qb, 4096, Lc, tid); tile_load(rk, kb, 4096, Lc, tid); tile_load(rv, vb, 4096, Lc, tid);
        LDS_BARRIER();
        tile_store(lds + IMG_Q, rq, tid); tile_store(lds + IMG_K, rk, tid); tile_store(lds + IMG_V, rv, tid);
        LDS_BARRIER();
        for (int c = 0; c < nch; ++c) {
            int lane = lane_; asm volatile("" : "+v"(lane)); const int hl = lane >> 5, ecol = wid * 32 + (lane & 31);
            {
                const int mi = wid >> 1, nj0 = 2 * (wid & 1), l15 = lane & 15, l4 = lane >> 4;
                f32x4 sc[2] = {(f32x4){0.f, 0.f, 0.f, 0.f}, (f32x4){0.f, 0.f, 0.f, 0.f}};
#pragma unroll
                for (int s = 0; s < 8; ++s) {
                    const bf16x8 a = *(const LAS bf16x8*)(lds + IMG_K + img_off(16 * mi + l15, 4 * s + l4));
#pragma unroll
                    for (int t = 0; t < 2; ++t) {
                        const bf16x8 bq = *(const LAS bf16x8*)(lds + IMG_Q + img_off(16 * (nj0 + t) + l15, 4 * s + l4));
                        sc[t] = __builtin_amdgcn_mfma_f32_16x16x32_bf16(a, bq, sc[t], 0, 0, 0);
                    }
                }
#pragma unroll
                for (int t = 0; t < 2; ++t) {
                    const int n = 16 * (nj0 + t) + l15, m0 = 16 * mi + 4 * l4;
                    float pv[4];
#pragma unroll
                    for (int r = 0; r < 4; ++r) pv[r] = (n >= m0 + r) ? sc[t][r] * gCinv : 0.f;
                    u32x2 w; w.x = cvt_pk_bf16(pv[0], pv[1]); w.y = cvt_pk_bf16(pv[2], pv[3]);
                    *(LAS u32x2*)(lds + IMG_P + n * 144 + m0 * 2) = w;
                }
            }
            LDS_BARRIER();
            f32x16 o[2];
#pragma unroll
            for (int nt = 0; nt < 2; ++nt)
#pragma unroll
                for (int r = 0; r < 16; ++r) o[nt][r] = 0.f;
#pragma unroll
            for (int s = 0; s < 16; ++s) {
                const bf16x8 bs = pack8(S[s >> 1], 8 * (s & 1));
#pragma unroll
                for (int nt = 0; nt < 2; ++nt) {
                    const unsigned rown = 32 * nt + (lane & 31);
                    const u32x2 lo = *(const LAS u32x2*)(lds + IMG_Q + img_off(rown, 2 * s) + 8 * hl);
                    const u32x2 hi = *(const LAS u32x2*)(lds + IMG_Q + img_off(rown, 2 * s + 1) + 8 * hl);
                    const u32x4 aw = (u32x4){lo.x, lo.y, hi.x, hi.y};
                    o[nt] = __builtin_amdgcn_mfma_f32_32x32x16_bf16(__builtin_bit_cast(bf16x8, aw), bs, o[nt], 0, 0, 0);
                }
            }
            bf16x8 Vf[4];
#pragma unroll
            for (int ks = 0; ks < 4; ++ks) Vf[ks] = tr_frag(lds + IMG_V, lane, wid, ks);
#pragma unroll
            for (int ks = 0; ks < 4; ++ks)
#pragma unroll
                for (int nt = 0; nt < 2; ++nt) {
                    const bf16x8 a = *(const LAS bf16x8*)(lds + IMG_P + (32 * nt + (lane & 31)) * 144 + (16 * ks + 8 * hl) * 2);
                    o[nt] = __builtin_amdgcn_mfma_f32_32x32x16_bf16(a, Vf[ks], o[nt], 0, 0, 0);
                }
            {
                LAS unsigned char* oi = lds + IMG_O + (4 * hl) * 528 + ecol * 2;
#pragma unroll
                for (int nt = 0; nt < 2; ++nt)
#pragma unroll
                    for (int r = 0; r < 16; ++r) *(LAS bf16_t*)(oi + (32 * nt + (r & 3) + 8 * (r >> 2)) * 528) = (bf16_t)cvt_pk_bf16(o[nt][r], o[nt][r]);
            }
            if (c + 1 < nch) { tile_load(rk, kb + (size_t)(c + 1) * 64 * 4096, 4096, 64, tid); tile_load(rv, vb + (size_t)(c + 1) * 64 * 4096, 4096, 64, tid); }
#pragma unroll
            for (int i = 0; i < 8; ++i) S[i] *= gC;
            {
                int lane2 = lane_; asm volatile("" : "+v"(lane2));
                bf16x8 Vg[4];
#pragma unroll
                for (int ks = 0; ks < 4; ++ks) Vg[ks] = tr_frag(lds + IMG_V, lane2, wid, ks);
                state_update(S, lds + IMG_K, Vg, lane2);
            }
            __builtin_amdgcn_sched_barrier(0);
            LDS_BARRIER();
            if (c + 1 < nch) { tile_load(rq, qb + (size_t)(c + 1) * 64 * 4096, 4096, 64, tid); tile_store(lds + IMG_K, rk, tid); tile_store(lds + IMG_V, rv, tid); tile_store(lds + IMG_Q, rq, tid); }
            {
                int t2 = tid; asm volatile("" : "+v"(t2));
                const int r0 = (t2 >> 5) & 15, ch = t2 & 31;
                bf16_t* og = vb + (size_t)c * 64 * 4096 + (size_t)r0 * 4096 + ch * 8;
#pragma unroll
                for (int i = 0; i < 4; ++i) {
                    if (i == 0 || Lc == 64) {
                        const u32x4 w = *(const LAS u32x4*)(lds + IMG_O + (r0 + 16 * i) * 528 + ch * 16);
                        *(u32x4*)(og + (size_t)(16 * i) * 4096) = w;
                        const float a0 = __uint_as_float(w.x << 16), a1 = __uint_as_float(w.x & 0xffff0000u), a2 = __uint_as_float(w.y << 16), a3 = __uint_as_float(w.y & 0xffff0000u);
                        const float a4 = __uint_as_float(w.z << 16), a5 = __uint_as_float(w.z & 0xffff0000u), a6 = __uint_as_float(w.w << 16), a7 = __uint_as_float(w.w & 0xffff0000u);
                        float ss = ((a0 * a0 + a1 * a1) + (a2 * a2 + a3 * a3)) + ((a4 * a4 + a5 * a5) + (a6 * a6 + a7 * a7));
                        ss += __shfl_xor(ss, 16); ss += __shfl_xor(ss, 8); ss += __shfl_xor(ss, 4); ss += __shfl_xor(ss, 2); ss += __shfl_xor(ss, 1);
                        if (ch == 0) gss[((row0 + (size_t)c * 64 + r0 + 16 * i) * 4 + h) * 2 + eh] = ss;
                    }
                }
            }
            LDS_BARRIER();
        }
        if (Sout) {
            int lz = lane_; asm volatile("" : "+v"(lz)); const int hl_ = lz >> 5, ecol_ = wid * 32 + (lz & 31);
#pragma unroll
            for (int dt = 0; dt < 8; ++dt)
#pragma unroll
                for (int r = 0; r < 16; ++r) Sout[(size_t)(32 * dt + (r & 3) + 8 * (r >> 2) + 4 * hl_) * 512 + ecol_] = S[dt][r];
        }
    }
}

struct PoolOrder : pg8::StaticOrder {
    __device__ __forceinline__ bool next(int i, Unit& u) const { const bool ok = pg8::StaticOrder::next(i, u); if (ok) u.kofs = u.pn * 256; return ok; }
};
template <class Epi>
__device__ __forceinline__ void run_gemm(LAS unsigned char* lds, const bf16_t* A, int lda, const bf16_t* Bt, int N, int K, const Epi& E, int M = NTOK) {
    pg8::Gemm g{A, Bt, M, N, K, lda, K}; pg8::StaticOrder S; S.init(M, N, (int)gridDim.x, (int)blockIdx.x);
    pg8::gemm_phase<Epi, pg8::StaticOrder, false>(lds, g, S, E, nullptr);
}

__device__ __forceinline__ void narrow_core(LAS unsigned char* lds, const bf16_t* ag, int lda, const bf16_t* bg0, const bf16_t* bg1, int K, f32x16& acc0, f32x16& acc1, int tid, int lane, int wid) {
    const int lr = tid >> 4, lc = tid & 15, hl = lane >> 5, l31 = lane & 31;
#pragma unroll
    for (int i = 0; i < 16; ++i) { acc0[i] = 0.f; acc1[i] = 0.f; }
    u32x4 ra0[8], rb0[2], ra1[8], rb1[2];
#define NR_LOAD(RA, RB, KO) do { int ko_ = (KO); asm volatile("" : "+s"(ko_)); const bf16_t* agp = ag + ko_; const bf16_t* b0p = bg0 + ko_; const bf16_t* b1p = bg1 + ko_; \
        _Pragma("unroll") for (int q = 0; q < 8; ++q) { RA[q] = *(const u32x4*)agp; agp += (size_t)32 * lda; } \
        RB[0] = *(const u32x4*)b0p; RB[1] = *(const u32x4*)b1p; } while (0)
#define NR_STORE(RA, RB) do { _Pragma("unroll") for (int q = 0; q < 8; ++q) *(LAS u32x4*)(lds + (q >> 1) * 16384 + offb((q & 1) * 32 + lr, lc)) = RA[q]; \
        *(LAS u32x4*)(lds + 65536 + offb(lr, lc)) = RB[0]; *(LAS u32x4*)(lds + 65536 + offb(32 + lr, lc)) = RB[1]; } while (0)
#define NR_COMPUTE() do { LAS unsigned char* ai = lds + (wid >> 1) * 16384; const unsigned arow = (wid & 1) * 32 + l31; \
        _Pragma("unroll") for (int q = 0; q < 8; ++q) { \
            const bf16x8 a = *(const LAS bf16x8*)(ai + offb(arow, 2 * q + hl)); \
            const bf16x8 x0 = *(const LAS bf16x8*)(lds + 65536 + offb(l31, 2 * q + hl)); \
            const bf16x8 x1 = *(const LAS bf16x8*)(lds + 65536 + offb(32 + l31, 2 * q + hl)); \
            acc0 = __builtin_amdgcn_mfma_f32_32x32x16_bf16(a, x0, acc0, 0, 0, 0); acc1 = __builtin_amdgcn_mfma_f32_32x32x16_bf16(a, x1, acc1, 0, 0, 0); } } while (0)
    NR_LOAD(ra0, rb0, 0); NR_LOAD(ra1, rb1, 128);
    LDS_BARRIER();
    for (int k = 0; k < K; k += 256) {
        NR_STORE(ra0, rb0); LDS_BARRIER();
        if (k + 256 < K) NR_LOAD(ra0, rb0, k + 256);
        NR_COMPUTE(); LDS_BARRIER();
        NR_STORE(ra1, rb1); LDS_BARRIER();
        if (k + 384 < K) NR_LOAD(ra1, rb1, k + 384);
        NR_COMPUTE(); LDS_BARRIER();
    }
#undef NR_LOAD
#undef NR_STORE
#undef NR_COMPUTE
}
__device__ __forceinline__ void narrow_scales(LAS unsigned char* lds, const float* rss, int tid) {
    if (tid < 256) ((LAS float*)(lds + 81920))[tid] = rs_row(rss + (size_t)(NP + tid) * 16);
}
__device__ __forceinline__ void narrow_ffn(LAS unsigned char* lds, const bf16_t* xb, const bf16_t* Wfi, bf16_t* act, const float* rss) {
    const int tid = opaque_tid(), lane = tid & 63, wid = __builtin_amdgcn_readfirstlane(tid >> 6), lr = tid >> 4, lc = tid & 15;
    for (int j = blockIdx.x; j < 88; j += gridDim.x) {
        const int jj = 32 * j + lr, dra = (jj >> 2) * 8 + (jj & 3);
        f32x16 acc0, acc1;
        __syncthreads(); narrow_scales(lds, rss, tid);
        narrow_core(lds, xb + (size_t)(NP + lr) * DM + lc * 8, DM, Wfi + (size_t)dra * DM + lc * 8, Wfi + (size_t)(dra + 4) * DM + lc * 8, DM, acc0, acc1, tid, lane, wid);
        int lz = lane; asm volatile("" : "+v"(lz)); const int hl = lz >> 5, l31 = lz & 31;
#pragma unroll
        for (int i = 0; i < 16; ++i) {
            const int rs = 32 * wid + (i & 3) + 8 * (i >> 2) + 4 * hl; const float r = ((const LAS float*)(lds + 81920))[rs];
            act[(size_t)(NP + rs) * DFF + 32 * j + l31] = f2bf(silu_f(acc0[i] * r) * (acc1[i] * r));
        }
    }
}
__device__ __forceinline__ void narrow_qkv(LAS unsigned char* lds, const bf16_t* xb, const bf16_t* Wri, bf16_t* qkv, const float* rss, const float* cosT, const float* sinT) {
    const int tid = opaque_tid(), lane = tid & 63, wid = __builtin_amdgcn_readfirstlane(tid >> 6), lr = tid >> 4, lc = tid & 15;
    for (int j = blockIdx.x; j < 64; j += gridDim.x) {
        const bool rot = j < 32; const int hd = j >> 2, j0 = (j & 3) * 32;
        const int cA = rot ? hd * 256 + j0 : 2048 + (j - 32) * 64, cB = rot ? cA + 128 : cA + 32;
        f32x16 acc0, acc1;
        __syncthreads(); narrow_scales(lds, rss, tid);
        narrow_core(lds, xb + (size_t)(NP + lr) * DM + lc * 8, DM, Wri + (size_t)(cA + lr) * DM + lc * 8, Wri + (size_t)(cB + lr) * DM + lc * 8, DM, acc0, acc1, tid, lane, wid);
        int lz = lane; asm volatile("" : "+v"(lz)); const int hl = lz >> 5, l31 = lz & 31;
        const float lg = lg2gamma(hd & 3);
        float cs[16], sn_[16];
        if (rot) {
#pragma unroll
            for (int i = 0; i < 16; ++i) { const int l = (32 * wid + (i & 3) + 8 * (i >> 2) + 4 * hl) & 15; cs[i] = cosT[(size_t)(1024 + l) * 128 + j0 + l31]; sn_[i] = sinT[(size_t)(1024 + l) * 128 + j0 + l31]; }
        }
#pragma unroll
        for (int i = 0; i < 16; ++i) {
            const int rs = 32 * wid + (i & 3) + 8 * (i >> 2) + 4 * hl; const float r = ((const LAS float*)(lds + 81920))[rs];
            bf16_t* op = qkv + (size_t)(NP + rs) * 4096;
            if (rot) {
                const int l = rs & 15; const float e = (hd < 4) ? (float)(l + 1) : (float)(15 - l);
                const float dec = exp2f(e * lg) * r, x1 = acc0[i] * dec, x2 = acc1[i] * dec;
                const float c = cs[i], sn = sn_[i];
                op[cA + l31] = f2bf(x1 * c - x2 * sn); op[cB + l31] = f2bf(x1 * sn + x2 * c);
            } else { op[cA + l31] = f2bf(acc0[i] * r); op[cB + l31] = f2bf(acc1[i] * r); }
        }
    }
}
__device__ __forceinline__ void narrow_gate(LAS unsigned char* lds, const bf16_t* xb, const bf16_t* Wg, bf16_t* qkv, const float* rss, const float* gss) {
    const int tid = opaque_tid(), lane = tid & 63, wid = __builtin_amdgcn_readfirstlane(tid >> 6), lr = tid >> 4, lc = tid & 15;
    for (int j = blockIdx.x; j < 32; j += gridDim.x) {
        const int cA = j * 64, head = j >> 3;
        f32x16 acc0, acc1;
        __syncthreads(); narrow_scales(lds, rss, tid);
        if (tid < 256) { const float2 gp = *(const float2*)(gss + ((size_t)(NP + tid) * 4 + head) * 2); ((LAS float*)(lds + 81920 + 1024))[tid] = __builtin_amdgcn_rsqf((gp.x + gp.y) * (1.0f / 512.0f) + EPS); }
        narrow_core(lds, xb + (size_t)(NP + lr) * DM + lc * 8, DM, Wg + (size_t)(cA + lr) * DM + lc * 8, Wg + (size_t)(cA + 32 + lr) * DM + lc * 8, DM, acc0, acc1, tid, lane, wid);
        int lz = lane; asm volatile("" : "+v"(lz)); const int hl = lz >> 5, l31 = lz & 31;
        unsigned short ob0[16], ob1[16];
#pragma unroll
        for (int i = 0; i < 16; ++i) { const bf16_t* op = qkv + (size_t)(NP + 32 * wid + (i & 3) + 8 * (i >> 2) + 4 * hl) * 4096 + 2048 + cA + l31; ob0[i] = op[0]; ob1[i] = op[32]; }
#pragma unroll
        for (int i = 0; i < 16; ++i) {
            const int rs = 32 * wid + (i & 3) + 8 * (i >> 2) + 4 * hl; const float r = ((const LAS float*)(lds + 81920))[rs], rn = ((const LAS float*)(lds + 81920 + 1024))[rs];
            bf16_t* op = qkv + (size_t)(NP + rs) * 4096 + 2048 + cA + l31;
            const float o0 = __uint_as_float(((unsigned)ob0[i]) << 16), o1 = __uint_as_float(((unsigned)ob1[i]) << 16);
            op[0] = f2bf(silu_f(acc0[i] * r) * o0 * rn); op[32] = f2bf(silu_f(acc1[i] * r) * o1 * rn);
        }
    }
}
__device__ __forceinline__ void narrow_res(LAS unsigned char* lds, const bf16_t* A, int lda, const bf16_t* Bt, int K, const EpiRes& E, int ldb = 0, int kstep = 0) {
    const int tid = opaque_tid(), lane = tid & 63, wid = __builtin_amdgcn_readfirstlane(tid >> 6), lr = tid >> 4, lc = tid & 15;
    for (int j = blockIdx.x; j < 16; j += gridDim.x) {
        const int pn = j >> 2, wc = j & 3, c0 = pn * 256 + wc * 32;
        f32x16 acc0, acc1;
        __syncthreads();
        const int ldb_ = ldb ? ldb : K, ko = pn * kstep;
        narrow_core(lds, A + (size_t)(NP + lr) * lda + ko + lc * 8, lda, Bt + (size_t)(c0 + lr) * ldb_ + ko + lc * 8, Bt + (size_t)(c0 + 128 + lr) * ldb_ + ko + lc * 8, K, acc0, acc1, tid, lane, wid);
        float sq[16];
        int lz = lane; asm volatile("" : "+v"(lz)); const int hl = lz >> 5, l31 = lz & 31;
        float bb0[16], bb1[16];
#pragma unroll
        for (int i = 0; i < 16; ++i) { const float* bp = E.base_s + (size_t)(32 * wid + (i & 3) + 8 * (i >> 2) + 4 * hl) * DM + c0 + l31; bb0[i] = bp[0]; bb1[i] = bp[128]; }
#pragma unroll
        for (int i = 0; i < 16; ++i) {
            const int rs = 32 * wid + (i & 3) + 8 * (i >> 2) + 4 * hl;
            const float v0 = bb0[i] + acc0[i], v1 = bb1[i] + acc1[i];
            float* xo = E.xres + (size_t)(NP + rs) * DM + c0 + l31; xo[0] = v0; xo[128] = v1;
            if (E.xb) { bf16_t* bo = E.xb + (size_t)(NP + rs) * DM + c0 + l31; bo[0] = f2bf(v0); bo[128] = f2bf(v1); }
            sq[i] = v0 * v0 + v1 * v1;
        }
        float s8[8], s4[4], s2[2], s1;
        { const bool bit = (lane & 16) != 0;
#pragma unroll
          for (int i = 0; i < 8; ++i) { const float keep = bit ? sq[i + 8] : sq[i], send = bit ? sq[i] : sq[i + 8]; s8[i] = keep + __shfl_xor(send, 16); } }
        { const bool bit = (lane & 8) != 0;
#pragma unroll
          for (int i = 0; i < 4; ++i) { const float keep = bit ? s8[i + 4] : s8[i], send = bit ? s8[i] : s8[i + 4]; s4[i] = keep + __shfl_xor(send, 8); } }
        { const bool bit = (lane & 4) != 0;
#pragma unroll
          for (int i = 0; i < 2; ++i) { const float keep = bit ? s4[i + 2] : s4[i], send = bit ? s4[i] : s4[i + 2]; s2[i] = keep + __shfl_xor(send, 4); } }
        { const bool bit = (lane & 2) != 0; const float keep = bit ? s2[1] : s2[0], send = bit ? s2[0] : s2[1]; s1 = keep + __shfl_xor(send, 2); }
        s1 += __shfl_xor(s1, 1);
        const int idx = (lane >> 1) & 15, rs = 32 * wid + (idx & 3) + 8 * (idx >> 2) + 4 * hl;
        if ((lane & 1) == 0) E.rss_next[(size_t)(NP + rs) * 16 + pn * 4 + wc] = s1;
    }
}

__device__ __forceinline__ void run_phase(const Params& p_, LAS unsigned char* lds, int ph_) {
    const bool nonarrow = false; const int ph = ph_ >= 100 ? ph_ - 100 : ph_;
    Params p = p_; { size_t z0 = 0, z1 = 0; asm volatile("" : "+s"(z0), "+s"(z1)); p.ws = p_.ws + z0; p.out = p_.out + z1; }
    bf16_t* xb = (bf16_t*)(p.ws + WS_XB); bf16_t* qkv = (bf16_t*)(p.ws + WS_QKV); float* rss = (float*)(p.ws + WS_RSS); float* gss = (float*)(p.ws + WS_GSS);
    const bf16_t* Wri = (const bf16_t*)(p.ws + WS_WRI); const bf16_t* Wro = (const bf16_t*)(p.ws + WS_WRO); const bf16_t* Wpl = (const bf16_t*)(p.ws + WS_WPL);
    const bf16_t* Wfi = (const bf16_t*)(p.ws + WS_WFI); const bf16_t* Wfo = (const bf16_t*)(p.ws + WS_WFO);
    float* xres = p.out;
    if (ph == NPHASE - 1) { phase_final(p); return; }
    int layer, step;
    if (ph < 9) { layer = 0; step = ph - 1; } else if (ph < 13) { layer = 1; step = ph - 9; } else if (ph < 21) { layer = 2; step = ph - 13; } else { layer = 3; step = ph - 21; }
    const int jl = layer >> 1;
    const bool is_ret = (layer & 1) == 0;
    const int fstep = is_ret ? step - 6 : step - 2;
    if (step == 0 && layer >= 1) { convert_ffn(p, lds, layer); if (layer + 1 < 4) convert_mixer(p, lds, layer + 1); __syncthreads(); }
    if (fstep == 0) { EpiFfn E{qkv, rss + (size_t)(2 * layer + 1) * NTOK * 16}; run_gemm(lds, xb, 1024, Wfi, 5632, 1024, E, NP); if (!nonarrow) narrow_ffn(lds, xb, Wfi, qkv, rss + (size_t)(2 * layer + 1) * NTOK * 16); return; }
    if (fstep == 1) { EpiRes E{xres, xres + (size_t)NP * DM, xres, layer == 3 ? (bf16_t*)nullptr : xb, rss + (size_t)(2 * layer + 2) * NTOK * 16}; run_gemm(lds, qkv, DFF, Wfo, 1024, DFF, E, NP); narrow_res(lds, qkv, DFF, Wfo, DFF, E); return; }
    if (is_ret) {
        if (step == 0) { EpiQKV E{qkv, rss + (size_t)(2 * layer) * NTOK * 16, (const float*)(p.ws + WS_COS), (const float*)(p.ws + WS_SIN)}; run_gemm(lds, xb, 1024, Wri, 4096, 1024, E, NP); if (!nonarrow) narrow_qkv(lds, xb, Wri, qkv, rss + (size_t)(2 * layer) * NTOK * 16, (const float*)(p.ws + WS_COS), (const float*)(p.ws + WS_SIN)); }
        else if (step == 1) phase_scan_local(p, lds);
        else if (step == 2) phase_scan_prefix(p, jl);
        else if (step == 3) phase_scan(p, lds, jl);
        else if (step == 4) { EpiGate E{qkv, rss + (size_t)(2 * layer) * NTOK * 16, gss + (size_t)jl * NTOK * 8}; run_gemm(lds, xb, 1024, Wri + (size_t)4096 * 1024, 2048, 1024, E, NP); narrow_gate(lds, xb, Wri + (size_t)4096 * 1024, qkv, rss + (size_t)(2 * layer) * NTOK * 16, gss + (size_t)jl * NTOK * 8); }
        else if (step == 5) {
            const float* bp = layer == 0 ? p.x_prompt : xres; const float* bs = layer == 0 ? p.x_sample : xres + (size_t)NP * DM;
            EpiRes E{bp, bs, xres, xb, rss + (size_t)(2 * layer + 1) * NTOK * 16};
            run_gemm(lds, qkv + 2048, 4096, Wro, 1024, 2048, E, NP); narrow_res(lds, qkv + 2048, 4096, Wro, 2048, E);
        }
    } else {
        if (step == 0) phase_pool_prep(p, lds, layer);
        else if (step == 1) { EpiRes E{xres, xres + (size_t)NP * DM, xres, xb, rss + (size_t)(2 * layer + 1) * NTOK * 16}; pg8::Gemm g{qkv, Wpl, NP, 1024, 256, 1024, 1024}; PoolOrder S; S.init(NP, 1024, (int)gridDim.x, (int)blockIdx.x);
            pg8::gemm_phase<EpiRes, PoolOrder, false>(lds, g, S, E, nullptr); narrow_res(lds, qkv, 1024, Wpl, 256, E, 1024, 256); }
    }
}

__global__ void __launch_bounds__(512) mega(Params p) {
    extern __shared__ __attribute__((aligned(16))) unsigned char lds_raw[];
    LAS unsigned char* lds = (LAS unsigned char*)lds_raw;
    volatile LAS unsigned* bst = (volatile LAS unsigned*)(lds + LDS_MAIN);
    if (threadIdx.x == 0) { bst[0] = 0u; bst[1] = 0u; }
    __syncthreads();
    const XcdBarrier gbar = xcd_barrier_post((unsigned*)(p.ws + WS_BAR), bst);
#define GRID_SYNC() xcd_barrier(gbar)
#ifdef MK_PRE_SYNCS
    for (int i = 0; i < MK_PRE_SYNCS; ++i) GRID_SYNC();
#endif
#ifdef MK_PRE_MASK
#define MK_PRE(PH) if ((MK_PRE_MASK >> PH) & 1) { if (PH == 0) phase0(p, lds); else run_phase(p, lds, PH); GRID_SYNC(); }
    MK_PRE(0) MK_PRE(1) MK_PRE(2) MK_PRE(3) MK_PRE(4) MK_PRE(5) MK_PRE(6) MK_PRE(7) MK_PRE(8) MK_PRE(9) MK_PRE(10) MK_PRE(11) MK_PRE(12) MK_PRE(25)
#endif
    int ph = p.ph_lo;
    if (p.ph_hi < 0) cg::this_grid().sync();
    if (ph == 0) { phase0(p, lds); ++ph; if (ph < p.ph_hi) { GRID_SYNC(); } }
#ifdef MK_PRE_PH
    ph = 1 - MK_PRE_REP;
#endif
    for (; ph < p.ph_hi; ++ph) {
#ifdef MK_PRE_PH
        const int phx = (ph < 1) ? MK_PRE_PH + 100 : ph;
#else
        const int phx = ph;
#endif
        run_phase(p, lds, phx);
        if (ph + 1 < p.ph_hi) { GRID_SYNC(); }
    }
}
}

#ifndef MK_SINGLE
#define MK_SINGLE 1
#endif
extern "C" void kernel_launch(void* const* d_in, const int* in_sizes, int n_in, void* d_out, int out_size, void* d_ws, size_t ws_size, hipStream_t stream) {
    static int grid = 0;
    constexpr int LDS_BYTES = mk::LDS_TOTAL;
    if (grid == 0) {
        int dev = 0, cus = 0, per_cu = 0;
        hipGetDevice(&dev); hipDeviceGetAttribute(&cus, hipDeviceAttributeMultiprocessorCount, dev);
        if (hipFuncSetAttribute((const void*)mk::mega, hipFuncAttributeMaxDynamicSharedMemorySize, LDS_BYTES) != hipSuccess) { fprintf(stderr, "hipFuncSetAttribute failed\n"); }
        if (hipOccupancyMaxActiveBlocksPerMultiprocessor(&per_cu, (const void*)mk::mega, 512, LDS_BYTES) != hipSuccess || per_cu < 1) { fprintf(stderr, "occupancy query: %d\n", per_cu); per_cu = 1; }
        (void)hipGetLastError();
        grid = cus * (per_cu < 1 ? 1 : per_cu);
        if (grid <= 0) grid = 256;
    }
    if (ws_size < mk::WS_END) { fprintf(stderr, "workspace too small: %zu < %zu\n", ws_size, (size_t)mk::WS_END); return; }
    mk::Params p{};
    p.x_prompt = (const float*)d_in[0]; p.x_sample = (const float*)d_in[1]; p.state_ret = (const float*)d_in[2]; p.state_pool = (const float*)d_in[3];
    p.norm_mix = (const float*)d_in[4]; p.w_ret_in = (const float*)d_in[5]; p.w_ret_out = (const float*)d_in[6]; p.w_pool = (const float*)d_in[7];
    p.pool_scale = (const float*)d_in[8]; p.norm_ffn = (const float*)d_in[9]; p.w_ffn_in = (const float*)d_in[10]; p.w_ffn_out = (const float*)d_in[11]; p.norm_final = (const float*)d_in[12];
    p.out = (float*)d_out; p.ws = (unsigned char*)d_ws;
#if MK_SINGLE
    hipMemsetAsync((unsigned char*)d_ws + mk::WS_BAR, 0, XCD_BAR_WORDS * 4, stream);
    p.ph_lo = 0; p.ph_hi = mk::NPHASE;
    void* args[] = {&p};
    hipError_t e = hipLaunchCooperativeKernel((const void*)mk::mega, dim3(grid), dim3(512), args, LDS_BYTES, stream);
    if (e != hipSuccess) fprintf(stderr, "cooperative launch failed: %s (grid %d)\n", hipGetErrorString(e), grid);
#else
#ifndef MK_STOP
#define MK_STOP 23
#endif
    for (int ph = 0; ph < mk::NPHASE; ++ph) {
        p.ph_lo = ph; p.ph_hi = ph + 1;
        hipLaunchKernelGGL(mk::mega, dim3(grid), dim3(512), LDS_BYTES, stream, p);
    }
#endif
}
```

```cpp
#include <hip/hip_runtime.h>
#include <hip/hip_cooperative_groups.h>
#include <cstdio>
namespace cg = cooperative_groups;
#define LDS_BARRIER() asm volatile("s_waitcnt lgkmcnt(0)\n\ts_barrier" ::: "memory")
__device__ __forceinline__ int opaque_tid() { int t = (int)threadIdx.x; asm volatile("" : "+v"(t)); return t; }
namespace pg8 {
#define PG8_LAS __attribute__((address_space(3)))
typedef unsigned short bf16_t;
typedef short bf16x8 __attribute__((ext_vector_type(8)));
typedef float f32x4 __attribute__((ext_vector_type(4)));
typedef unsigned u32x4 __attribute__((ext_vector_type(4)));
constexpr int BM = 256, BK = 64, HALF = 128, HTB = HALF * BK * 2  , STAGE_BYTES = 8 * HTB, NXCD = 8, WGM = 8;

__host__ __device__ __forceinline__ int lds_byte(int r, int c) { const int st = (r >> 4) * 2 + (c >> 5), rr = r & 15, cc = c & 31, ob = rr * 64 + cc * 2; return st * 1024 + (ob ^ (((ob >> 9) & 1) << 5)); }
__host__ __device__ __forceinline__ void stage_rc(int b, int& R, int& C) { const int st = b / 1024, sb = b % 1024, swz = sb ^ (((sb >> 9) & 1) << 5); R = (st >> 1) * 16 + swz / 64; C = (st & 1) * 32 + (swz % 64) / 2; }
__host__ __device__ __forceinline__ int perm32(int rho) { const int n = rho >> 4, i = rho & 15; return 8 * (i >> 2) + 4 * n + (i & 3); }

struct Unit { int pm, pn, kofs; };
struct Gemm { const bf16_t* A; const bf16_t* Bt; int M, N, K, lda, ldb; };

struct StaticOrder {
    int nM, nN, nwg, G, c;
    __host__ __device__ void init(int M, int N, int G_, int c_) { nM = M / BM; nN = N / BM; nwg = nM * nN; G = G_; c = c_; }
    __host__ __device__ bool next(int i, Unit& u) const {
        const long L = (long)i * G + c; if (L >= nwg) return false;
        int wgid = (int)L; { const int q = nwg / NXCD, r = nwg % NXCD, xcd = wgid % NXCD, off = wgid / NXCD; wgid = (xcd < r ? xcd * (q + 1) : r * (q + 1) + (xcd - r) * q) + off; }
        const int nig = WGM * nN, gid = wgid / nig, fm = gid * WGM, gsz = (nM - fm) < WGM ? (nM - fm) : WGM;
        u.pm = fm + ((wgid % nig) % gsz); u.pn = (wgid % nig) / gsz; u.kofs = 0; return true;
    }
    __device__ __forceinline__ void a_ready(const Unit&) const {}
    __device__ __forceinline__ void done(const Unit&) const {}
};
struct CountedOrder : StaticOrder {
    const unsigned* ready; unsigned need; unsigned* tmo;
    __device__ __forceinline__ void a_ready(const Unit& u) const {
        if (threadIdx.x < 64) {
            const unsigned long long t0 = __builtin_amdgcn_s_memrealtime(); unsigned polls = 0;
            while ((unsigned)__builtin_amdgcn_readfirstlane(__hip_atomic_load(ready + 64 * u.pm, __ATOMIC_RELAXED, __HIP_MEMORY_SCOPE_AGENT)) < need) {
                if ((++polls & 255u) == 0u && __builtin_amdgcn_readfirstlane(__hip_atomic_load(tmo, __ATOMIC_RELAXED, __HIP_MEMORY_SCOPE_AGENT)) != 0u) break;
                if (__builtin_amdgcn_s_memrealtime() - t0 > 2000000ull) {
                    if (threadIdx.x == 0) { unsigned expect = 0u; __hip_atomic_compare_exchange_strong(tmo + 1, &expect, 0x600u | (unsigned)(u.pm & 0xff), __ATOMIC_RELAXED, __ATOMIC_RELAXED, __HIP_MEMORY_SCOPE_AGENT); __hip_atomic_store(tmo, 1u, __ATOMIC_RELAXED, __HIP_MEMORY_SCOPE_AGENT); }
                    break; }
                __builtin_amdgcn_s_sleep(2); }
            __builtin_amdgcn_fence(__ATOMIC_ACQUIRE, "agent");
            asm volatile("s_waitcnt vmcnt(0)" ::: "memory");
        }
#if !defined(BROKEN_HOOK_NO_BARRIER)
        asm volatile("" ::: "memory"); __builtin_amdgcn_s_barrier(); asm volatile("" ::: "memory");
#endif
    }
};

__device__ __forceinline__ unsigned cvt_pk_bf16(float lo, float hi) { unsigned r; asm volatile("v_cvt_pk_bf16_f32 %0, %1, %2" : "=v"(r) : "v"(lo), "v"(hi)); return r; }
typedef float f32x2 __attribute__((ext_vector_type(2)));
__device__ __forceinline__ f32x2 gelu_pk(f32x2 v) {
    const f32x2 av = __builtin_elementwise_abs(v), d = av * 0.2316418882f + 1.0f;
    f32x2 t; t.x = __builtin_amdgcn_rcpf(d.x); t.y = __builtin_amdgcn_rcpf(d.y);
    f32x2 q = t * 0.5307027145f + (-0.7265760135f); q = q * t + 0.7107068705f; q = q * t + (-0.142248368f); q = q * t + 0.127414796f; q = q * t;
    const f32x2 s = (v * v) * (-0.72134752044f);
    f32x2 e; e.x = __builtin_amdgcn_exp2f(s.x); e.y = __builtin_amdgcn_exp2f(s.y);
    const f32x2 m = v * (q * e), r = v - m;
    f32x2 o; o.x = v.x < 0.f ? m.x : r.x; o.y = v.y < 0.f ? m.y : r.y; return o;
}

struct EpiF32 {
    static constexpr bool PERM = false, AFTER_DRAIN = false;
    float* C; int ldc; const float* bias;
    __device__ __forceinline__ void operator()(const f32x4 (&acc)[2][2][4][2], const Unit& u, int wr, int wc, int fr_, int fq_) const {
        const int tl_ = opaque_tid(), fr = tl_ & 15, fq = (tl_ >> 4) & 3; (void)fr_; (void)fq_;
        const int row0 = u.pm * BM + wr * 64 + fr, col0 = u.pn * BM + wc * 32 + 4 * fq;
        f32x4 bv[2][2];
#pragma unroll
        for (int bj = 0; bj < 2; ++bj)
#pragma unroll
            for (int n = 0; n < 2; ++n) bv[bj][n] = bias ? *(const f32x4*)(bias + col0 + bj * HALF + n * 16) : (f32x4){0.f, 0.f, 0.f, 0.f};
#pragma unroll
        for (int ai = 0; ai < 2; ++ai)
#pragma unroll
            for (int m = 0; m < 4; ++m) { float* rowp = C + (size_t)(row0 + ai * HALF + m * 16) * ldc + col0;
#pragma unroll
                for (int bj = 0; bj < 2; ++bj)
#pragma unroll
                    for (int n = 0; n < 2; ++n) *(f32x4*)(rowp + bj * HALF + n * 16) = acc[ai][bj][m][n] + bv[bj][n]; }
    }
};
template <int ACT  > struct EpiBf16 {
    static constexpr bool PERM = true, AFTER_DRAIN = false;
    bf16_t* O; int ldc; const float* bias; int split_cols; size_t split_stride;
    __device__ __forceinline__ void operator()(const f32x4 (&acc)[2][2][4][2], const Unit& u, int wr, int wc, int fr_, int fq_) const {
        const int tl_ = opaque_tid(), fr = tl_ & 15, fq = (tl_ >> 4) & 3; (void)fr_; (void)fq_;
        const int row0 = u.pm * BM + wr * 64 + fr; int colt = u.pn * BM; bf16_t* base = O;
        if (split_cols) { const int t = colt / split_cols; base += (size_t)t * split_stride; colt -= t * split_cols; }
        const int col0 = colt + wc * 32 + 8 * fq, bcol0 = u.pn * BM + wc * 32 + 8 * fq;
        f32x4 bv[2][2];
#pragma unroll
        for (int bj = 0; bj < 2; ++bj)
#pragma unroll
            for (int n = 0; n < 2; ++n) bv[bj][n] = bias ? *(const f32x4*)(bias + bcol0 + bj * HALF + 4 * n) : (f32x4){0.f, 0.f, 0.f, 0.f};
#pragma unroll
        for (int ai = 0; ai < 2; ++ai)
#pragma unroll
            for (int m = 0; m < 4; ++m) { bf16_t* rowp = base + (size_t)(row0 + ai * HALF + m * 16) * ldc + col0;
#pragma unroll
                for (int bj = 0; bj < 2; ++bj) { f32x4 v0 = acc[ai][bj][m][0] + bv[bj][0], v1 = acc[ai][bj][m][1] + bv[bj][1];
                    if (ACT == 1) { f32x2 a = gelu_pk((f32x2){v0[0], v0[1]}), b = gelu_pk((f32x2){v0[2], v0[3]}), c = gelu_pk((f32x2){v1[0], v1[1]}), d = gelu_pk((f32x2){v1[2], v1[3]});
                        v0 = (f32x4){a.x, a.y, b.x, b.y}; v1 = (f32x4){c.x, c.y, d.x, d.y}; }
                    if (ACT == 2) {
#pragma unroll
                        for (int j = 0; j < 4; ++j) { v0[j] = 0.5f * v0[j] * (1.0f + erff(v0[j] * 0.70710678f)); v1[j] = 0.5f * v1[j] * (1.0f + erff(v1[j] * 0.70710678f)); } }
                    u32x4 w; w.x = cvt_pk_bf16(v0[0], v0[1]); w.y = cvt_pk_bf16(v0[2], v0[3]); w.z = cvt_pk_bf16(v1[0], v1[1]); w.w = cvt_pk_bf16(v1[2], v1[3]);
                    *(u32x4*)(rowp + bj * HALF) = w; } }
    }
};

template <class Epi, class Sched, bool STAMP = false>
__device__ __forceinline__ void gemm_phase(PG8_LAS unsigned char* lds, const Gemm g, const Sched& S, const Epi& E, unsigned long long* stamps) {
    const int tid = opaque_tid(), wid = __builtin_amdgcn_readfirstlane(tid >> 6), lane = tid & 63, wr = wid >> 2, wc = wid & 3, fr = lane & 15, fq = lane >> 4;
    const int K = g.K, nt = K / BK, lda = g.lda, ldb = g.ldb;
    int ts_lo = 0, ts_hi = 0, nts = 0; const unsigned long long rt_entry = STAMP ? (unsigned long long)wall_clock64() : 0ull;
#define PG8_STAMP() do { if (STAMP && wid == 0 && nts < 64) { const unsigned long long _c = (unsigned long long)clock64(); \
        ts_lo = (lane == nts) ? (int)(unsigned)_c : ts_lo; ts_hi = (lane == nts) ? (int)(unsigned)(_c >> 32) : ts_hi; ++nts; } } while (0)
    PG8_STAMP();
    unsigned voffA[2], voffB[2];
#pragma unroll
    for (int i = 0; i < 2; ++i) { int R, C; stage_rc(tid * 16 + i * 8192, R, C); const int Rb = Epi::PERM ? ((R & ~31) + perm32(R & 31)) : R;
        voffA[i] = (unsigned)(R * lda + C) * 2u; voffB[i] = (unsigned)(Rb * ldb + C) * 2u; }
    const size_t kstep = (size_t)(BK * 2);
    const size_t hstep = (size_t)HALF * ldb * 2;
    const size_t tstep = 2 * hstep; const size_t hstepA = (size_t)HALF * lda * 2, tstepA = 2 * hstepA;
    const unsigned ldsw = (unsigned)wid * 1024u;
    const int aoff = lds_byte(wr * 64 + fr, fq * 8), boff = lds_byte(wc * 32 + fr, fq * 8);
#define PG8_SA(b, h) (((b) * 2 + (h)) * HTB)
#define PG8_SB(b, h) ((4 + (b) * 2 + (h)) * HTB)
#define PG8_STAGE(bufoff, gbase, voff) do { _Pragma("unroll") for (int _i = 0; _i < 2; ++_i) \
        __builtin_amdgcn_global_load_lds((const unsigned*)((const char*)(gbase) + (voff)[_i]), (PG8_LAS unsigned*)(lds + (bufoff) + ldsw + _i * 8192), 16, 0, 0); } while (0)
#define PG8_LDA(dst, b, h) do { _Pragma("unroll") for (int m = 0; m < 4; ++m) _Pragma("unroll") for (int k = 0; k < 2; ++k) dst[m][k] = *(const PG8_LAS bf16x8*)(lds + PG8_SA(b, h) + aoff + m * 2048 + k * 1024); } while (0)
#define PG8_LDB(dst, b, h) do { _Pragma("unroll") for (int n = 0; n < 2; ++n) _Pragma("unroll") for (int k = 0; k < 2; ++k) dst[n][k] = *(const PG8_LAS bf16x8*)(lds + PG8_SB(b, h) + boff + n * 2048 + k * 1024); } while (0)
#define PG8_MMA(ai, bj, At, Bt) do { __builtin_amdgcn_s_setprio(1); _Pragma("unroll") for (int m = 0; m < 4; ++m) _Pragma("unroll") for (int n = 0; n < 2; ++n) _Pragma("unroll") for (int k = 0; k < 2; ++k) \
        acc[ai][bj][m][n] = __builtin_amdgcn_mfma_f32_16x16x32_bf16(Bt[n][k], At[m][k], acc[ai][bj][m][n], 0, 0, 0); __builtin_amdgcn_s_setprio(0); } while (0)
#define PG8_WAIT_V(n) asm volatile("s_waitcnt vmcnt(" #n ")" ::: "memory")
#define PG8_WAIT_L(n) asm volatile("s_waitcnt lgkmcnt(" #n ")" ::: "memory")
#define PG8_BAR __builtin_amdgcn_s_barrier()
#define PG8_SCHED __builtin_amdgcn_sched_barrier(0)
    Unit cur, nxt; int ui = 0;
    if (!S.next(0, cur)) return;
    f32x4 acc[2][2][4][2];
#pragma unroll
    for (int a = 0; a < 2; ++a)
#pragma unroll
        for (int b = 0; b < 2; ++b)
#pragma unroll
            for (int m = 0; m < 4; ++m)
#pragma unroll
                for (int n = 0; n < 2; ++n) acc[a][b][m][n] = (f32x4){0.f, 0.f, 0.f, 0.f};
    bf16x8 At[4][2], B0[2][2], B1[2][2];
    const char* cA = (const char*)g.A + (size_t)cur.pm * tstepA + (size_t)cur.kofs * 2; const char* cB = (const char*)g.Bt + (size_t)cur.pn * tstep + (size_t)cur.kofs * 2;
    S.a_ready(cur);
    PG8_STAGE(PG8_SB(0, 0), cB, voffB); PG8_STAGE(PG8_SA(0, 0), cA, voffA); PG8_STAGE(PG8_SB(0, 1), cB + hstep, voffB); PG8_STAGE(PG8_SA(0, 1), cA + hstepA, voffA);
    if (wr == 1) PG8_BAR;
    PG8_WAIT_V(4); PG8_BAR;
    PG8_STAGE(PG8_SB(1, 0), cB + kstep, voffB); PG8_STAGE(PG8_SA(1, 0), cA + kstep, voffA); PG8_STAGE(PG8_SB(1, 1), cB + hstep + kstep, voffB);
    PG8_WAIT_V(6); PG8_BAR;
    PG8_STAMP();
    for (;;) {
        const bool has_next = S.next(ui + 1, nxt);
        const char* nA = has_next ? (const char*)g.A + (size_t)nxt.pm * tstepA + (size_t)nxt.kofs * 2 : cA; const char* nB = has_next ? (const char*)g.Bt + (size_t)nxt.pn * tstep + (size_t)nxt.kofs * 2 : cB;
        for (int t = 0; t < nt; t += 2) {
            const bool last = (t == nt - 2);
            const char* a1 = cA + (size_t)(t + 1) * kstep;
            const char* a2 = last ? nA : cA + (size_t)(t + 2) * kstep; const char* b2 = last ? nB : cB + (size_t)(t + 2) * kstep;
            const char* a3 = a2 + kstep; const char* b3 = b2 + kstep;
            if (last && has_next) S.a_ready(nxt);
            PG8_LDB(B0, 0, 0); PG8_SCHED; PG8_LDA(At, 0, 0); PG8_STAGE(PG8_SA(1, 1), a1 + hstepA, voffA);
            PG8_WAIT_L(8); PG8_BAR; PG8_WAIT_L(0); PG8_MMA(0, 0, At, B0); PG8_BAR; PG8_SCHED;
            PG8_LDB(B1, 0, 1); PG8_STAGE(PG8_SB(0, 0), b2, voffB);
            PG8_BAR; PG8_WAIT_L(0); PG8_MMA(0, 1, At, B1); PG8_BAR;
            PG8_LDA(At, 0, 1); PG8_STAGE(PG8_SA(0, 0), a2, voffA);
            PG8_BAR; PG8_WAIT_L(0); PG8_MMA(1, 0, At, B0); PG8_BAR; PG8_SCHED;
            PG8_STAGE(PG8_SB(0, 1), b2 + hstep, voffB);
            PG8_WAIT_V(6); PG8_BAR; PG8_MMA(1, 1, At, B1); PG8_BAR;
            PG8_LDB(B0, 1, 0); PG8_SCHED; PG8_LDA(At, 1, 0); PG8_STAGE(PG8_SA(0, 1), a2 + hstepA, voffA);
            PG8_WAIT_L(8); PG8_BAR; PG8_WAIT_L(0); PG8_MMA(0, 0, At, B0); PG8_BAR; PG8_SCHED;
            PG8_LDB(B1, 1, 1); PG8_STAGE(PG8_SB(1, 0), b3, voffB);
            PG8_BAR; PG8_WAIT_L(0); PG8_MMA(0, 1, At, B1); PG8_BAR;
            PG8_LDA(At, 1, 1); PG8_STAGE(PG8_SA(1, 0), a3, voffA);
            PG8_BAR; PG8_WAIT_L(0); PG8_MMA(1, 0, At, B0); PG8_BAR; PG8_SCHED;
            PG8_STAGE(PG8_SB(1, 1), b3 + hstep, voffB);
            PG8_WAIT_V(6); PG8_BAR; PG8_MMA(1, 1, At, B1); PG8_BAR;
        }
        PG8_STAMP();
        if constexpr (!Epi::AFTER_DRAIN) { E(acc, cur, wr, wc, fr, fq); S.done(cur); }
        PG8_STAMP();
        if (!has_next) break;
#pragma unroll
        for (int a = 0; a < 2; ++a)
#pragma unroll
            for (int b = 0; b < 2; ++b)
#pragma unroll
                for (int m = 0; m < 4; ++m)
#pragma unroll
                    for (int n = 0; n < 2; ++n) acc[a][b][m][n] = (f32x4){0.f, 0.f, 0.f, 0.f};
        cur = nxt; cA = nA; cB = nB; ++ui;
    }
    PG8_WAIT_V(0);
    if (wr == 0) PG8_BAR;
    PG8_BAR;
    if constexpr (Epi::AFTER_DRAIN) { E.fused(acc, cur, wr, wc, fr, fq, lds, wid, lane); S.done(cur); }
    PG8_STAMP();
    if (STAMP && wid == 0) { stamps[lane] = lane < nts ? (((unsigned long long)(unsigned)ts_hi << 32) | (unsigned)ts_lo) : 0ull;
        if (lane == 62) stamps[62] = rt_entry; if (lane == 63) stamps[63] = (unsigned long long)wall_clock64(); }
#undef PG8_STAMP
#undef PG8_SA
#undef PG8_SB
#undef PG8_STAGE
#undef PG8_LDA
#undef PG8_LDB
#undef PG8_MMA
#undef PG8_WAIT_V
#undef PG8_WAIT_L
#undef PG8_BAR
#undef PG8_SCHED
}
}

#define XB_TMO      128
#define XB_XCNT(j)  (256  + 64 * (j))
#define XB_XSUB(j)  (1280 + 64 * (j))
#define XB_XGEN(j)  (2304 + 64 * (j))
#define XB_TOP      3328
#define XB_TOPGEN   3392
#define XCD_BAR_WORDS 3456
#define XB_SPIN_CAP (1u << 18)
#define LAS __attribute__((address_space(3)))

__device__ __forceinline__ unsigned xb_ld(unsigned* p)              { return __hip_atomic_load(p, __ATOMIC_RELAXED, __HIP_MEMORY_SCOPE_AGENT); }
__device__ __forceinline__ unsigned xb_add(unsigned* p, unsigned v) { return __hip_atomic_fetch_add(p, v, __ATOMIC_RELAXED, __HIP_MEMORY_SCOPE_AGENT); }
__device__ __forceinline__ unsigned xb_xcc_id() { return (unsigned)__builtin_amdgcn_s_getreg((3 << 11) | 20) & 0xFu; }
#define XB_SPIN(cond, bar) do { unsigned _sp = 0; while (cond) { __builtin_amdgcn_s_sleep(1); \
    if ((++_sp & 255u) == 0u) { if (xb_ld(&(bar)[XB_TMO])) break; if (_sp > XB_SPIN_CAP) { atomicAdd(&(bar)[XB_TMO], 1u); break; } } } } while (0)

struct XcdBarrier {
    unsigned* bar; unsigned x;
    volatile LAS unsigned* st;
};

__device__ __forceinline__ XcdBarrier xcd_barrier_post(unsigned* bar, volatile LAS unsigned* st) {
    XcdBarrier b; b.bar = bar; b.x = xb_xcc_id(); b.st = st;
    if (threadIdx.x == 0) (void)xb_add(&bar[XB_XCNT(b.x)], 1u);
    return b;
}
__device__ __forceinline__ void xcd_barrier_complete(unsigned* bar, unsigned x, unsigned& nloc, unsigned& nx) {
    const unsigned G = gridDim.x * gridDim.y * gridDim.z;
    unsigned sum, cnt, mine, sp = 0u;
    for (;;) {
        sum = 0u; cnt = 0u; mine = 0u;
#pragma unroll
        for (unsigned j = 0; j < 16; ++j) { const unsigned c = xb_ld(&bar[XB_XCNT(j)]); sum += c; cnt += (c > 0u) ? 1u : 0u; mine = (j == x) ? c : mine; }
        if (sum == G) break;
        __builtin_amdgcn_s_sleep(1);
        if ((++sp & 255u) == 0u) { if (xb_ld(&bar[XB_TMO])) break; if (sp > XB_SPIN_CAP) { atomicAdd(&bar[XB_TMO], 1u); break; } }
    }
    nloc = mine > 0u ? mine : 1u; nx = cnt > 0u ? cnt : 1u;
}

__device__ __forceinline__ void xcd_barrier(const XcdBarrier& b) {
    asm volatile("s_waitcnt vmcnt(0)" ::: "memory");
    __syncthreads();
    if (threadIdx.x == 0) {
        unsigned* bar = b.bar;
        __builtin_amdgcn_s_waitcnt(0);
        unsigned nloc = b.st[0], nx = b.st[1];
        if (nloc == 0u) { xcd_barrier_complete(bar, b.x, nloc, nx); b.st[0] = nloc; b.st[1] = nx; }
        const unsigned old = xb_add(&bar[XB_XSUB(b.x)], 1u);
        const unsigned gen = old / nloc;
        if (old + 1u == (gen + 1u) * nloc) {
            __builtin_amdgcn_fence(__ATOMIC_RELEASE, "agent");
            asm volatile("s_waitcnt vmcnt(0)" ::: "memory");
            const unsigned og = xb_add(&bar[XB_TOP], 1u);
            const unsigned tg = og / nx;
            if (og + 1u == (tg + 1u) * nx) xb_add(&bar[XB_TOPGEN], 1u);
            else XB_SPIN(xb_ld(&bar[XB_TOPGEN]) == tg, bar);
            __builtin_amdgcn_fence(__ATOMIC_ACQUIRE, "agent");
            xb_add(&bar[XB_XGEN(b.x)], 1u);
            asm volatile("s_waitcnt vmcnt(0)" ::: "memory");
        } else {
            XB_SPIN(xb_ld(&bar[XB_XGEN(b.x)]) == gen, bar);
            __builtin_amdgcn_fence(__ATOMIC_ACQUIRE, "agent");
            asm volatile("s_waitcnt vmcnt(0)" ::: "memory");
        }
    }
    __syncthreads();
}

namespace mk {
using pg8::bf16_t; using pg8::bf16x8; using pg8::f32x4; using pg8::u32x4; using pg8::Unit; using pg8::cvt_pk_bf16;
typedef float f32x16 __attribute__((ext_vector_type(16)));
typedef short s16x4 __attribute__((ext_vector_type(4)));
typedef unsigned u32x2 __attribute__((ext_vector_type(2)));

constexpr int NTOK = 33024, NP = 32768, DM = 1024, SEQ = 16384, DFF = 2816;
constexpr float EPS = 1e-6f;
constexpr int NPHASE = 26;
constexpr int LDS_MAIN = 141312, LDS_TOTAL = LDS_MAIN + 16;
constexpr size_t OUT_RETP = 33816576, OUT_RETS = 35913728, OUT_POOLP = 52690944, OUT_POOLS = 52752384;
constexpr size_t WS_WRI = 0, WS_WRO = 12582912, WS_WPL = 16777216, WS_WFI = 18874368, WS_WFO = 30408704, WS_XB = 36175872,
                 WS_QKV = 103809024, WS_T = 374341632, WS_COS = 441450496, WS_SIN = 449839104, WS_RSS = 458227712, WS_GSS = 477249536, WS_BAR = 494157824, WS_END = 494174208;

struct Params {
    const float *x_prompt, *x_sample, *state_ret, *state_pool, *norm_mix, *w_ret_in, *w_ret_out, *w_pool, *pool_scale, *norm_ffn, *w_ffn_in, *w_ffn_out, *norm_final;
    float* out; unsigned char* ws; int ph_lo, ph_hi;
};

__device__ __forceinline__ float lg2gamma(int h) { return h == 0 ? -0.04580368961312479f : h == 1 ? -0.02272007650008353f : h == 2 ? -0.011315313227834146f : -0.005646563141142063f; }
__device__ __forceinline__ float sum16(const float* p) {
    const float4 a = *(const float4*)p, b = *(const float4*)(p + 4), c = *(const float4*)(p + 8), d = *(const float4*)(p + 12);
    return (((a.x + a.y) + (a.z + a.w)) + ((b.x + b.y) + (b.z + b.w))) + (((c.x + c.y) + (c.z + c.w)) + ((d.x + d.y) + (d.z + d.w)));
}
__device__ __forceinline__ float rs_row(const float* rssrow) { return __builtin_amdgcn_rsqf(sum16(rssrow) * (1.0f / 1024.0f) + EPS); }
__device__ __forceinline__ float silu_f(float v) { return v * __builtin_amdgcn_rcpf(1.0f + __builtin_amdgcn_exp2f(v * -1.4426950408889634f)); }
__device__ __forceinline__ bf16_t f2bf(float f) { unsigned u = __float_as_uint(f); u += 0x7FFFu + ((u >> 16) & 1u); return (bf16_t)(u >> 16); }
__device__ __forceinline__ float bf2f(unsigned short b) { return __uint_as_float(((unsigned)b) << 16); }

__device__ __forceinline__ void row_scales(float (&r)[8], const float* rss, int row0, int fq) {
    float4 q[8];
#pragma unroll
    for (int i = 0; i < 8; ++i) q[i] = *(const float4*)(rss + (size_t)(row0 + (i >> 2) * 128 + (i & 3) * 16) * 16 + fq * 4);
#pragma unroll
    for (int i = 0; i < 8; ++i) { float t = (q[i].x + q[i].y) + (q[i].z + q[i].w); t += __shfl_xor(t, 16); t += __shfl_xor(t, 32); r[i] = __builtin_amdgcn_rsqf(t * (1.0f / 1024.0f) + EPS); }
}
struct EpiQKV {
    static constexpr bool PERM = true, AFTER_DRAIN = false;
    bf16_t* O; const float* rss; const float* cosT; const float* sinT;
    __device__ __forceinline__ void operator()(const f32x4 (&acc)[2][2][4][2], const Unit& u, int wr, int wc, int fr_, int fq_) const {
        const int tl_ = opaque_tid(), fr = tl_ & 15, fq = (tl_ >> 4) & 3; (void)fr_; (void)fq_;
        const int row0 = u.pm * 256 + wr * 64 + fr, cin = wc * 32 + 8 * fq;
        const bool rot = u.pn < 8; const float lg = lg2gamma(u.pn & 3);
        float rr[8]; row_scales(rr, rss, row0, fq);
        u32x4 wout[8][2];
#pragma unroll
        for (int am = 0; am < 4; ++am) {
            const int ai = am >> 1;
            f32x4 ct[2][2], st[2][2];
            if (rot) {
#pragma unroll
                for (int mm = 0; mm < 2; ++mm) {
                    const int row = row0 + ai * 128 + ((am & 1) * 2 + mm) * 16; const int pos = (row < NP) ? (row & (SEQ - 1)) : 1024 + ((row - NP) & 15);
#pragma unroll
                    for (int n = 0; n < 2; ++n) { ct[mm][n] = *(const f32x4*)(cosT + (size_t)pos * 128 + cin + 4 * n); st[mm][n] = *(const f32x4*)(sinT + (size_t)pos * 128 + cin + 4 * n); }
                }
            }
#pragma unroll
            for (int mm = 0; mm < 2; ++mm) {
                const int m = (am & 1) * 2 + mm;
                const int row = row0 + ai * 128 + m * 16;
                const float r = rr[ai * 4 + m];
                int l, Lc;
                if (row < NP) { l = row & 63; Lc = 64; } else { l = (row - NP) & 15; Lc = 16; }
                f32x4 o1[2], o2[2];
                if (rot) {
                    const float e = (u.pn < 4) ? (float)(l + 1) : (float)(Lc - 1 - l);
                    const float dec = exp2f(e * lg) * r;
#pragma unroll
                    for (int n = 0; n < 2; ++n) {
                        const f32x4 c4 = ct[mm][n], s4 = st[mm][n];
                        const f32x4 x1 = acc[ai][0][m][n] * dec, x2 = acc[ai][1][m][n] * dec;
                        o1[n] = x1 * c4 - x2 * s4; o2[n] = x1 * s4 + x2 * c4;
                    }
                } else {
#pragma unroll
                    for (int n = 0; n < 2; ++n) { o1[n] = acc[ai][0][m][n] * r; o2[n] = acc[ai][1][m][n] * r; }
                }
                u32x4 w; w.x = cvt_pk_bf16(o1[0][0], o1[0][1]); w.y = cvt_pk_bf16(o1[0][2], o1[0][3]); w.z = cvt_pk_bf16(o1[1][0], o1[1][1]); w.w = cvt_pk_bf16(o1[1][2], o1[1][3]);
                wout[ai * 4 + m][0] = w;
                w.x = cvt_pk_bf16(o2[0][0], o2[0][1]); w.y = cvt_pk_bf16(o2[0][2], o2[0][3]); w.z = cvt_pk_bf16(o2[1][0], o2[1][1]); w.w = cvt_pk_bf16(o2[1][2], o2[1][3]);
                wout[ai * 4 + m][1] = w;
            }
        }
#pragma unroll
        for (int i = 0; i < 8; ++i) {
            bf16_t* rowp = O + (size_t)(row0 + (i >> 2) * 128 + (i & 3) * 16) * 4096 + u.pn * 256 + cin;
            *(u32x4*)rowp = wout[i][0]; *(u32x4*)(rowp + 128) = wout[i][1];
        }
    }
};
struct EpiGate {
    static constexpr bool PERM = true, AFTER_DRAIN = false;
    bf16_t* QKV; const float* rss; const float* gss;
    __device__ __forceinline__ void operator()(const f32x4 (&acc)[2][2][4][2], const Unit& u, int wr, int wc, int fr_, int fq_) const {
        const int tl_ = opaque_tid(), fr = tl_ & 15, fq = (tl_ >> 4) & 3; (void)fr_; (void)fq_;
        const int row0 = u.pm * 256 + wr * 64 + fr, cin = wc * 32 + 8 * fq, head = u.pn >> 1;
        float rr[8]; row_scales(rr, rss, row0, fq);
        u32x4 wout[8][2];
#pragma unroll
        for (int ai = 0; ai < 2; ++ai) {
            u32x4 ovs[4][2]; float2 gps[4];
#pragma unroll
            for (int i = 0; i < 4; ++i) {
                const int row = row0 + ai * 128 + i * 16; const bf16_t* rp = QKV + (size_t)row * 4096 + 2048 + u.pn * 256 + cin;
                ovs[i][0] = *(const u32x4*)rp; ovs[i][1] = *(const u32x4*)(rp + 128); gps[i] = *(const float2*)(gss + ((size_t)row * 4 + head) * 2);
            }
#pragma unroll
            for (int m = 0; m < 4; ++m) {
                const float r = rr[ai * 4 + m];
                const float rn = __builtin_amdgcn_rsqf((gps[m].x + gps[m].y) * (1.0f / 512.0f) + EPS);
#pragma unroll
                for (int bj = 0; bj < 2; ++bj) {
                    const u32x4 ov = ovs[m][bj];
                    float g[8], o[8];
#pragma unroll
                    for (int j = 0; j < 4; ++j) { g[j] = acc[ai][bj][m][0][j] * r; g[4 + j] = acc[ai][bj][m][1][j] * r; }
                    o[0] = __uint_as_float(ov.x << 16); o[1] = __uint_as_float(ov.x & 0xffff0000u); o[2] = __uint_as_float(ov.y << 16); o[3] = __uint_as_float(ov.y & 0xffff0000u);
                    o[4] = __uint_as_float(ov.z << 16); o[5] = __uint_as_float(ov.z & 0xffff0000u); o[6] = __uint_as_float(ov.w << 16); o[7] = __uint_as_float(ov.w & 0xffff0000u);
                    float y[8];
#pragma unroll
                    for (int j = 0; j < 8; ++j) y[j] = silu_f(g[j]) * o[j] * rn;
                    u32x4 w; w.x = cvt_pk_bf16(y[0], y[1]); w.y = cvt_pk_bf16(y[2], y[3]); w.z = cvt_pk_bf16(y[4], y[5]); w.w = cvt_pk_bf16(y[6], y[7]);
                    wout[ai * 4 + m][bj] = w;
                }
            }
        }
#pragma unroll
        for (int i = 0; i < 8; ++i) {
            bf16_t* rowp = QKV + (size_t)(row0 + (i >> 2) * 128 + (i & 3) * 16) * 4096 + 2048 + u.pn * 256 + cin;
            *(u32x4*)rowp = wout[i][0]; *(u32x4*)(rowp + 128) = wout[i][1];
        }
    }
};
struct EpiFfn {
    static constexpr bool PERM = true, AFTER_DRAIN = false;
    bf16_t* ACT; const float* rss;
    __device__ __forceinline__ void operator()(const f32x4 (&acc)[2][2][4][2], const Unit& u, int wr, int wc, int fr_, int fq_) const {
        const int tl_ = opaque_tid(), fr = tl_ & 15, fq = (tl_ >> 4) & 3; (void)fr_; (void)fq_;
        const int row0 = u.pm * 256 + wr * 64 + fr, cout = u.pn * 128 + wc * 16 + 4 * fq;
        float rr[8]; row_scales(rr, rss, row0, fq);
#pragma unroll
        for (int ai = 0; ai < 2; ++ai)
#pragma unroll
            for (int m = 0; m < 4; ++m) {
                const int row = row0 + ai * 128 + m * 16;
                const float r = rr[ai * 4 + m];
                bf16_t* rowp = ACT + (size_t)row * DFF + cout;
#pragma unroll
                for (int bj = 0; bj < 2; ++bj) {
                    const f32x4 a = acc[ai][bj][m][0] * r, b = acc[ai][bj][m][1] * r;
                    u32x2 w; w.x = cvt_pk_bf16(silu_f(a[0]) * b[0], silu_f(a[1]) * b[1]); w.y = cvt_pk_bf16(silu_f(a[2]) * b[2], silu_f(a[3]) * b[3]);
                    *(u32x2*)(rowp + bj * 64) = w;
                }
            }
    }
};
struct EpiRes {
    static constexpr bool PERM = false, AFTER_DRAIN = false;
    const float* base_p; const float* base_s; float* xres; bf16_t* xb; float* rss_next;
    __device__ __forceinline__ void operator()(const f32x4 (&acc)[2][2][4][2], const Unit& u, int wr, int wc, int fr_, int fq_) const {
        const int tl_ = opaque_tid(), fr = tl_ & 15, fq = (tl_ >> 4) & 3; (void)fr_; (void)fq_;
        const int row0 = u.pm * 256 + wr * 64 + fr, col0 = u.pn * 256 + wc * 32 + 4 * fq;
#pragma unroll
        for (int ai = 0; ai < 2; ++ai) {
            f32x4 bv[4][4];
#pragma unroll
            for (int m = 0; m < 4; ++m) {
                const int row = row0 + ai * 128 + m * 16;
                const float* bp = (row < NP) ? base_p + (size_t)row * DM : base_s + (size_t)(row - NP) * DM;
#pragma unroll
                for (int q = 0; q < 4; ++q) bv[m][q] = *(const f32x4*)(bp + col0 + (q >> 1) * 128 + (q & 1) * 16);
            }
#pragma unroll
            for (int m = 0; m < 4; ++m) {
                const int row = row0 + ai * 128 + m * 16;
                float ss = 0.f;
#pragma unroll
                for (int bj = 0; bj < 2; ++bj)
#pragma unroll
                    for (int n = 0; n < 2; ++n) {
                        const int c = col0 + bj * 128 + n * 16;
                        const f32x4 v = bv[m][bj * 2 + n] + acc[ai][bj][m][n];
                        *(f32x4*)(xres + (size_t)row * DM + c) = v;
                        u32x2 w; w.x = cvt_pk_bf16(v[0], v[1]); w.y = cvt_pk_bf16(v[2], v[3]);
                        if (xb) *(u32x2*)(xb + (size_t)row * DM + c) = w;
                        ss += (v[0] * v[0] + v[1] * v[1]) + (v[2] * v[2] + v[3] * v[3]);
                    }
                ss += __shfl_xor(ss, 16); ss += __shfl_xor(ss, 32);
                if (fq == 0) rss_next[(size_t)row * 16 + u.pn * 4 + wc] = ss;
            }
        }
    }
};

struct MapId { __device__ __forceinline__ float scale(int) const { return 1.f; } __device__ __forceinline__ int drow(int n) const { return n; } };
struct MapRetIn { __device__ __forceinline__ float scale(int n) const { return (n >= 1024 && n < 2048) ? 0.0625f : 1.f; } __device__ __forceinline__ int drow(int n) const { return n; } };
struct MapFfnIn { __device__ __forceinline__ float scale(int) const { return 1.f; }
    __device__ __forceinline__ int drow(int n) const { const int isb = n >= DFF, j = n - isb * DFF; return (j >> 2) * 8 + isb * 4 + (j & 3); } };
struct MapPool { const float* cs; __device__ __forceinline__ float scale(int n) const { return cs[n]; } __device__ __forceinline__ int drow(int n) const { return n; } };

template <class MapF>
__device__ __forceinline__ void conv_T(LAS unsigned char* lds, const float* src, int K, int Nsrc, int ldsrc, bf16_t* dst, int lddst, const float* gain, const MapF map) {
    const int tid = opaque_tid(), tk = K >> 6, tn = Nsrc >> 8, ntile = tk * tn;
    LAS bf16_t* tile = (LAS bf16_t*)lds;
    for (int t = blockIdx.x; t < ntile; t += gridDim.x) {
        const int k0 = (t % tk) << 6, n0 = (t / tk) << 8;
        {
            const int kk = tid >> 3, nn = (tid & 7) * 8; const float* sp = src + (size_t)(k0 + kk) * ldsrc + n0 + nn;
            const float gk = gain ? gain[k0 + kk] : 1.f;
            float4 a[4], b[4];
#pragma unroll
            for (int q = 0; q < 4; ++q) { a[q] = *(const float4*)(sp + q * 64); b[q] = *(const float4*)(sp + q * 64 + 4); }
#pragma unroll
            for (int q = 0; q < 4; ++q) {
                const int nb = q * 64 + nn; LAS bf16_t* tp = tile + nb * 72 + kk;
                tp[0 * 72] = f2bf(a[q].x * gk * map.scale(n0 + nb + 0)); tp[1 * 72] = f2bf(a[q].y * gk * map.scale(n0 + nb + 1));
                tp[2 * 72] = f2bf(a[q].z * gk * map.scale(n0 + nb + 2)); tp[3 * 72] = f2bf(a[q].w * gk * map.scale(n0 + nb + 3));
                tp[4 * 72] = f2bf(b[q].x * gk * map.scale(n0 + nb + 4)); tp[5 * 72] = f2bf(b[q].y * gk * map.scale(n0 + nb + 5));
                tp[6 * 72] = f2bf(b[q].z * gk * map.scale(n0 + nb + 6)); tp[7 * 72] = f2bf(b[q].w * gk * map.scale(n0 + nb + 7));
            }
        }
        __syncthreads();
        {
            const int nn = tid >> 3, kc = (tid & 7) * 8;
#pragma unroll
            for (int q = 0; q < 4; ++q) {
                const u32x4 raw = *(const LAS u32x4*)(tile + (q * 64 + nn) * 72 + kc);
                *(u32x4*)(dst + (size_t)map.drow(n0 + q * 64 + nn) * lddst + k0 + kc) = raw;
            }
        }
        __syncthreads();
    }
}
__device__ __forceinline__ void convert_ret(const Params& p, LAS unsigned char* lds, int j) {
    conv_T(lds, p.w_ret_in + (size_t)j * 1024 * 6144, 1024, 6144, 6144, (bf16_t*)(p.ws + WS_WRI), 1024, p.norm_mix + (size_t)(2 * j) * DM, MapRetIn{});
    conv_T(lds, p.w_ret_out + (size_t)j * 2048 * 1024, 2048, 1024, 1024, (bf16_t*)(p.ws + WS_WRO), 2048, nullptr, MapId{});
}
__device__ __forceinline__ void convert_pool(const Params& p, LAS unsigned char* lds, int j) {
    bf16_t* W = (bf16_t*)(p.ws + WS_WPL);
    for (size_t i = (size_t)blockIdx.x * blockDim.x + opaque_tid(); i < (size_t)1024 * 128; i += (size_t)gridDim.x * blockDim.x) {
        const int n = (int)(i >> 7), k = (int)(i & 127) * 8;
        if ((n >> 8) != (k >> 8)) { unsigned z = 0u; asm volatile("" : "+v"(z)); *(u32x4*)(W + (size_t)n * 1024 + k) = (u32x4){z, z, z, z}; }
    }
    for (int g = 0; g < 4; ++g)
        conv_T(lds, p.w_pool + ((size_t)j * 4 + g) * 65536, 256, 256, 256, W + (size_t)(g * 256) * 1024 + g * 256, 1024, nullptr, MapPool{p.pool_scale + (size_t)j * DM + g * 256});
}
__device__ __forceinline__ void convert_ffn(const Params& p, LAS unsigned char* lds, int i) {
    conv_T(lds, p.w_ffn_in + (size_t)i * 1024 * 5632, 1024, 5632, 5632, (bf16_t*)(p.ws + WS_WFI), 1024, p.norm_ffn + (size_t)i * DM, MapFfnIn{});
    conv_T(lds, p.w_ffn_out + (size_t)i * DFF * 1024, DFF, 1024, 1024, (bf16_t*)(p.ws + WS_WFO), DFF, nullptr, MapId{});
}
__device__ __forceinline__ void convert_mixer(const Params& p, LAS unsigned char* lds, int layer) { if (layer & 1) convert_pool(p, lds, layer >> 1); else convert_ret(p, lds, layer >> 1); }

__device__ __forceinline__ void phase0(const Params& p, LAS unsigned char* lds) {
    const int tid = opaque_tid(), lane = tid & 63, wid = tid >> 6;
    bf16_t* xb = (bf16_t*)(p.ws + WS_XB); float* rss = (float*)(p.ws + WS_RSS);
    for (int row = blockIdx.x * 8 + wid; row < NTOK; row += gridDim.x * 8) {
        const float* src = (row < NP) ? p.x_prompt + (size_t)row * DM : p.x_sample + (size_t)(row - NP) * DM;
        float ss = 0.f;
#pragma unroll
        for (int i = 0; i < 4; ++i) {
            const float4 v = *(const float4*)(src + i * 256 + lane * 4);
            ss += (v.x * v.x + v.y * v.y) + (v.z * v.z + v.w * v.w);
            u32x2 w; w.x = cvt_pk_bf16(v.x, v.y); w.y = cvt_pk_bf16(v.z, v.w);
            *(u32x2*)(xb + (size_t)row * DM + i * 256 + lane * 4) = w;
        }
#pragma unroll
        for (int o = 32; o >= 1; o >>= 1) ss += __shfl_xor(ss, o);
        if (lane < 16) rss[(size_t)row * 16 + lane] = (lane == 0) ? ss : 0.f;
    }
    const size_t gt = (size_t)blockIdx.x * blockDim.x + tid, nth = (size_t)gridDim.x * blockDim.x;
    float* cosT = (float*)(p.ws + WS_COS); float* sinT = (float*)(p.ws + WS_SIN);
    for (size_t i = gt; i < (size_t)SEQ * 128; i += nth) {
        const int pos = (int)(i >> 7), j = (int)(i & 127);
        const double inv = exp2(-(double)j * 0.10381025296523007), t = (double)pos * inv * 0.31830988618379067154;
        double s, c; sincospi(t, &s, &c);
        cosT[i] = (float)c; sinT[i] = (float)s;
    }
    convert_mixer(p, lds, 0); convert_mixer(p, lds, 1); convert_ffn(p, lds, 0);
}

template <int W>
__device__ __forceinline__ void pool_unit(const float* xres, const float* sp, const LAS float* rl, bf16_t* dbuf, float* po, int rowbase, int t0, int c0, float g0, float g1, bool isS, bool lastu) {
    float2 hv[15 + W];
#pragma unroll
    for (int i = 0; i < 15 + W; ++i) {
        const int t = t0 - (W - 1) + i;
        float2 v = make_float2(0.f, 0.f);
        if (t >= 0) { const float2 x = *(const float2*)(xres + (size_t)(rowbase + t) * DM + c0); const float r = rl[i + 16 - W]; v = make_float2(x.x * r * g0, x.y * r * g1); }
        else if (isS) v = *(const float2*)(sp + (size_t)(15 + t) * DM + c0);
        hv[i] = v;
    }
    float2 s = make_float2(0.f, 0.f);
#pragma unroll
    for (int i = 0; i < W - 1; ++i) { s.x += hv[i].x; s.y += hv[i].y; }
#pragma unroll
    for (int k = 0; k < 16; ++k) {
        const float2 h = hv[W - 1 + k];
        s.x += h.x; s.y += h.y;
        const float inv = 1.0f / (isS ? (float)W : (float)min(t0 + k + 1, W));
        *(unsigned*)(dbuf + (size_t)(rowbase + t0 + k) * DM + c0) = cvt_pk_bf16(s.x * inv - h.x, s.y * inv - h.y);
        if (lastu && k >= 1) *(float2*)(po + (size_t)(k - 1) * DM + c0) = h;
        s.x -= hv[k].x; s.y -= hv[k].y;
    }
}
__device__ __forceinline__ void phase_pool_prep(const Params& p, LAS unsigned char* lds, int layer) {
    const int j = layer >> 1, tid = opaque_tid(), c0 = tid * 2, gi = __builtin_amdgcn_readfirstlane(tid >> 7);
    const float* xres = p.out; const float* rssc = (const float*)(p.ws + WS_RSS) + (size_t)(2 * layer) * NTOK * 16;
    const float g0 = p.norm_mix[(size_t)layer * DM + c0], g1 = p.norm_mix[(size_t)layer * DM + c0 + 1];
    bf16_t* dbuf = (bf16_t*)(p.ws + WS_QKV);
    LAS float* rl = (LAS float*)lds;
    for (int u = blockIdx.x; u < 2064; u += gridDim.x) {
        int t0, rowbase; bool isS, lastu; const float* sp = nullptr; float* po;
        if (u < 2048) { const int b = u >> 10; t0 = (u & 1023) * 16; rowbase = b * SEQ; isS = false; lastu = (u & 1023) == 1023; po = p.out + OUT_POOLP + ((size_t)(j * 2 + b) * 15) * DM; }
        else { const int sb = u - 2048; t0 = 0; rowbase = NP + sb * 16; isS = true; lastu = true; sp = p.state_pool + ((size_t)(j * 16 + sb) * 15) * DM; po = p.out + OUT_POOLS + ((size_t)(j * 16 + sb) * 15) * DM; }
        __syncthreads();
        if (tid < 31) { const int t = t0 - 15 + tid; rl[tid] = (t >= 0) ? rs_row(rssc + (size_t)(rowbase + t) * 16) : 0.f; }
        __syncthreads();
        if (gi == 0) pool_unit<2>(xres, sp, rl, dbuf, po, rowbase, t0, c0, g0, g1, isS, lastu);
        else if (gi == 1) pool_unit<4>(xres, sp, rl, dbuf, po, rowbase, t0, c0, g0, g1, isS, lastu);
        else if (gi == 2) pool_unit<8>(xres, sp, rl, dbuf, po, rowbase, t0, c0, g0, g1, isS, lastu);
        else pool_unit<16>(xres, sp, rl, dbuf, po, rowbase, t0, c0, g0, g1, isS, lastu);
    }
}

__device__ __forceinline__ void phase_final(const Params& p) {
    const float* rssc = (const float*)(p.ws + WS_RSS) + (size_t)8 * NTOK * 16;
    for (size_t i = (size_t)blockIdx.x * blockDim.x + opaque_tid(); i < (size_t)NTOK * 256; i += (size_t)gridDim.x * blockDim.x) {
        const int row = (int)(i >> 8), c = (int)(i & 255) * 4;
        const float r = rs_row(rssc + (size_t)row * 16);
        const float4 g = *(const float4*)(p.norm_final + c);
        float4 v = *(const float4*)(p.out + (size_t)row * DM + c);
        v.x *= r * g.x; v.y *= r * g.y; v.z *= r * g.z; v.w *= r * g.w;
        *(float4*)(p.out + (size_t)row * DM + c) = v;
    }
}

__device__ __forceinline__ unsigned offb(unsigned row, unsigned ch) { return 256u * row + 16u * (ch ^ (((row & 3u) << 2) | ((row >> 2) & 3u))); }
__device__ __forceinline__ unsigned img_off(unsigned row, unsigned ch32) { return (ch32 >> 4) * 16384u + offb(row, ch32 & 15u); }
constexpr unsigned IMG_Q = 0, IMG_K = 32768, IMG_V = 65536, IMG_P = 98304, IMG_O = 107520;

__device__ __forceinline__ void tile_load(u32x4 (&r)[4], const bf16_t* g, int ld, int nvalid, int tid_) {
    int tid = tid_; asm volatile("" : "+v"(tid));
    const int r0 = (tid >> 5) & 15, ch = tid & 31;
    const bf16_t* gp = g + (size_t)r0 * ld + ch * 8;
    if (nvalid >= 64) {
#pragma unroll
        for (int i = 0; i < 4; ++i) r[i] = *(const u32x4*)(gp + (size_t)(16 * i) * ld);
    } else {
        r[0] = *(const u32x4*)gp;
        unsigned z = 0u; asm volatile("" : "+v"(z));
#pragma unroll
        for (int i = 1; i < 4; ++i) r[i] = (u32x4){z, z, z, z};
    }
}
__device__ __forceinline__ void tile_store(LAS unsigned char* img, const u32x4 (&r)[4], int tid_) {
    int tid = tid_; asm volatile("" : "+v"(tid));
    const unsigned r0 = (tid >> 5) & 15, ch = tid & 31;
    LAS unsigned char* bp = img + img_off(r0, ch);
#pragma unroll
    for (int i = 0; i < 4; ++i) *(LAS u32x4*)(bp + 4096 * i) = r[i];
}
__device__ __forceinline__ bf16x8 tr_frag(LAS unsigned char* img, int lane, int cblk  , int ks) {
    const unsigned h = lane >> 5, blk = (lane >> 4) & 1, q = (lane & 15) >> 2, pp = lane & 3;
    const unsigned c = cblk & 3;
    const unsigned lowc = 2 * blk + (pp >> 1);
    const unsigned chx0 = ((c ^ q) << 2) | (lowc ^ (2 * h)), chx1 = chx0 ^ 1u;
    const unsigned rb = 256u * (8 * h + q) + 8 * (pp & 1);
    const unsigned a0 = rb + 16u * chx0, a1 = rb + 1024u + 16u * chx1;
    LAS unsigned char* base = img + (cblk >> 2) * 16384 + ks * 4096;
    const s16x4 lo = __builtin_amdgcn_ds_read_tr16_b64_v4i16((LAS s16x4*)(base + a0));
    const s16x4 hi = __builtin_amdgcn_ds_read_tr16_b64_v4i16((LAS s16x4*)(base + a1));
    return __builtin_shufflevector(lo, hi, 0, 1, 2, 3, 4, 5, 6, 7);
}
__device__ __forceinline__ bf16x8 pack8(const f32x16& s, int base) {
    u32x4 w; w.x = cvt_pk_bf16(s[base + 0], s[base + 1]); w.y = cvt_pk_bf16(s[base + 2], s[base + 3]); w.z = cvt_pk_bf16(s[base + 4], s[base + 5]); w.w = cvt_pk_bf16(s[base + 6], s[base + 7]);
    return __builtin_bit_cast(bf16x8, w);
}

__device__ __forceinline__ void state_update(f32x16 (&S)[8], LAS unsigned char* kimg, const bf16x8 (&Vf)[4], int lane) {
#pragma unroll
    for (int dt = 0; dt < 8; ++dt)
#pragma unroll
        for (int ks = 0; ks < 4; ++ks) {
            const bf16x8 a = tr_frag(kimg, lane, dt, ks);
            S[dt] = __builtin_amdgcn_mfma_f32_32x32x16_bf16(a, Vf[ks], S[dt], 0, 0, 0);
        }
}

__device__ __forceinline__ void phase_scan_local(const Params& p, LAS unsigned char* lds) {
    const int tid = opaque_tid(), lane_ = tid & 63, wid = __builtin_amdgcn_readfirstlane(tid >> 6);
    const bf16_t* qkv = (const bf16_t*)(p.ws + WS_QKV); float* T = (float*)(p.ws + WS_T);
    for (int u_ = blockIdx.x; u_ < 256; u_ += gridDim.x) {
        const int u = (gridDim.x == 256) ? (((u_ >> 4) << 4) | ((u_ & 7) << 1) | ((u_ >> 3) & 1)) : u_;
        const int eh = u & 1, seg = (u >> 1) & 15, h = (u >> 5) & 3, b = u >> 7;
        const size_t row0 = (size_t)b * SEQ + (size_t)seg * 1024;
        const bf16_t* kb = qkv + row0 * 4096 + 1024 + h * 256; const bf16_t* vb = qkv + row0 * 4096 + 2048 + h * 512 + eh * 256;
        const float gC = exp2f(64.f * lg2gamma(h));
        f32x16 S[8];
#pragma unroll
        for (int i = 0; i < 8; ++i)
#pragma unroll
            for (int r = 0; r < 16; ++r) S[i][r] = 0.f;
        u32x4 rk0[4], rv0[4], rk1[4], rv1[4];
        tile_load(rk0, kb, 4096, 64, tid); tile_load(rv0, vb, 4096, 64, tid);
        tile_load(rk1, kb + (size_t)64 * 4096, 4096, 64, tid); tile_load(rv1, vb + (size_t)64 * 4096, 4096, 64, tid);
        LDS_BARRIER();
        tile_store(lds, rk0, tid); tile_store(lds + 32768, rv0, tid);
        LDS_BARRIER();
        tile_load(rk0, kb + (size_t)2 * 64 * 4096, 4096, 64, tid); tile_load(rv0, vb + (size_t)2 * 64 * 4096, 4096, 64, tid);
        for (int c = 0; c < 16; c += 2) {
            {
                int lane = lane_; asm volatile("" : "+v"(lane));
                tile_store(lds + 65536, rk1, tid); tile_store(lds + 98304, rv1, tid);
#pragma unroll
                for (int i = 0; i < 8; ++i) S[i] *= gC;
                bf16x8 Vf[4];
#pragma unroll
                for (int ks = 0; ks < 4; ++ks) Vf[ks] = tr_frag(lds + 32768, lane, wid, ks);
                state_update(S, lds, Vf, lane);
                LDS_BARRIER();
                if (c + 3 < 16) { tile_load(rk1, kb + (size_t)(c + 3) * 64 * 4096, 4096, 64, tid); tile_load(rv1, vb + (size_t)(c + 3) * 64 * 4096, 4096, 64, tid); }
            }
            {
                int lane = lane_; asm volatile("" : "+v"(lane));
                if (c + 2 < 16) { tile_store(lds, rk0, tid); tile_store(lds + 32768, rv0, tid); }
#pragma unroll
                for (int i = 0; i < 8; ++i) S[i] *= gC;
                bf16x8 Vf[4];
#pragma unroll
                for (int ks = 0; ks < 4; ++ks) Vf[ks] = tr_frag(lds + 98304, lane, wid, ks);
                state_update(S, lds + 65536, Vf, lane);
                LDS_BARRIER();
                if (c + 4 < 16) { tile_load(rk0, kb + (size_t)(c + 4) * 64 * 4096, 4096, 64, tid); tile_load(rv0, vb + (size_t)(c + 4) * 64 * 4096, 4096, 64, tid); }
            }
        }
        float* Tu = T + (size_t)u * 65536;
        int lz = lane_; asm volatile("" : "+v"(lz));
        const int hl = lz >> 5, e = wid * 32 + (lz & 31);
#pragma unroll
        for (int dt = 0; dt < 8; ++dt)
#pragma unroll
            for (int r = 0; r < 16; ++r) Tu[(size_t)(32 * dt + (r & 3) + 8 * (r >> 2) + 4 * hl) * 256 + e] = S[dt][r];
    }
}

__device__ __forceinline__ void phase_scan_prefix(const Params& p, int jl) {
    float* T = (float*)(p.ws + WS_T);
    const int gt = blockIdx.x * 512 + opaque_tid(), nth = gridDim.x * 512;
    for (int i = gt; i < 262144; i += nth) {
        const int grp = i >> 14, pos = (i & 16383) * 4, eh = grp & 1, bh = grp >> 1, h = bh & 3;
        const float gS = exp2f(1024.f * lg2gamma(h));
        float* base = T + ((size_t)(bh * 16) * 2 + eh) * 65536 + pos;
        float4 t[16];
#pragma unroll
        for (int j = 0; j < 16; ++j) t[j] = *(const float4*)(base + (size_t)j * 131072);
        float zf = 0.f; asm volatile("" : "+v"(zf));
        float4 run = make_float4(zf, zf, zf, zf);
#pragma unroll
        for (int j = 0; j < 16; ++j) {
            *(float4*)(base + (size_t)j * 131072) = run;
            run.x = run.x * gS + t[j].x; run.y = run.y * gS + t[j].y; run.z = run.z * gS + t[j].z; run.w = run.w * gS + t[j].w;
        }
        const int d = pos >> 8, e = pos & 255;
        *(float4*)(p.out + OUT_RETP + ((size_t)((jl * 2 + (bh >> 2)) * 4 + h) * 256 + d) * 512 + eh * 256 + e) = run;
    }
}

__device__ __forceinline__ void phase_scan(const Params& p, LAS unsigned char* lds, int jl) {
    const int tid = opaque_tid(), lane_ = tid & 63, wid = __builtin_amdgcn_readfirstlane(tid >> 6);
    bf16_t* qkv = (bf16_t*)(p.ws + WS_QKV); const float* T = (const float*)(p.ws + WS_T);
    float* gss = (float*)(p.ws + WS_GSS) + (size_t)jl * NTOK * 8;
    for (int v_ = blockIdx.x; v_ < 384; v_ += gridDim.x) {
        const int v = (gridDim.x == 256) ? ((v_ & 256) | (((v_ & 255) >> 4) << 4) | ((v_ & 7) << 1) | ((v_ >> 3) & 1)) : v_;
        int eh, h, Lc, nch; size_t row0; float* Sout = nullptr;
        f32x16 S[8];
        if (v < 256) {
            eh = v & 1; const int seg = (v >> 1) & 15; h = (v >> 5) & 3; const int b = v >> 7;
            row0 = (size_t)b * SEQ + (size_t)seg * 1024; Lc = 64; nch = 16;
            {
                int lz = lane_; asm volatile("" : "+v"(lz)); const int hl_ = lz >> 5, ecol_ = wid * 32 + (lz & 31);
                const float* Tu = T + (size_t)v * 65536;
#pragma unroll
                for (int dt = 0; dt < 8; ++dt)
#pragma unroll
                    for (int r = 0; r < 16; ++r) S[dt][r] = Tu[(size_t)(32 * dt + (r & 3) + 8 * (r >> 2) + 4 * hl_) * 256 + ecol_];
            }
        } else {
            const int su = v - 256; eh = su & 1; h = (su >> 1) & 3; const int sb = su >> 3;
            row0 = (size_t)NP + (size_t)sb * 16; Lc = 16; nch = 1;
            Sout = p.out + OUT_RETS + ((size_t)((jl * 16 + sb) * 4 + h) * 256) * 512 + eh * 256;
            int lz = lane_; asm volatile("" : "+v"(lz)); const int hl_ = lz >> 5, ecol_ = wid * 32 + (lz & 31);
            const float* Sin = p.state_ret + ((size_t)((jl * 16 + sb) * 4 + h) * 256) * 512 + eh * 256;
#pragma unroll
            for (int dt = 0; dt < 8; ++dt)
#pragma unroll
                for (int r = 0; r < 16; ++r) S[dt][r] = Sin[(size_t)(32 * dt + (r & 3) + 8 * (r >> 2) + 4 * hl_) * 512 + ecol_];
        }
        const float lg = lg2gamma(h), gC = exp2f((float)Lc * lg), gCinv = exp2f(-(float)Lc * lg);
        bf16_t* qb = qkv + row0 * 4096 + h * 256; bf16_t* kb = qkv + row0 * 4096 + 1024 + h * 256; bf16_t* vb = qkv + row0 * 4096 + 2048 + h * 512 + eh * 256;
        u32x4 rq[4], rk[4], rv[4];
        tile_load(rq, qb, 4096, Lc, tid); tile_load(rk, kb, 4096, Lc, tid); tile_load(rv, vb, 4096, Lc, tid);
        LDS_BARRIER();
        tile_store(lds + IMG_Q, rq, tid); tile_store(lds + IMG_K, rk, tid); tile_store(lds + IMG_V, rv, tid);
        LDS_BARRIER();
        for (int c = 0; c < nch; ++c) {
            int lane = lane_; asm volatile("" : "+v"(lane)); const int hl = lane >> 5, ecol = wid * 32 + (lane & 31);
            {
                const int mi = wid >> 1, nj0 = 2 * (wid & 1), l15 = lane & 15, l4 = lane >> 4;
                f32x4 sc[2] = {(f32x4){0.f, 0.f, 0.f, 0.f}, (f32x4){0.f, 0.f, 0.f, 0.f}};
#pragma unroll
                for (int s = 0; s < 8; ++s) {
                    const bf16x8 a = *(const LAS bf16x8*)(lds + IMG_K + img_off(16 * mi + l15, 4 * s + l4));
#pragma unroll
                    for (int t = 0; t < 2; ++t) {
                        const bf16x8 bq = *(const LAS bf16x8*)(lds + IMG_Q + img_off(16 * (nj0 + t) + l15, 4 * s + l4));
                        sc[t] = __builtin_amdgcn_mfma_f32_16x16x32_bf16(a, bq, sc[t], 0, 0, 0);
                    }
                }
#pragma unroll
                for (int t = 0; t < 2; ++t) {
                    const int n = 16 * (nj0 + t) + l15, m0 = 16 * mi + 4 * l4;
                    float pv[4];
#pragma unroll
                    for (int r = 0; r < 4; ++r) pv[r] = (n >= m0 + r) ? sc[t][r] * gCinv : 0.f;
                    u32x2 w; w.x = cvt_pk_bf16(pv[0], pv[1]); w.y = cvt_pk_bf16(pv[2], pv[3]);
                    *(LAS u32x2*)(lds + IMG_P + n * 144 + m0 * 2) = w;
                }
            }
            LDS_BARRIER();
            f32x16 o[2];
#pragma unroll
            for (int nt = 0; nt < 2; ++nt)
#pragma unroll
                for (int r = 0; r < 16; ++r) o[nt][r] = 0.f;
#pragma unroll
            for (int s = 0; s < 16; ++s) {
                const bf16x8 bs = pack8(S[s >> 1], 8 * (s & 1));
#pragma unroll
                for (int nt = 0; nt < 2; ++nt) {
                    const unsigned rown = 32 * nt + (lane & 31);
                    const u32x2 lo = *(const LAS u32x2*)(lds + IMG_Q + img_off(rown, 2 * s) + 8 * hl);
                    const u32x2 hi = *(const LAS u32x2*)(lds + IMG_Q + img_off(rown, 2 * s + 1) + 8 * hl);
                    const u32x4 aw = (u32x4){lo.x, lo.y, hi.x, hi.y};
                    o[nt] = __builtin_amdgcn_mfma_f32_32x32x16_bf16(__builtin_bit_cast(bf16x8, aw), bs, o[nt], 0, 0, 0);
                }
            }
            bf16x8 Vf[4];
#pragma unroll
            for (int ks = 0; ks < 4; ++ks) Vf[ks] = tr_frag(lds + IMG_V, lane, wid, ks);
#pragma unroll
            for (int ks = 0; ks < 4; ++ks)
#pragma unroll
                for (int nt = 0; nt < 2; ++nt) {
                    const bf16x8 a = *(const LAS bf16x8*)(lds + IMG_P + (32 * nt + (lane & 31)) * 144 + (16 * ks + 8 * hl) * 2);
                    o[nt] = __builtin_amdgcn_mfma_f32_32x32x16_bf16(a, Vf[ks], o[nt], 0, 0, 0);
                }
            {
                LAS unsigned char* oi = lds + IMG_O + (4 * hl) * 528 + ecol * 2;
#pragma unroll
                for (int nt = 0; nt < 2; ++nt)
#pragma unroll
                    for (int r = 0; r < 16; ++r) *(LAS bf16_t*)(oi + (32 * nt + (r & 3) + 8 * (r >> 2)) * 528) = (bf16_t)cvt_pk_bf16(o[nt][r], o[nt][r]);
            }
            if (c + 1 < nch) { tile_load(rk, kb + (size_t)(c + 1) * 64 * 4096, 4096, 64, tid); tile_load(rv, vb + (size_t)(c + 1) * 64 * 4096, 4096, 64, tid); }
#pragma unroll
            for (int i = 0; i < 8; ++i) S[i] *= gC;
            {
                int lane2 = lane_; asm volatile("" : "+v"(lane2));
                bf16x8 Vg[4];
#pragma unroll
                for (int ks = 0; ks < 4; ++ks) Vg[ks] = tr_frag(lds + IMG_V, lane2, wid, ks);
                state_update(S, lds + IMG_K, Vg, lane2);
            }
            __builtin_amdgcn_sched_barrier(0);
            LDS_BARRIER();
            if (c + 1 < nch) { tile_load(rq, qb + (size_t)(c + 1) * 64 * 4096, 4096, 64, tid); tile_store(lds + IMG_K, rk, tid); tile_store(lds + IMG_V, rv, tid); tile_store(lds + IMG_Q, rq, tid); }
            {
                int t2 = tid; asm volatile("" : "+v"(t2));
                const int r0 = (t2 >> 5) & 15, ch = t2 & 31;
                bf16_t* og = vb + (size_t)c * 64 * 4096 + (size_t)r0 * 4096 + ch * 8;
#pragma unroll
                for (int i = 0; i < 4; ++i) {
                    if (i == 0 || Lc == 64) {
                        const u32x4 w = *(const LAS u32x4*)(lds + IMG_O + (r0 + 16 * i) * 528 + ch * 16);
                        *(u32x4*)(og + (size_t)(16 * i) * 4096) = w;
                        const float a0 = __uint_as_float(w.x << 16), a1 = __uint_as_float(w.x & 0xffff0000u), a2 = __uint_as_float(w.y << 16), a3 = __uint_as_float(w.y & 0xffff0000u);
                        const float a4 = __uint_as_float(w.z << 16), a5 = __uint_as_float(w.z & 0xffff0000u), a6 = __uint_as_float(w.w << 16), a7 = __uint_as_float(w.w & 0xffff0000u);
                        float ss = ((a0 * a0 + a1 * a1) + (a2 * a2 + a3 * a3)) + ((a4 * a4 + a5 * a5) + (a6 * a6 + a7 * a7));
                        ss += __shfl_xor(ss, 16); ss += __shfl_xor(ss, 8); ss += __shfl_xor(ss, 4); ss += __shfl_xor(ss, 2); ss += __shfl_xor(ss, 1);
                        if (ch == 0) gss[((row0 + (size_t)c * 64 + r0 + 16 * i) * 4 + h) * 2 + eh] = ss;
                    }
                }
            }
            LDS_BARRIER();
        }
        if (Sout) {
            int lz = lane_; asm volatile("" : "+v"(lz)); const int hl_ = lz >> 5, ecol_ = wid * 32 + (lz & 31);
#pragma unroll
            for (int dt = 0; dt < 8; ++dt)
#pragma unroll
                for (int r = 0; r < 16; ++r) Sout[(size_t)(32 * dt + (r & 3) + 8 * (r >> 2) + 4 * hl_) * 512 + ecol_] = S[dt][r];
        }
    }
}

struct PoolOrder : pg8::StaticOrder {
    __device__ __forceinline__ bool next(int i, Unit& u) const { const bool ok = pg8::StaticOrder::next(i, u); if (ok) u.kofs = u.pn * 256; return ok; }
};
template <class Epi>
__device__ __forceinline__ void run_gemm(LAS unsigned char* lds, const bf16_t* A, int lda, const bf16_t* Bt, int N, int K, const Epi& E, int M = NTOK) {
    pg8::Gemm g{A, Bt, M, N, K, lda, K}; pg8::StaticOrder S; S.init(M, N, (int)gridDim.x, (int)blockIdx.x);
    pg8::gemm_phase<Epi, pg8::StaticOrder, false>(lds, g, S, E, nullptr);
}

__device__ __forceinline__ void narrow_core(LAS unsigned char* lds, const bf16_t* ag, int lda, const bf16_t* bg0, const bf16_t* bg1, int K, f32x16& acc0, f32x16& acc1, int tid, int lane, int wid) {
    const int lr = tid >> 4, lc = tid & 15, hl = lane >> 5, l31 = lane & 31;
#pragma unroll
    for (int i = 0; i < 16; ++i) { acc0[i] = 0.f; acc1[i] = 0.f; }
    u32x4 ra0[8], rb0[2], ra1[8], rb1[2];
#define NR_LOAD(RA, RB, KO) do { int ko_ = (KO); asm volatile("" : "+s"(ko_)); const bf16_t* agp = ag + ko_; const bf16_t* b0p = bg0 + ko_; const bf16_t* b1p = bg1 + ko_; \
        _Pragma("unroll") for (int q = 0; q < 8; ++q) { RA[q] = *(const u32x4*)agp; agp += (size_t)32 * lda; } \
        RB[0] = *(const u32x4*)b0p; RB[1] = *(const u32x4*)b1p; } while (0)
#define NR_STORE(RA, RB) do { _Pragma("unroll") for (int q = 0; q < 8; ++q) *(LAS u32x4*)(lds + (q >> 1) * 16384 + offb((q & 1) * 32 + lr, lc)) = RA[q]; \
        *(LAS u32x4*)(lds + 65536 + offb(lr, lc)) = RB[0]; *(LAS u32x4*)(lds + 65536 + offb(32 + lr, lc)) = RB[1]; } while (0)
#define NR_COMPUTE() do { LAS unsigned char* ai = lds + (wid >> 1) * 16384; const unsigned arow = (wid & 1) * 32 + l31; \
        _Pragma("unroll") for (int q = 0; q < 8; ++q) { \
            const bf16x8 a = *(const LAS bf16x8*)(ai + offb(arow, 2 * q + hl)); \
            const bf16x8 x0 = *(const LAS bf16x8*)(lds + 65536 + offb(l31, 2 * q + hl)); \
            const bf16x8 x1 = *(const LAS bf16x8*)(lds + 65536 + offb(32 + l31, 2 * q + hl)); \
            acc0 = __builtin_amdgcn_mfma_f32_32x32x16_bf16(a, x0, acc0, 0, 0, 0); acc1 = __builtin_amdgcn_mfma_f32_32x32x16_bf16(a, x1, acc1, 0, 0, 0); } } while (0)
    NR_LOAD(ra0, rb0, 0); NR_LOAD(ra1, rb1, 128);
    LDS_BARRIER();
    for (int k = 0; k < K; k += 256) {
        NR_STORE(ra0, rb0); LDS_BARRIER();
        if (k + 256 < K) NR_LOAD(ra0, rb0, k + 256);
        NR_COMPUTE(); LDS_BARRIER();
        NR_STORE(ra1, rb1); LDS_BARRIER();
        if (k + 384 < K) NR_LOAD(ra1, rb1, k + 384);
        NR_COMPUTE(); LDS_BARRIER();
    }
#undef NR_LOAD
#undef NR_STORE
#undef NR_COMPUTE
}
__device__ __forceinline__ void narrow_scales(LAS unsigned char* lds, const float* rss, int tid) {
    if (tid < 256) ((LAS float*)(lds + 81920))[tid] = rs_row(rss + (size_t)(NP + tid) * 16);
}
__device__ __forceinline__ void narrow_ffn(LAS unsigned char* lds, const bf16_t* xb, const bf16_t* Wfi, bf16_t* act, const float* rss) {
    const int tid = opaque_tid(), lane = tid & 63, wid = __builtin_amdgcn_readfirstlane(tid >> 6), lr = tid >> 4, lc = tid & 15;
    for (int j = blockIdx.x; j < 88; j += gridDim.x) {
        const int jj = 32 * j + lr, dra = (jj >> 2) * 8 + (jj & 3);
        f32x16 acc0, acc1;
        __syncthreads(); narrow_scales(lds, rss, tid);
        narrow_core(lds, xb + (size_t)(NP + lr) * DM + lc * 8, DM, Wfi + (size_t)dra * DM + lc * 8, Wfi + (size_t)(dra + 4) * DM + lc * 8, DM, acc0, acc1, tid, lane, wid);
        int lz = lane; asm volatile("" : "+v"(lz)); const int hl = lz >> 5, l31 = lz & 31;
#pragma unroll
        for (int i = 0; i < 16; ++i) {
            const int rs = 32 * wid + (i & 3) + 8 * (i >> 2) + 4 * hl; const float r = ((const LAS float*)(lds + 81920))[rs];
            act[(size_t)(NP + rs) * DFF + 32 * j + l31] = f2bf(silu_f(acc0[i] * r) * (acc1[i] * r));
        }
    }
}
__device__ __forceinline__ void narrow_qkv(LAS unsigned char* lds, const bf16_t* xb, const bf16_t* Wri, bf16_t* qkv, const float* rss, const float* cosT, const float* sinT) {
    const int tid = opaque_tid(), lane = tid & 63, wid = __builtin_amdgcn_readfirstlane(tid >> 6), lr = tid >> 4, lc = tid & 15;
    for (int j = blockIdx.x; j < 64; j += gridDim.x) {
        const bool rot = j < 32; const int hd = j >> 2, j0 = (j & 3) * 32;
        const int cA = rot ? hd * 256 + j0 : 2048 + (j - 32) * 64, cB = rot ? cA + 128 : cA + 32;
        f32x16 acc0, acc1;
        __syncthreads(); narrow_scales(lds, rss, tid);
        narrow_core(lds, xb + (size_t)(NP + lr) * DM + lc * 8, DM, Wri + (size_t)(cA + lr) * DM + lc * 8, Wri + (size_t)(cB + lr) * DM + lc * 8, DM, acc0, acc1, tid, lane, wid);
        int lz = lane; asm volatile("" : "+v"(lz)); const int hl = lz >> 5, l31 = lz & 31;
        const float lg = lg2gamma(hd & 3);
        float cs[16], sn_[16];
        if (rot) {
#pragma unroll
            for (int i = 0; i < 16; ++i) { const int l = (32 * wid + (i & 3) + 8 * (i >> 2) + 4 * hl) & 15; cs[i] = cosT[(size_t)(1024 + l) * 128 + j0 + l31]; sn_[i] = sinT[(size_t)(1024 + l) * 128 + j0 + l31]; }
        }
#pragma unroll
        for (int i = 0; i < 16; ++i) {
            const int rs = 32 * wid + (i & 3) + 8 * (i >> 2) + 4 * hl; const float r = ((const LAS float*)(lds + 81920))[rs];
            bf16_t* op = qkv + (size_t)(NP + rs) * 4096;
            if (rot) {
                const int l = rs & 15; const float e = (hd < 4) ? (float)(l + 1) : (float)(15 - l);
                const float dec = exp2f(e * lg) * r, x1 = acc0[i] * dec, x2 = acc1[i] * dec;
                const float c = cs[i], sn = sn_[i];
                op[cA + l31] = f2bf(x1 * c - x2 * sn); op[cB + l31] = f2bf(x1 * sn + x2 * c);
            } else { op[cA + l31] = f2bf(acc0[i] * r); op[cB + l31] = f2bf(acc1[i] * r); }
        }
    }
}
__device__ __forceinline__ void narrow_gate(LAS unsigned char* lds, const bf16_t* xb, const bf16_t* Wg, bf16_t* qkv, const float* rss, const float* gss) {
    const int tid = opaque_tid(), lane = tid & 63, wid = __builtin_amdgcn_readfirstlane(tid >> 6), lr = tid >> 4, lc = tid & 15;
    for (int j = blockIdx.x; j < 32; j += gridDim.x) {
        const int cA = j * 64, head = j >> 3;
        f32x16 acc0, acc1;
        __syncthreads(); narrow_scales(lds, rss, tid);
        if (tid < 256) { const float2 gp = *(const float2*)(gss + ((size_t)(NP + tid) * 4 + head) * 2); ((LAS float*)(lds + 81920 + 1024))[tid] = __builtin_amdgcn_rsqf((gp.x + gp.y) * (1.0f / 512.0f) + EPS); }
        narrow_core(lds, xb + (size_t)(NP + lr) * DM + lc * 8, DM, Wg + (size_t)(cA + lr) * DM + lc * 8, Wg + (size_t)(cA + 32 + lr) * DM + lc * 8, DM, acc0, acc1, tid, lane, wid);
        int lz = lane; asm volatile("" : "+v"(lz)); const int hl = lz >> 5, l31 = lz & 31;
        unsigned short ob0[16], ob1[16];
#pragma unroll
        for (int i = 0; i < 16; ++i) { const bf16_t* op = qkv + (size_t)(NP + 32 * wid + (i & 3) + 8 * (i >> 2) + 4 * hl) * 4096 + 2048 + cA + l31; ob0[i] = op[0]; ob1[i] = op[32]; }
#pragma unroll
        for (int i = 0; i < 16; ++i) {
            const int rs = 32 * wid + (i & 3) + 8 * (i >> 2) + 4 * hl; const float r = ((const LAS float*)(lds + 81920))[rs], rn = ((const LAS float*)(lds + 81920 + 1024))[rs];
            bf16_t* op = qkv + (size_t)(NP + rs) * 4096 + 2048 + cA + l31;
            const float o0 = __uint_as_float(((unsigned)ob0[i]) << 16), o1 = __uint_as_float(((unsigned)ob1[i]) << 16);
            op[0] = f2bf(silu_f(acc0[i] * r) * o0 * rn); op[32] = f2bf(silu_f(acc1[i] * r) * o1 * rn);
        }
    }
}
__device__ __forceinline__ void narrow_res(LAS unsigned char* lds, const bf16_t* A, int lda, const bf16_t* Bt, int K, const EpiRes& E, int ldb = 0, int kstep = 0) {
    const int tid = opaque_tid(), lane = tid & 63, wid = __builtin_amdgcn_readfirstlane(tid >> 6), lr = tid >> 4, lc = tid & 15;
    for (int j = blockIdx.x; j < 16; j += gridDim.x) {
        const int pn = j >> 2, wc = j & 3, c0 = pn * 256 + wc * 32;
        f32x16 acc0, acc1;
        __syncthreads();
        const int ldb_ = ldb ? ldb : K, ko = pn * kstep;
        narrow_core(lds, A + (size_t)(NP + lr) * lda + ko + lc * 8, lda, Bt + (size_t)(c0 + lr) * ldb_ + ko + lc * 8, Bt + (size_t)(c0 + 128 + lr) * ldb_ + ko + lc * 8, K, acc0, acc1, tid, lane, wid);
        float sq[16];
        int lz = lane; asm volatile("" : "+v"(lz)); const int hl = lz >> 5, l31 = lz & 31;
        float bb0[16], bb1[16];
#pragma unroll
        for (int i = 0; i < 16; ++i) { const float* bp = E.base_s + (size_t)(32 * wid + (i & 3) + 8 * (i >> 2) + 4 * hl) * DM + c0 + l31; bb0[i] = bp[0]; bb1[i] = bp[128]; }
#pragma unroll
        for (int i = 0; i < 16; ++i) {
            const int rs = 32 * wid + (i & 3) + 8 * (i >> 2) + 4 * hl;
            const float v0 = bb0[i] + acc0[i], v1 = bb1[i] + acc1[i];
            float* xo = E.xres + (size_t)(NP + rs) * DM + c0 + l31; xo[0] = v0; xo[128] = v1;
            if (E.xb) { bf16_t* bo = E.xb + (size_t)(NP + rs) * DM + c0 + l31; bo[0] = f2bf(v0); bo[128] = f2bf(v1); }
            sq[i] = v0 * v0 + v1 * v1;
        }
        float s8[8], s4[4], s2[2], s1;
        { const bool bit = (lane & 16) != 0;
#pragma unroll
          for (int i = 0; i < 8; ++i) { const float keep = bit ? sq[i + 8] : sq[i], send = bit ? sq[i] : sq[i + 8]; s8[i] = keep + __shfl_xor(send, 16); } }
        { const bool bit = (lane & 8) != 0;
#pragma unroll
          for (int i = 0; i < 4; ++i) { const float keep = bit ? s8[i + 4] : s8[i], send = bit ? s8[i] : s8[i + 4]; s4[i] = keep + __shfl_xor(send, 8); } }
        { const bool bit = (lane & 4) != 0;
#pragma unroll
          for (int i = 0; i < 2; ++i) { const float keep = bit ? s4[i + 2] : s4[i], send = bit ? s4[i] : s4[i + 2]; s2[i] = keep + __shfl_xor(send, 4); } }
        { const bool bit = (lane & 2) != 0; const float keep = bit ? s2[1] : s2[0], send = bit ? s2[0] : s2[1]; s1 = keep + __shfl_xor(send, 2); }
        s1 += __shfl_xor(s1, 1);
        const int idx = (lane >> 1) & 15, rs = 32 * wid + (idx & 3) + 8 * (idx >> 2) + 4 * hl;
        if ((lane & 1) == 0) E.rss_next[(size_t)(NP + rs) * 16 + pn * 4 + wc] = s1;
    }
}

__device__ __forceinline__ void run_phase(const Params& p_, LAS unsigned char* lds, int ph_) {
    const bool nonarrow = false; const int ph = ph_ >= 100 ? ph_ - 100 : ph_;
    Params p = p_; { size_t z0 = 0, z1 = 0; asm volatile("" : "+s"(z0), "+s"(z1)); p.ws = p_.ws + z0; p.out = p_.out + z1; }
    bf16_t* xb = (bf16_t*)(p.ws + WS_XB); bf16_t* qkv = (bf16_t*)(p.ws + WS_QKV); float* rss = (float*)(p.ws + WS_RSS); float* gss = (float*)(p.ws + WS_GSS);
    const bf16_t* Wri = (const bf16_t*)(p.ws + WS_WRI); const bf16_t* Wro = (const bf16_t*)(p.ws + WS_WRO); const bf16_t* Wpl = (const bf16_t*)(p.ws + WS_WPL);
    const bf16_t* Wfi = (const bf16_t*)(p.ws + WS_WFI); const bf16_t* Wfo = (const bf16_t*)(p.ws + WS_WFO);
    float* xres = p.out;
    if (ph == NPHASE - 1) { phase_final(p); return; }
    int layer, step;
    if (ph < 9) { layer = 0; step = ph - 1; } else if (ph < 13) { layer = 1; step = ph - 9; } else if (ph < 21) { layer = 2; step = ph - 13; } else { layer = 3; step = ph - 21; }
    const int jl = layer >> 1;
    const bool is_ret = (layer & 1) == 0;
    const int fstep = is_ret ? step - 6 : step - 2;
    if (step == 0 && layer >= 1) { convert_ffn(p, lds, layer); if (layer + 1 < 4) convert_mixer(p, lds, layer + 1); __syncthreads(); }
    if (fstep == 0) { EpiFfn E{qkv, rss + (size_t)(2 * layer + 1) * NTOK * 16}; run_gemm(lds, xb, 1024, Wfi, 5632, 1024, E, NP); if (!nonarrow) narrow_ffn(lds, xb, Wfi, qkv, rss + (size_t)(2 * layer + 1) * NTOK * 16); return; }
    if (fstep == 1) { EpiRes E{xres, xres + (size_t)NP * DM, xres, layer == 1 ? xb : (bf16_t*)nullptr  , rss + (size_t)(2 * layer + 2) * NTOK * 16}; run_gemm(lds, qkv, DFF, Wfo, 1024, DFF, E, NP); narrow_res(lds, qkv, DFF, Wfo, DFF, E); return; }
    if (is_ret) {
        if (step == 0) { EpiQKV E{qkv, rss + (size_t)(2 * layer) * NTOK * 16, (const float*)(p.ws + WS_COS), (const float*)(p.ws + WS_SIN)}; run_gemm(lds, xb, 1024, Wri, 4096, 1024, E, NP); if (!nonarrow) narrow_qkv(lds, xb, Wri, qkv, rss + (size_t)(2 * layer) * NTOK * 16, (const float*)(p.ws + WS_COS), (const float*)(p.ws + WS_SIN)); }
        else if (step == 1) phase_scan_local(p, lds);
        else if (step == 2) phase_scan_prefix(p, jl);
        else if (step == 3) phase_scan(p, lds, jl);
        else if (step == 4) { EpiGate E{qkv, rss + (size_t)(2 * layer) * NTOK * 16, gss + (size_t)jl * NTOK * 8}; run_gemm(lds, xb, 1024, Wri + (size_t)4096 * 1024, 2048, 1024, E, NP); narrow_gate(lds, xb, Wri + (size_t)4096 * 1024, qkv, rss + (size_t)(2 * layer) * NTOK * 16, gss + (size_t)jl * NTOK * 8); }
        else if (step == 5) {
            const float* bp = layer == 0 ? p.x_prompt : xres; const float* bs = layer == 0 ? p.x_sample : xres + (size_t)NP * DM;
            EpiRes E{bp, bs, xres, xb, rss + (size_t)(2 * layer + 1) * NTOK * 16};
            run_gemm(lds, qkv + 2048, 4096, Wro, 1024, 2048, E, NP); narrow_res(lds, qkv + 2048, 4096, Wro, 2048, E);
        }
    } else {
        if (step == 0) phase_pool_prep(p, lds, layer);
        else if (step == 1) { EpiRes E{xres, xres + (size_t)NP * DM, xres, xb, rss + (size_t)(2 * layer + 1) * NTOK * 16}; pg8::Gemm g{qkv, Wpl, NP, 1024, 256, 1024, 1024}; PoolOrder S; S.init(NP, 1024, (int)gridDim.x, (int)blockIdx.x);
            pg8::gemm_phase<EpiRes, PoolOrder, false>(lds, g, S, E, nullptr); narrow_res(lds, qkv, 1024, Wpl, 256, E, 1024, 256); }
    }
}

__global__ void __launch_bounds__(512) mega(Params p) {
    extern __shared__ __attribute__((aligned(16))) unsigned char lds_raw[];
    LAS unsigned char* lds = (LAS unsigned char*)lds_raw;
    volatile LAS unsigned* bst = (volatile LAS unsigned*)(lds + LDS_MAIN);
    if (threadIdx.x == 0) { bst[0] = 0u; bst[1] = 0u; }
    __syncthreads();
    const XcdBarrier gbar = xcd_barrier_post((unsigned*)(p.ws + WS_BAR), bst);
#define GRID_SYNC() xcd_barrier(gbar)
#ifdef MK_PRE_SYNCS
    for (int i = 0; i < MK_PRE_SYNCS; ++i) GRID_SYNC();
#endif
#ifdef MK_PRE_MASK
#define MK_PRE(PH) if ((MK_PRE_MASK >> PH) & 1) { if (PH == 0) phase0(p, lds); else run_phase(p, lds, PH); GRID_SYNC(); }
    MK_PRE(0) MK_PRE(1) MK_PRE(2) MK_PRE(3) MK_PRE(4) MK_PRE(5) MK_PRE(6) MK_PRE(7) MK_PRE(8) MK_PRE(9) MK_PRE(10) MK_PRE(11) MK_PRE(12) MK_PRE(25)
#endif
    int ph = p.ph_lo;
    if (p.ph_hi < 0) cg::this_grid().sync();
    if (ph == 0) { phase0(p, lds); ++ph; if (ph < p.ph_hi) { GRID_SYNC(); } }
#ifdef MK_PRE_PH
    ph = 1 - MK_PRE_REP;
#endif
    for (; ph < p.ph_hi; ++ph) {
#ifdef MK_PRE_PH
        const int phx = (ph < 1) ? MK_PRE_PH + 100 : ph;
#else
        const int phx = ph;
#endif
        run_phase(p, lds, phx);
        if (ph + 1 < p.ph_hi) { GRID_SYNC(); }
    }
}
}

#ifndef MK_SINGLE
#define MK_SINGLE 1
#endif
extern "C" void kernel_launch(void* const* d_in, const int* in_sizes, int n_in, void* d_out, int out_size, void* d_ws, size_t ws_size, hipStream_t stream) {
    static int grid = 0;
    constexpr int LDS_BYTES = mk::LDS_TOTAL;
    if (grid == 0) {
        int dev = 0, cus = 0, per_cu = 0;
        hipGetDevice(&dev); hipDeviceGetAttribute(&cus, hipDeviceAttributeMultiprocessorCount, dev);
        if (hipFuncSetAttribute((const void*)mk::mega, hipFuncAttributeMaxDynamicSharedMemorySize, LDS_BYTES) != hipSuccess) { fprintf(stderr, "hipFuncSetAttribute failed\n"); }
        if (hipOccupancyMaxActiveBlocksPerMultiprocessor(&per_cu, (const void*)mk::mega, 512, LDS_BYTES) != hipSuccess || per_cu < 1) { fprintf(stderr, "occupancy query: %d\n", per_cu); per_cu = 1; }
        (void)hipGetLastError();
        grid = cus * (per_cu < 1 ? 1 : per_cu);
        if (grid <= 0) grid = 256;
    }
    if (ws_size < mk::WS_END) { fprintf(stderr, "workspace too small: %zu < %zu\n", ws_size, (size_t)mk::WS_END); return; }
    mk::Params p{};
    p.x_prompt = (const float*)d_in[0]; p.x_sample = (const float*)d_in[1]; p.state_ret = (const float*)d_in[2]; p.state_pool = (const float*)d_in[3];
    p.norm_mix = (const float*)d_in[4]; p.w_ret_in = (const float*)d_in[5]; p.w_ret_out = (const float*)d_in[6]; p.w_pool = (const float*)d_in[7];
    p.pool_scale = (const float*)d_in[8]; p.norm_ffn = (const float*)d_in[9]; p.w_ffn_in = (const float*)d_in[10]; p.w_ffn_out = (const float*)d_in[11]; p.norm_final = (const float*)d_in[12];
    p.out = (float*)d_out; p.ws = (unsigned char*)d_ws;
#if MK_SINGLE
    hipMemsetAsync((unsigned char*)d_ws + mk::WS_BAR, 0, XCD_BAR_WORDS * 4, stream);
    p.ph_lo = 0; p.ph_hi = mk::NPHASE;
    void* args[] = {&p};
    hipError_t e = hipLaunchCooperativeKernel((const void*)mk::mega, dim3(grid), dim3(512), args, LDS_BYTES, stream);
    if (e != hipSuccess) fprintf(stderr, "cooperative launch failed: %s (grid %d)\n", hipGetErrorString(e), grid);
#else
#ifndef MK_STOP
#define MK_STOP 23
#endif
    for (int ph = 0; ph < mk::NPHASE; ++ph) {
        p.ph_lo = ph; p.ph_hi = ph + 1;
        hipLaunchKernelGGL(mk::mega, dim3(grid), dim3(512), LDS_BYTES, stream, p);
    }
#endif
}
```

```cpp
#include <hip/hip_runtime.h>
#include <hip/hip_cooperative_groups.h>
#include <cstdio>
namespace cg = cooperative_groups;
#define LDS_BARRIER() asm volatile("s_waitcnt lgkmcnt(0)\n\ts_barrier" ::: "memory")
__device__ __forceinline__ int opaque_tid() { int t = (int)threadIdx.x; asm volatile("" : "+v"(t)); return t; }
namespace pg8 {
#define PG8_LAS __attribute__((address_space(3)))
typedef unsigned short bf16_t;
typedef short bf16x8 __attribute__((ext_vector_type(8)));
typedef float f32x4 __attribute__((ext_vector_type(4)));
typedef unsigned u32x4 __attribute__((ext_vector_type(4)));
constexpr int BM = 256, BK = 64, HALF = 128, HTB = HALF * BK * 2  , STAGE_BYTES = 8 * HTB, NXCD = 8, WGM = 8;

__host__ __device__ __forceinline__ int lds_byte(int r, int c) { const int st = (r >> 4) * 2 + (c >> 5), rr = r & 15, cc = c & 31, ob = rr * 64 + cc * 2; return st * 1024 + (ob ^ (((ob >> 9) & 1) << 5)); }
__host__ __device__ __forceinline__ void stage_rc(int b, int& R, int& C) { const int st = b / 1024, sb = b % 1024, swz = sb ^ (((sb >> 9) & 1) << 5); R = (st >> 1) * 16 + swz / 64; C = (st & 1) * 32 + (swz % 64) / 2; }
__host__ __device__ __forceinline__ int perm32(int rho) { const int n = rho >> 4, i = rho & 15; return 8 * (i >> 2) + 4 * n + (i & 3); }

struct Unit { int pm, pn, kofs; };
struct Gemm { const bf16_t* A; const bf16_t* Bt; int M, N, K, lda, ldb; };

struct StaticOrder {
    int nM, nN, nwg, G, c;
    __host__ __device__ void init(int M, int N, int G_, int c_) { nM = M / BM; nN = N / BM; nwg = nM * nN; G = G_; c = c_; }
    __host__ __device__ bool next(int i, Unit& u) const {
        const long L = (long)i * G + c; if (L >= nwg) return false;
        int wgid = (int)L; { const int q = nwg / NXCD, r = nwg % NXCD, xcd = wgid % NXCD, off = wgid / NXCD; wgid = (xcd < r ? xcd * (q + 1) : r * (q + 1) + (xcd - r) * q) + off; }
        const int nig = WGM * nN, gid = wgid / nig, fm = gid * WGM, gsz = (nM - fm) < WGM ? (nM - fm) : WGM;
        u.pm = fm + ((wgid % nig) % gsz); u.pn = (wgid % nig) / gsz; u.kofs = 0; return true;
    }
    __device__ __forceinline__ void a_ready(const Unit&) const {}
    __device__ __forceinline__ void done(const Unit&) const {}
};
struct CountedOrder : StaticOrder {
    const unsigned* ready; unsigned need; unsigned* tmo;
    __device__ __forceinline__ void a_ready(const Unit& u) const {
        if (threadIdx.x < 64) {
            const unsigned long long t0 = __builtin_amdgcn_s_memrealtime(); unsigned polls = 0;
            while ((unsigned)__builtin_amdgcn_readfirstlane(__hip_atomic_load(ready + 64 * u.pm, __ATOMIC_RELAXED, __HIP_MEMORY_SCOPE_AGENT)) < need) {
                if ((++polls & 255u) == 0u && __builtin_amdgcn_readfirstlane(__hip_atomic_load(tmo, __ATOMIC_RELAXED, __HIP_MEMORY_SCOPE_AGENT)) != 0u) break;
                if (__builtin_amdgcn_s_memrealtime() - t0 > 2000000ull) {
                    if (threadIdx.x == 0) { unsigned expect = 0u; __hip_atomic_compare_exchange_strong(tmo + 1, &expect, 0x600u | (unsigned)(u.pm & 0xff), __ATOMIC_RELAXED, __ATOMIC_RELAXED, __HIP_MEMORY_SCOPE_AGENT); __hip_atomic_store(tmo, 1u, __ATOMIC_RELAXED, __HIP_MEMORY_SCOPE_AGENT); }
                    break; }
                __builtin_amdgcn_s_sleep(2); }
            __builtin_amdgcn_fence(__ATOMIC_ACQUIRE, "agent");
            asm volatile("s_waitcnt vmcnt(0)" ::: "memory");
        }
#if !defined(BROKEN_HOOK_NO_BARRIER)
        asm volatile("" ::: "memory"); __builtin_amdgcn_s_barrier(); asm volatile("" ::: "memory");
#endif
    }
};

__device__ __forceinline__ unsigned cvt_pk_bf16(float lo, float hi) { unsigned r; asm volatile("v_cvt_pk_bf16_f32 %0, %1, %2" : "=v"(r) : "v"(lo), "v"(hi)); return r; }
typedef float f32x2 __attribute__((ext_vector_type(2)));
__device__ __forceinline__ f32x2 gelu_pk(f32x2 v) {
    const f32x2 av = __builtin_elementwise_abs(v), d = av * 0.2316418882f + 1.0f;
    f32x2 t; t.x = __builtin_amdgcn_rcpf(d.x); t.y = __builtin_amdgcn_rcpf(d.y);
    f32x2 q = t * 0.5307027145f + (-0.7265760135f); q = q * t + 0.7107068705f; q = q * t + (-0.142248368f); q = q * t + 0.127414796f; q = q * t;
    const f32x2 s = (v * v) * (-0.72134752044f);
    f32x2 e; e.x = __builtin_amdgcn_exp2f(s.x); e.y = __builtin_amdgcn_exp2f(s.y);
    const f32x2 m = v * (q * e), r = v - m;
    f32x2 o; o.x = v.x < 0.f ? m.x : r.x; o.y = v.y < 0.f ? m.y : r.y; return o;
}

struct EpiF32 {
    static constexpr bool PERM = false, AFTER_DRAIN = false;
    float* C; int ldc; const float* bias;
    __device__ __forceinline__ void operator()(const f32x4 (&acc)[2][2][4][2], const Unit& u, int wr, int wc, int fr_, int fq_) const {
        const int tl_ = opaque_tid(), fr = tl_ & 15, fq = (tl_ >> 4) & 3; (void)fr_; (void)fq_;
        const int row0 = u.pm * BM + wr * 64 + fr, col0 = u.pn * BM + wc * 32 + 4 * fq;
        f32x4 bv[2][2];
#pragma unroll
        for (int bj = 0; bj < 2; ++bj)
#pragma unroll
            for (int n = 0; n < 2; ++n) bv[bj][n] = bias ? *(const f32x4*)(bias + col0 + bj * HALF + n * 16) : (f32x4){0.f, 0.f, 0.f, 0.f};
#pragma unroll
        for (int ai = 0; ai < 2; ++ai)
#pragma unroll
            for (int m = 0; m < 4; ++m) { float* rowp = C + (size_t)(row0 + ai * HALF + m * 16) * ldc + col0;
#pragma unroll
                for (int bj = 0; bj < 2; ++bj)
#pragma unroll
                    for (int n = 0; n < 2; ++n) *(f32x4*)(rowp + bj * HALF + n * 16) = acc[ai][bj][m][n] + bv[bj][n]; }
    }
};
template <int ACT  > struct EpiBf16 {
    static constexpr bool PERM = true, AFTER_DRAIN = false;
    bf16_t* O; int ldc; const float* bias; int split_cols; size_t split_stride;
    __device__ __forceinline__ void operator()(const f32x4 (&acc)[2][2][4][2], const Unit& u, int wr, int wc, int fr_, int fq_) const {
        const int tl_ = opaque_tid(), fr = tl_ & 15, fq = (tl_ >> 4) & 3; (void)fr_; (void)fq_;
        const int row0 = u.pm * BM + wr * 64 + fr; int colt = u.pn * BM; bf16_t* base = O;
        if (split_cols) { const int t = colt / split_cols; base += (size_t)t * split_stride; colt -= t * split_cols; }
        const int col0 = colt + wc * 32 + 8 * fq, bcol0 = u.pn * BM + wc * 32 + 8 * fq;
        f32x4 bv[2][2];
#pragma unroll
        for (int bj = 0; bj < 2; ++bj)
#pragma unroll
            for (int n = 0; n < 2; ++n) bv[bj][n] = bias ? *(const f32x4*)(bias + bcol0 + bj * HALF + 4 * n) : (f32x4){0.f, 0.f, 0.f, 0.f};
#pragma unroll
        for (int ai = 0; ai < 2; ++ai)
#pragma unroll
            for (int m = 0; m < 4; ++m) { bf16_t* rowp = base + (size_t)(row0 + ai * HALF + m * 16) * ldc + col0;
#pragma unroll
                for (int bj = 0; bj < 2; ++bj) { f32x4 v0 = acc[ai][bj][m][0] + bv[bj][0], v1 = acc[ai][bj][m][1] + bv[bj][1];
                    if (ACT == 1) { f32x2 a = gelu_pk((f32x2){v0[0], v0[1]}), b = gelu_pk((f32x2){v0[2], v0[3]}), c = gelu_pk((f32x2){v1[0], v1[1]}), d = gelu_pk((f32x2){v1[2], v1[3]});
                        v0 = (f32x4){a.x, a.y, b.x, b.y}; v1 = (f32x4){c.x, c.y, d.x, d.y}; }
                    if (ACT == 2) {
#pragma unroll
                        for (int j = 0; j < 4; ++j) { v0[j] = 0.5f * v0[j] * (1.0f + erff(v0[j] * 0.70710678f)); v1[j] = 0.5f * v1[j] * (1.0f + erff(v1[j] * 0.70710678f)); } }
                    u32x4 w; w.x = cvt_pk_bf16(v0[0], v0[1]); w.y = cvt_pk_bf16(v0[2], v0[3]); w.z = cvt_pk_bf16(v1[0], v1[1]); w.w = cvt_pk_bf16(v1[2], v1[3]);
                    *(u32x4*)(rowp + bj * HALF) = w; } }
    }
};

template <class Epi, class Sched, bool STAMP = false>
__device__ __forceinline__ void gemm_phase(PG8_LAS unsigned char* lds, const Gemm g, const Sched& S, const Epi& E, unsigned long long* stamps) {
    const int tid = opaque_tid(), wid = __builtin_amdgcn_readfirstlane(tid >> 6), lane = tid & 63, wr = wid >> 2, wc = wid & 3, fr = lane & 15, fq = lane >> 4;
    const int K = g.K, nt = K / BK, lda = g.lda, ldb = g.ldb;
    int ts_lo = 0, ts_hi = 0, nts = 0; const unsigned long long rt_entry = STAMP ? (unsigned long long)wall_clock64() : 0ull;
#define PG8_STAMP() do { if (STAMP && wid == 0 && nts < 64) { const unsigned long long _c = (unsigned long long)clock64(); \
        ts_lo = (lane == nts) ? (int)(unsigned)_c : ts_lo; ts_hi = (lane == nts) ? (int)(unsigned)(_c >> 32) : ts_hi; ++nts; } } while (0)
    PG8_STAMP();
    unsigned voffA[2], voffB[2];
#pragma unroll
    for (int i = 0; i < 2; ++i) { int R, C; stage_rc(tid * 16 + i * 8192, R, C); const int Rb = Epi::PERM ? ((R & ~31) + perm32(R & 31)) : R;
        voffA[i] = (unsigned)(R * lda + C) * 2u; voffB[i] = (unsigned)(Rb * ldb + C) * 2u; }
    const size_t kstep = (size_t)(BK * 2);
    const size_t hstep = (size_t)HALF * ldb * 2;
    const size_t tstep = 2 * hstep; const size_t hstepA = (size_t)HALF * lda * 2, tstepA = 2 * hstepA;
    const unsigned ldsw = (unsigned)wid * 1024u;
    const int aoff = lds_byte(wr * 64 + fr, fq * 8), boff = lds_byte(wc * 32 + fr, fq * 8);
#define PG8_SA(b, h) (((b) * 2 + (h)) * HTB)
#define PG8_SB(b, h) ((4 + (b) * 2 + (h)) * HTB)
#define PG8_STAGE(bufoff, gbase, voff) do { _Pragma("unroll") for (int _i = 0; _i < 2; ++_i) \
        __builtin_amdgcn_global_load_lds((const unsigned*)((const char*)(gbase) + (voff)[_i]), (PG8_LAS unsigned*)(lds + (bufoff) + ldsw + _i * 8192), 16, 0, 0); } while (0)
#define PG8_LDA(dst, b, h) do { _Pragma("unroll") for (int m = 0; m < 4; ++m) _Pragma("unroll") for (int k = 0; k < 2; ++k) dst[m][k] = *(const PG8_LAS bf16x8*)(lds + PG8_SA(b, h) + aoff + m * 2048 + k * 1024); } while (0)
#define PG8_LDB(dst, b, h) do { _Pragma("unroll") for (int n = 0; n < 2; ++n) _Pragma("unroll") for (int k = 0; k < 2; ++k) dst[n][k] = *(const PG8_LAS bf16x8*)(lds + PG8_SB(b, h) + boff + n * 2048 + k * 1024); } while (0)
#define PG8_MMA(ai, bj, At, Bt) do { __builtin_amdgcn_s_setprio(1); _Pragma("unroll") for (int m = 0; m < 4; ++m) _Pragma("unroll") for (int n = 0; n < 2; ++n) _Pragma("unroll") for (int k = 0; k < 2; ++k) \
        acc[ai][bj][m][n] = __builtin_amdgcn_mfma_f32_16x16x32_bf16(Bt[n][k], At[m][k], acc[ai][bj][m][n], 0, 0, 0); __builtin_amdgcn_s_setprio(0); } while (0)
#define PG8_WAIT_V(n) asm volatile("s_waitcnt vmcnt(" #n ")" ::: "memory")
#define PG8_WAIT_L(n) asm volatile("s_waitcnt lgkmcnt(" #n ")" ::: "memory")
#define PG8_BAR __builtin_amdgcn_s_barrier()
#define PG8_SCHED __builtin_amdgcn_sched_barrier(0)
    Unit cur, nxt; int ui = 0;
    if (!S.next(0, cur)) return;
    f32x4 acc[2][2][4][2];
#pragma unroll
    for (int a = 0; a < 2; ++a)
#pragma unroll
        for (int b = 0; b < 2; ++b)
#pragma unroll
            for (int m = 0; m < 4; ++m)
#pragma unroll
                for (int n = 0; n < 2; ++n) acc[a][b][m][n] = (f32x4){0.f, 0.f, 0.f, 0.f};
    bf16x8 At[4][2], B0[2][2], B1[2][2];
    const char* cA = (const char*)g.A + (size_t)cur.pm * tstepA + (size_t)cur.kofs * 2; const char* cB = (const char*)g.Bt + (size_t)cur.pn * tstep + (size_t)cur.kofs * 2;
    S.a_ready(cur);
    PG8_STAGE(PG8_SB(0, 0), cB, voffB); PG8_STAGE(PG8_SA(0, 0), cA, voffA); PG8_STAGE(PG8_SB(0, 1), cB + hstep, voffB); PG8_STAGE(PG8_SA(0, 1), cA + hstepA, voffA);
    if (wr == 1) PG8_BAR;
    PG8_WAIT_V(4); PG8_BAR;
    PG8_STAGE(PG8_SB(1, 0), cB + kstep, voffB); PG8_STAGE(PG8_SA(1, 0), cA + kstep, voffA); PG8_STAGE(PG8_SB(1, 1), cB + hstep + kstep, voffB);
    PG8_WAIT_V(6); PG8_BAR;
    PG8_STAMP();
    for (;;) {
        const bool has_next = S.next(ui + 1, nxt);
        const char* nA = has_next ? (const char*)g.A + (size_t)nxt.pm * tstepA + (size_t)nxt.kofs * 2 : cA; const char* nB = has_next ? (const char*)g.Bt + (size_t)nxt.pn * tstep + (size_t)nxt.kofs * 2 : cB;
        for (int t = 0; t < nt; t += 2) {
            const bool last = (t == nt - 2);
            const char* a1 = cA + (size_t)(t + 1) * kstep;
            const char* a2 = last ? nA : cA + (size_t)(t + 2) * kstep; const char* b2 = last ? nB : cB + (size_t)(t + 2) * kstep;
            const char* a3 = a2 + kstep; const char* b3 = b2 + kstep;
            if (last && has_next) S.a_ready(nxt);
            PG8_LDB(B0, 0, 0); PG8_SCHED; PG8_LDA(At, 0, 0); PG8_STAGE(PG8_SA(1, 1), a1 + hstepA, voffA);
            PG8_WAIT_L(8); PG8_BAR; PG8_WAIT_L(0); PG8_MMA(0, 0, At, B0); PG8_BAR; PG8_SCHED;
            PG8_LDB(B1, 0, 1); PG8_STAGE(PG8_SB(0, 0), b2, voffB);
            PG8_BAR; PG8_WAIT_L(0); PG8_MMA(0, 1, At, B1); PG8_BAR;
            PG8_LDA(At, 0, 1); PG8_STAGE(PG8_SA(0, 0), a2, voffA);
            PG8_BAR; PG8_WAIT_L(0); PG8_MMA(1, 0, At, B0); PG8_BAR; PG8_SCHED;
            PG8_STAGE(PG8_SB(0, 1), b2 + hstep, voffB);
            PG8_WAIT_V(6); PG8_BAR; PG8_MMA(1, 1, At, B1); PG8_BAR;
            PG8_LDB(B0, 1, 0); PG8_SCHED; PG8_LDA(At, 1, 0); PG8_STAGE(PG8_SA(0, 1), a2 + hstepA, voffA);
            PG8_WAIT_L(8); PG8_BAR; PG8_WAIT_L(0); PG8_MMA(0, 0, At, B0); PG8_BAR; PG8_SCHED;
            PG8_LDB(B1, 1, 1); PG8_STAGE(PG8_SB(1, 0), b3, voffB);
            PG8_BAR; PG8_WAIT_L(0); PG8_MMA(0, 1, At, B1); PG8_BAR;
            PG8_LDA(At, 1, 1); PG8_STAGE(PG8_SA(1, 0), a3, voffA);
            PG8_BAR; PG8_WAIT_L(0); PG8_MMA(1, 0, At, B0); PG8_BAR; PG8_SCHED;
            PG8_STAGE(PG8_SB(1, 1), b3 + hstep, voffB);
            PG8_WAIT_V(6); PG8_BAR; PG8_MMA(1, 1, At, B1); PG8_BAR;
        }
        PG8_STAMP();
        if constexpr (!Epi::AFTER_DRAIN) { E(acc, cur, wr, wc, fr, fq); S.done(cur); }
        PG8_STAMP();
        if (!has_next) break;
#pragma unroll
        for (int a = 0; a < 2; ++a)
#pragma unroll
            for (int b = 0; b < 2; ++b)
#pragma unroll
                for (int m = 0; m < 4; ++m)
#pragma unroll
                    for (int n = 0; n < 2; ++n) acc[a][b][m][n] = (f32x4){0.f, 0.f, 0.f, 0.f};
        cur = nxt; cA = nA; cB = nB; ++ui;
    }
    PG8_WAIT_V(0);
    if (wr == 0) PG8_BAR;
    PG8_BAR;
    if constexpr (Epi::AFTER_DRAIN) { E.fused(acc, cur, wr, wc, fr, fq, lds, wid, lane); S.done(cur); }
    PG8_STAMP();
    if (STAMP && wid == 0) { stamps[lane] = lane < nts ? (((unsigned long long)(unsigned)ts_hi << 32) | (unsigned)ts_lo) : 0ull;
        if (lane == 62) stamps[62] = rt_entry; if (lane == 63) stamps[63] = (unsigned long long)wall_clock64(); }
#undef PG8_STAMP
#undef PG8_SA
#undef PG8_SB
#undef PG8_STAGE
#undef PG8_LDA
#undef PG8_LDB
#undef PG8_MMA
#undef PG8_WAIT_V
#undef PG8_WAIT_L
#undef PG8_BAR
#undef PG8_SCHED
}
}

#define XB_TMO      128
#define XB_XCNT(j)  (256  + 64 * (j))
#define XB_XSUB(j)  (1280 + 64 * (j))
#define XB_XGEN(j)  (2304 + 64 * (j))
#define XB_TOP      3328
#define XB_TOPGEN   3392
#define XCD_BAR_WORDS 3456
#define XB_SPIN_CAP (1u << 18)
#define LAS __attribute__((address_space(3)))

__device__ __forceinline__ unsigned xb_ld(unsigned* p)              { return __hip_atomic_load(p, __ATOMIC_RELAXED, __HIP_MEMORY_SCOPE_AGENT); }
__device__ __forceinline__ unsigned xb_add(unsigned* p, unsigned v) { return __hip_atomic_fetch_add(p, v, __ATOMIC_RELAXED, __HIP_MEMORY_SCOPE_AGENT); }
__device__ __forceinline__ unsigned xb_xcc_id() { return (unsigned)__builtin_amdgcn_s_getreg((3 << 11) | 20) & 0xFu; }
#define XB_SPIN(cond, bar) do { unsigned _sp = 0; while (cond) { __builtin_amdgcn_s_sleep(1); \
    if ((++_sp & 255u) == 0u) { if (xb_ld(&(bar)[XB_TMO])) break; if (_sp > XB_SPIN_CAP) { atomicAdd(&(bar)[XB_TMO], 1u); break; } } } } while (0)

struct XcdBarrier {
    unsigned* bar; unsigned x;
    volatile LAS unsigned* st;
};

__device__ __forceinline__ XcdBarrier xcd_barrier_post(unsigned* bar, volatile LAS unsigned* st) {
    XcdBarrier b; b.bar = bar; b.x = xb_xcc_id(); b.st = st;
    if (threadIdx.x == 0) (void)xb_add(&bar[XB_XCNT(b.x)], 1u);
    return b;
}
__device__ __forceinline__ void xcd_barrier_complete(unsigned* bar, unsigned x, unsigned& nloc, unsigned& nx) {
    const unsigned G = gridDim.x * gridDim.y * gridDim.z;
    unsigned sum, cnt, mine, sp = 0u;
    for (;;) {
        sum = 0u; cnt = 0u; mine = 0u;
#pragma unroll
        for (unsigned j = 0; j < 16; ++j) { const unsigned c = xb_ld(&bar[XB_XCNT(j)]); sum += c; cnt += (c > 0u) ? 1u : 0u; mine = (j == x) ? c : mine; }
        if (sum == G) break;
        __builtin_amdgcn_s_sleep(1);
        if ((++sp & 255u) == 0u) { if (xb_ld(&bar[XB_TMO])) break; if (sp > XB_SPIN_CAP) { atomicAdd(&bar[XB_TMO], 1u); break; } }
    }
    nloc = mine > 0u ? mine : 1u; nx = cnt > 0u ? cnt : 1u;
}

__device__ __forceinline__ void xcd_barrier(const XcdBarrier& b) {
    asm volatile("s_waitcnt vmcnt(0)" ::: "memory");
    __syncthreads();
    if (threadIdx.x == 0) {
        unsigned* bar = b.bar;
        __builtin_amdgcn_s_waitcnt(0);
        unsigned nloc = b.st[0], nx = b.st[1];
        if (nloc == 0u) { xcd_barrier_complete(bar, b.x, nloc, nx); b.st[0] = nloc; b.st[1] = nx; }
        const unsigned old = xb_add(&bar[XB_XSUB(b.x)], 1u);
        const unsigned gen = old / nloc;
        if (old + 1u == (gen + 1u) * nloc) {
            __builtin_amdgcn_fence(__ATOMIC_RELEASE, "agent");
            asm volatile("s_waitcnt vmcnt(0)" ::: "memory");
            const unsigned og = xb_add(&bar[XB_TOP], 1u);
            const unsigned tg = og / nx;
            if (og + 1u == (tg + 1u) * nx) xb_add(&bar[XB_TOPGEN], 1u);
            else XB_SPIN(xb_ld(&bar[XB_TOPGEN]) == tg, bar);
            __builtin_amdgcn_fence(__ATOMIC_ACQUIRE, "agent");
            xb_add(&bar[XB_XGEN(b.x)], 1u);
            asm volatile("s_waitcnt vmcnt(0)" ::: "memory");
        } else {
            XB_SPIN(xb_ld(&bar[XB_XGEN(b.x)]) == gen, bar);
            __builtin_amdgcn_fence(__ATOMIC_ACQUIRE, "agent");
            asm volatile("s_waitcnt vmcnt(0)" ::: "memory");
        }
    }
    __syncthreads();
}

namespace mk {
using pg8::bf16_t; using pg8::bf16x8; using pg8::f32x4; using pg8::u32x4; using pg8::Unit; using pg8::cvt_pk_bf16;
typedef float f32x16 __attribute__((ext_vector_type(16)));
typedef short s16x4 __attribute__((ext_vector_type(4)));
typedef unsigned u32x2 __attribute__((ext_vector_type(2)));

constexpr int NTOK = 33024, NP = 32768, DM = 1024, SEQ = 16384, DFF = 2816;
constexpr float EPS = 1e-6f;
constexpr int NPHASE = 26;
constexpr int LDS_MAIN = 141312, LDS_TOTAL = LDS_MAIN + 16;
constexpr size_t OUT_RETP = 33816576, OUT_RETS = 35913728, OUT_POOLP = 52690944, OUT_POOLS = 52752384;
constexpr size_t WS_WRI = 0, WS_WRO = 12582912, WS_WPL = 16777216, WS_WFI = 18874368, WS_WFO = 30408704, WS_XB = 36175872,
                 WS_QKV = 103809024, WS_T = 374341632, WS_COS = 441450496, WS_SIN = 449839104, WS_RSS = 458227712, WS_GSS = 477249536, WS_BAR = 494157824, WS_END = 494174208;

struct Params {
    const float *x_prompt, *x_sample, *state_ret, *state_pool, *norm_mix, *w_ret_in, *w_ret_out, *w_pool, *pool_scale, *norm_ffn, *w_ffn_in, *w_ffn_out, *norm_final;
    float* out; unsigned char* ws; int ph_lo, ph_hi;
};

__device__ __forceinline__ float lg2gamma(int h) { return h == 0 ? -0.04580368961312479f : h == 1 ? -0.02272007650008353f : h == 2 ? -0.011315313227834146f : -0.005646563141142063f; }
__device__ __forceinline__ float sum16(const float* p) {
    const float4 a = *(const float4*)p, b = *(const float4*)(p + 4), c = *(const float4*)(p + 8), d = *(const float4*)(p + 12);
    return (((a.x + a.y) + (a.z + a.w)) + ((b.x + b.y) + (b.z + b.w))) + (((c.x + c.y) + (c.z + c.w)) + ((d.x + d.y) + (d.z + d.w)));
}
__device__ __forceinline__ float rs_row(const float* rssrow) { return __builtin_amdgcn_rsqf(sum16(rssrow) * (1.0f / 1024.0f) + EPS); }
__device__ __forceinline__ float silu_f(float v) { return v * __builtin_amdgcn_rcpf(1.0f + __builtin_amdgcn_exp2f(v * -1.4426950408889634f)); }
__device__ __forceinline__ bf16_t f2bf(float f) { unsigned u = __float_as_uint(f); u += 0x7FFFu + ((u >> 16) & 1u); return (bf16_t)(u >> 16); }
__device__ __forceinline__ float bf2f(unsigned short b) { return __uint_as_float(((unsigned)b) << 16); }

__device__ __forceinline__ void row_scales(float (&r)[8], const float* rss, int row0, int fq) {
    float4 q[8];
#pragma unroll
    for (int i = 0; i < 8; ++i) q[i] = *(const float4*)(rss + (size_t)(row0 + (i >> 2) * 128 + (i & 3) * 16) * 16 + fq * 4);
#pragma unroll
    for (int i = 0; i < 8; ++i) { float t = (q[i].x + q[i].y) + (q[i].z + q[i].w); t += __shfl_xor(t, 16); t += __shfl_xor(t, 32); r[i] = __builtin_amdgcn_rsqf(t * (1.0f / 1024.0f) + EPS); }
}
struct EpiQKV {
    static constexpr bool PERM = true, AFTER_DRAIN = false;
    bf16_t* O; const float* rss; const float* cosT; const float* sinT;
    __device__ __forceinline__ void operator()(const f32x4 (&acc)[2][2][4][2], const Unit& u, int wr, int wc, int fr_, int fq_) const {
        const int tl_ = opaque_tid(), fr = tl_ & 15, fq = (tl_ >> 4) & 3; (void)fr_; (void)fq_;
        const int row0 = u.pm * 256 + wr * 64 + fr, cin = wc * 32 + 8 * fq;
        const bool rot = u.pn < 8; const float lg = lg2gamma(u.pn & 3);
        float rr[8]; row_scales(rr, rss, row0, fq);
        u32x4 wout[8][2];
#pragma unroll
        for (int am = 0; am < 4; ++am) {
            const int ai = am >> 1;
            f32x4 ct[2][2], st[2][2];
            if (rot) {
#pragma unroll
                for (int mm = 0; mm < 2; ++mm) {
                    const int row = row0 + ai * 128 + ((am & 1) * 2 + mm) * 16; const int pos = (row < NP) ? (row & (SEQ - 1)) : 1024 + ((row - NP) & 15);
#pragma unroll
                    for (int n = 0; n < 2; ++n) { ct[mm][n] = *(const f32x4*)(cosT + (size_t)pos * 128 + cin + 4 * n); st[mm][n] = *(const f32x4*)(sinT + (size_t)pos * 128 + cin + 4 * n); }
                }
            }
#pragma unroll
            for (int mm = 0; mm < 2; ++mm) {
                const int m = (am & 1) * 2 + mm;
                const int row = row0 + ai * 128 + m * 16;
                const float r = rr[ai * 4 + m];
                int l, Lc;
                if (row < NP) { l = row & 63; Lc = 64; } else { l = (row - NP) & 15; Lc = 16; }
                f32x4 o1[2], o2[2];
                if (rot) {
                    const float e = (u.pn < 4) ? (float)(l + 1) : (float)(Lc - 1 - l);
                    const float dec = exp2f(e * lg) * r;
#pragma unroll
                    for (int n = 0; n < 2; ++n) {
                        const f32x4 c4 = ct[mm][n], s4 = st[mm][n];
                        const f32x4 x1 = acc[ai][0][m][n] * dec, x2 = acc[ai][1][m][n] * dec;
                        o1[n] = x1 * c4 - x2 * s4; o2[n] = x1 * s4 + x2 * c4;
                    }
                } else {
#pragma unroll
                    for (int n = 0; n < 2; ++n) { o1[n] = acc[ai][0][m][n] * r; o2[n] = acc[ai][1][m][n] * r; }
                }
                u32x4 w; w.x = cvt_pk_bf16(o1[0][0], o1[0][1]); w.y = cvt_pk_bf16(o1[0][2], o1[0][3]); w.z = cvt_pk_bf16(o1[1][0], o1[1][1]); w.w = cvt_pk_bf16(o1[1][2], o1[1][3]);
                wout[ai * 4 + m][0] = w;
                w.x = cvt_pk_bf16(o2[0][0], o2[0][1]); w.y = cvt_pk_bf16(o2[0][2], o2[0][3]); w.z = cvt_pk_bf16(o2[1][0], o2[1][1]); w.w = cvt_pk_bf16(o2[1][2], o2[1][3]);
                wout[ai * 4 + m][1] = w;
            }
        }
#pragma unroll
        for (int i = 0; i < 8; ++i) {
            bf16_t* rowp = O + (size_t)(row0 + (i >> 2) * 128 + (i & 3) * 16) * 4096 + u.pn * 256 + cin;
            *(u32x4*)rowp = wout[i][0]; *(u32x4*)(rowp + 128) = wout[i][1];
        }
    }
};
struct EpiGate {
    static constexpr bool PERM = true, AFTER_DRAIN = false;
    bf16_t* QKV; const float* rss; const float* gss;
    __device__ __forceinline__ void operator()(const f32x4 (&acc)[2][2][4][2], const Unit& u, int wr, int wc, int fr_, int fq_) const {
        const int tl_ = opaque_tid(), fr = tl_ & 15, fq = (tl_ >> 4) & 3; (void)fr_; (void)fq_;
        const int row0 = u.pm * 256 + wr * 64 + fr, cin = wc * 32 + 8 * fq, head = u.pn >> 1;
        float rr[8]; row_scales(rr, rss, row0, fq);
        u32x4 wout[8][2];
#pragma unroll
        for (int ai = 0; ai < 2; ++ai) {
            u32x4 ovs[4][2]; float2 gps[4];
#pragma unroll
            for (int i = 0; i < 4; ++i) {
                const int row = row0 + ai * 128 + i * 16; const bf16_t* rp = QKV + (size_t)row * 4096 + 2048 + u.pn * 256 + cin;
                ovs[i][0] = *(const u32x4*)rp; ovs[i][1] = *(const u32x4*)(rp + 128); gps[i] = *(const float2*)(gss + ((size_t)row * 4 + head) * 2);
            }
#pragma unroll
            for (int m = 0; m < 4; ++m) {
                const float r = rr[ai * 4 + m];
                const float rn = __builtin_amdgcn_rsqf((gps[m].x + gps[m].y) * (1.0f / 512.0f) + EPS);
#pragma unroll
                for (int bj = 0; bj < 2; ++bj) {
                    const u32x4 ov = ovs[m][bj];
                    float g[8], o[8];
#pragma unroll
                    for (int j = 0; j < 4; ++j) { g[j] = acc[ai][bj][m][0][j] * r; g[4 + j] = acc[ai][bj][m][1][j] * r; }
                    o[0] = __uint_as_float(ov.x << 16); o[1] = __uint_as_float(ov.x & 0xffff0000u); o[2] = __uint_as_float(ov.y << 16); o[3] = __uint_as_float(ov.y & 0xffff0000u);
                    o[4] = __uint_as_float(ov.z << 16); o[5] = __uint_as_float(ov.z & 0xffff0000u); o[6] = __uint_as_float(ov.w << 16); o[7] = __uint_as_float(ov.w & 0xffff0000u);
                    float y[8];
#pragma unroll
                    for (int j = 0; j < 8; ++j) y[j] = silu_f(g[j]) * o[j] * rn;
                    u32x4 w; w.x = cvt_pk_bf16(y[0], y[1]); w.y = cvt_pk_bf16(y[2], y[3]); w.z = cvt_pk_bf16(y[4], y[5]); w.w = cvt_pk_bf16(y[6], y[7]);
                    wout[ai * 4 + m][bj] = w;
                }
            }
        }
#pragma unroll
        for (int i = 0; i < 8; ++i) {
            bf16_t* rowp = QKV + (size_t)(row0 + (i >> 2) * 128 + (i & 3) * 16) * 4096 + 2048 + u.pn * 256 + cin;
            *(u32x4*)rowp = wout[i][0]; *(u32x4*)(rowp + 128) = wout[i][1];
        }
    }
};
struct EpiFfn {
    static constexpr bool PERM = true, AFTER_DRAIN = false;
    bf16_t* ACT; const float* rss;
    __device__ __forceinline__ void operator()(const f32x4 (&acc)[2][2][4][2], const Unit& u, int wr, int wc, int fr_, int fq_) const {
        const int tl_ = opaque_tid(), fr = tl_ & 15, fq = (tl_ >> 4) & 3; (void)fr_; (void)fq_;
        const int row0 = u.pm * 256 + wr * 64 + fr, cout = u.pn * 128 + wc * 16 + 4 * fq;
        float rr[8]; row_scales(rr, rss, row0, fq);
#pragma unroll
        for (int ai = 0; ai < 2; ++ai)
#pragma unroll
            for (int m = 0; m < 4; ++m) {
                const int row = row0 + ai * 128 + m * 16;
                const float r = rr[ai * 4 + m];
                bf16_t* rowp = ACT + (size_t)row * DFF + cout;
#pragma unroll
                for (int bj = 0; bj < 2; ++bj) {
                    const f32x4 a = acc[ai][bj][m][0] * r, b = acc[ai][bj][m][1] * r;
                    u32x2 w; w.x = cvt_pk_bf16(silu_f(a[0]) * b[0], silu_f(a[1]) * b[1]); w.y = cvt_pk_bf16(silu_f(a[2]) * b[2], silu_f(a[3]) * b[3]);
                    *(u32x2*)(rowp + bj * 64) = w;
                }
            }
    }
};
struct EpiRes {
    static constexpr bool PERM = true, AFTER_DRAIN = false;
    const float* base_p; const float* base_s; float* xres; bf16_t* xb; float* rss_next;
    __device__ __forceinline__ void operator()(const f32x4 (&acc)[2][2][4][2], const Unit& u, int wr, int wc, int fr_, int fq_) const {
        const int tl_ = opaque_tid(), fr = tl_ & 15, fq = (tl_ >> 4) & 3; (void)fr_; (void)fq_;
        const int row0 = u.pm * 256 + wr * 64 + fr, col0 = u.pn * 256 + wc * 32 + 8 * fq;
#pragma unroll
        for (int ai = 0; ai < 2; ++ai) {
            f32x4 bv[4][4];
#pragma unroll
            for (int m = 0; m < 4; ++m) {
                const int row = row0 + ai * 128 + m * 16;
                const float* bp = (row < NP) ? base_p + (size_t)row * DM : base_s + (size_t)(row - NP) * DM;
#pragma unroll
                for (int q = 0; q < 4; ++q) bv[m][q] = *(const f32x4*)(bp + col0 + (q >> 1) * 128 + (q & 1) * 4);
            }
#pragma unroll
            for (int m = 0; m < 4; ++m) {
                const int row = row0 + ai * 128 + m * 16;
                float ss = 0.f;
#pragma unroll
                for (int bj = 0; bj < 2; ++bj) {
                    const int c = col0 + bj * 128;
                    const f32x4 v0 = bv[m][bj * 2 + 0] + acc[ai][bj][m][0], v1 = bv[m][bj * 2 + 1] + acc[ai][bj][m][1];
                    *(f32x4*)(xres + (size_t)row * DM + c) = v0; *(f32x4*)(xres + (size_t)row * DM + c + 4) = v1;
                    if (xb) { u32x4 w; w.x = cvt_pk_bf16(v0[0], v0[1]); w.y = cvt_pk_bf16(v0[2], v0[3]); w.z = cvt_pk_bf16(v1[0], v1[1]); w.w = cvt_pk_bf16(v1[2], v1[3]); *(u32x4*)(xb + (size_t)row * DM + c) = w; }
                    ss += ((v0[0] * v0[0] + v0[1] * v0[1]) + (v0[2] * v0[2] + v0[3] * v0[3])) + ((v1[0] * v1[0] + v1[1] * v1[1]) + (v1[2] * v1[2] + v1[3] * v1[3]));
                }
                ss += __shfl_xor(ss, 16); ss += __shfl_xor(ss, 32);
                if (fq == 0) rss_next[(size_t)row * 16 + u.pn * 4 + wc] = ss;
            }
        }
    }
};

struct MapId { __device__ __forceinline__ float scale(int) const { return 1.f; } __device__ __forceinline__ int drow(int n) const { return n; } };
struct MapRetIn { __device__ __forceinline__ float scale(int n) const { return (n >= 1024 && n < 2048) ? 0.0625f : 1.f; } __device__ __forceinline__ int drow(int n) const { return n; } };
struct MapFfnIn { __device__ __forceinline__ float scale(int) const { return 1.f; }
    __device__ __forceinline__ int drow(int n) const { const int isb = n >= DFF, j = n - isb * DFF; return (j >> 2) * 8 + isb * 4 + (j & 3); } };
struct MapPool { const float* cs; __device__ __forceinline__ float scale(int n) const { return cs[n]; } __device__ __forceinline__ int drow(int n) const { return n; } };

template <class MapF>
__device__ __forceinline__ void conv_T(LAS unsigned char* lds, const float* src, int K, int Nsrc, int ldsrc, bf16_t* dst, int lddst, const float* gain, const MapF map) {
    const int tid = opaque_tid(), tk = K >> 6, tn = Nsrc >> 8, ntile = tk * tn;
    LAS bf16_t* tile = (LAS bf16_t*)lds;
    for (int t = blockIdx.x; t < ntile; t += gridDim.x) {
        const int k0 = (t % tk) << 6, n0 = (t / tk) << 8;
        {
            const int kk = tid >> 3, nn = (tid & 7) * 8; const float* sp = src + (size_t)(k0 + kk) * ldsrc + n0 + nn;
            const float gk = gain ? gain[k0 + kk] : 1.f;
            float4 a[4], b[4];
#pragma unroll
            for (int q = 0; q < 4; ++q) { a[q] = *(const float4*)(sp + q * 64); b[q] = *(const float4*)(sp + q * 64 + 4); }
#pragma unroll
            for (int q = 0; q < 4; ++q) {
                const int nb = q * 64 + nn; LAS bf16_t* tp = tile + nb * 72 + kk;
                tp[0 * 72] = f2bf(a[q].x * gk * map.scale(n0 + nb + 0)); tp[1 * 72] = f2bf(a[q].y * gk * map.scale(n0 + nb + 1));
                tp[2 * 72] = f2bf(a[q].z * gk * map.scale(n0 + nb + 2)); tp[3 * 72] = f2bf(a[q].w * gk * map.scale(n0 + nb + 3));
                tp[4 * 72] = f2bf(b[q].x * gk * map.scale(n0 + nb + 4)); tp[5 * 72] = f2bf(b[q].y * gk * map.scale(n0 + nb + 5));
                tp[6 * 72] = f2bf(b[q].z * gk * map.scale(n0 + nb + 6)); tp[7 * 72] = f2bf(b[q].w * gk * map.scale(n0 + nb + 7));
            }
        }
        __syncthreads();
        {
            const int nn = tid >> 3, kc = (tid & 7) * 8;
#pragma unroll
            for (int q = 0; q < 4; ++q) {
                const u32x4 raw = *(const LAS u32x4*)(tile + (q * 64 + nn) * 72 + kc);
                *(u32x4*)(dst + (size_t)map.drow(n0 + q * 64 + nn) * lddst + k0 + kc) = raw;
            }
        }
        __syncthreads();
    }
}
__device__ __forceinline__ void convert_ret(const Params& p, LAS unsigned char* lds, int j) {
    conv_T(lds, p.w_ret_in + (size_t)j * 1024 * 6144, 1024, 6144, 6144, (bf16_t*)(p.ws + WS_WRI), 1024, p.norm_mix + (size_t)(2 * j) * DM, MapRetIn{});
    conv_T(lds, p.w_ret_out + (size_t)j * 2048 * 1024, 2048, 1024, 1024, (bf16_t*)(p.ws + WS_WRO), 2048, nullptr, MapId{});
}
__device__ __forceinline__ void convert_pool(const Params& p, LAS unsigned char* lds, int j) {
    bf16_t* W = (bf16_t*)(p.ws + WS_WPL);
    for (size_t i = (size_t)blockIdx.x * blockDim.x + opaque_tid(); i < (size_t)1024 * 128; i += (size_t)gridDim.x * blockDim.x) {
        const int n = (int)(i >> 7), k = (int)(i & 127) * 8;
        if ((n >> 8) != (k >> 8)) { unsigned z = 0u; asm volatile("" : "+v"(z)); *(u32x4*)(W + (size_t)n * 1024 + k) = (u32x4){z, z, z, z}; }
    }
    for (int g = 0; g < 4; ++g)
        conv_T(lds, p.w_pool + ((size_t)j * 4 + g) * 65536, 256, 256, 256, W + (size_t)(g * 256) * 1024 + g * 256, 1024, nullptr, MapPool{p.pool_scale + (size_t)j * DM + g * 256});
}
__device__ __forceinline__ void convert_ffn(const Params& p, LAS unsigned char* lds, int i) {
    conv_T(lds, p.w_ffn_in + (size_t)i * 1024 * 5632, 1024, 5632, 5632, (bf16_t*)(p.ws + WS_WFI), 1024, p.norm_ffn + (size_t)i * DM, MapFfnIn{});
    conv_T(lds, p.w_ffn_out + (size_t)i * DFF * 1024, DFF, 1024, 1024, (bf16_t*)(p.ws + WS_WFO), DFF, nullptr, MapId{});
}
__device__ __forceinline__ void convert_mixer(const Params& p, LAS unsigned char* lds, int layer) { if (layer & 1) convert_pool(p, lds, layer >> 1); else convert_ret(p, lds, layer >> 1); }

__device__ __forceinline__ void phase0(const Params& p, LAS unsigned char* lds) {
    const int tid = opaque_tid(), lane = tid & 63, wid = tid >> 6;
    bf16_t* xb = (bf16_t*)(p.ws + WS_XB); float* rss = (float*)(p.ws + WS_RSS);
    for (int row = blockIdx.x * 8 + wid; row < NTOK; row += gridDim.x * 8) {
        const float* src = (row < NP) ? p.x_prompt + (size_t)row * DM : p.x_sample + (size_t)(row - NP) * DM;
        float ss = 0.f;
#pragma unroll
        for (int i = 0; i < 4; ++i) {
            const float4 v = *(const float4*)(src + i * 256 + lane * 4);
            ss += (v.x * v.x + v.y * v.y) + (v.z * v.z + v.w * v.w);
            u32x2 w; w.x = cvt_pk_bf16(v.x, v.y); w.y = cvt_pk_bf16(v.z, v.w);
            *(u32x2*)(xb + (size_t)row * DM + i * 256 + lane * 4) = w;
        }
#pragma unroll
        for (int o = 32; o >= 1; o >>= 1) ss += __shfl_xor(ss, o);
        if (lane < 16) rss[(size_t)row * 16 + lane] = (lane == 0) ? ss : 0.f;
    }
    const size_t gt = (size_t)blockIdx.x * blockDim.x + tid, nth = (size_t)gridDim.x * blockDim.x;
    float* cosT = (float*)(p.ws + WS_COS); float* sinT = (float*)(p.ws + WS_SIN);
    for (size_t i = gt; i < (size_t)SEQ * 128; i += nth) {
        const int pos = (int)(i >> 7), j = (int)(i & 127);
        const double inv = exp2(-(double)j * 0.10381025296523007), t = (double)pos * inv * 0.31830988618379067154;
        double s, c; sincospi(t, &s, &c);
        cosT[i] = (float)c; sinT[i] = (float)s;
    }
    convert_mixer(p, lds, 0); convert_mixer(p, lds, 1); convert_ffn(p, lds, 0);
}

template <int W>
__device__ __forceinline__ void pool_unit(const float* xres, const float* sp, const LAS float* rl, bf16_t* dbuf, float* po, int rowbase, int t0, int c0, float g0, float g1, bool isS, bool lastu) {
    float2 hv[15 + W];
#pragma unroll
    for (int i = 0; i < 15 + W; ++i) {
        const int t = t0 - (W - 1) + i;
        float2 v = make_float2(0.f, 0.f);
        if (t >= 0) { const float2 x = *(const float2*)(xres + (size_t)(rowbase + t) * DM + c0); const float r = rl[i + 16 - W]; v = make_float2(x.x * r * g0, x.y * r * g1); }
        else if (isS) v = *(const float2*)(sp + (size_t)(15 + t) * DM + c0);
        hv[i] = v;
    }
    float2 s = make_float2(0.f, 0.f);
#pragma unroll
    for (int i = 0; i < W - 1; ++i) { s.x += hv[i].x; s.y += hv[i].y; }
#pragma unroll
    for (int k = 0; k < 16; ++k) {
        const float2 h = hv[W - 1 + k];
        s.x += h.x; s.y += h.y;
        const float inv = 1.0f / (isS ? (float)W : (float)min(t0 + k + 1, W));
        *(unsigned*)(dbuf + (size_t)(rowbase + t0 + k) * DM + c0) = cvt_pk_bf16(s.x * inv - h.x, s.y * inv - h.y);
        if (lastu && k >= 1) *(float2*)(po + (size_t)(k - 1) * DM + c0) = h;
        s.x -= hv[k].x; s.y -= hv[k].y;
    }
}
__device__ __forceinline__ void phase_pool_prep(const Params& p, LAS unsigned char* lds, int layer) {
    const int j = layer >> 1, tid = opaque_tid(), c0 = tid * 2, gi = __builtin_amdgcn_readfirstlane(tid >> 7);
    const float* xres = p.out; const float* rssc = (const float*)(p.ws + WS_RSS) + (size_t)(2 * layer) * NTOK * 16;
    const float g0 = p.norm_mix[(size_t)layer * DM + c0], g1 = p.norm_mix[(size_t)layer * DM + c0 + 1];
    bf16_t* dbuf = (bf16_t*)(p.ws + WS_QKV);
    LAS float* rl = (LAS float*)lds;
    for (int u = blockIdx.x; u < 2064; u += gridDim.x) {
        int t0, rowbase; bool isS, lastu; const float* sp = nullptr; float* po;
        if (u < 2048) { const int b = u >> 10; t0 = (u & 1023) * 16; rowbase = b * SEQ; isS = false; lastu = (u & 1023) == 1023; po = p.out + OUT_POOLP + ((size_t)(j * 2 + b) * 15) * DM; }
        else { const int sb = u - 2048; t0 = 0; rowbase = NP + sb * 16; isS = true; lastu = true; sp = p.state_pool + ((size_t)(j * 16 + sb) * 15) * DM; po = p.out + OUT_POOLS + ((size_t)(j * 16 + sb) * 15) * DM; }
        __syncthreads();
        if (tid < 31) { const int t = t0 - 15 + tid; rl[tid] = (t >= 0) ? rs_row(rssc + (size_t)(rowbase + t) * 16) : 0.f; }
        __syncthreads();
        if (gi == 0) pool_unit<2>(xres, sp, rl, dbuf, po, rowbase, t0, c0, g0, g1, isS, lastu);
        else if (gi == 1) pool_unit<4>(xres, sp, rl, dbuf, po, rowbase, t0, c0, g0, g1, isS, lastu);
        else if (gi == 2) pool_unit<8>(xres, sp, rl, dbuf, po, rowbase, t0, c0, g0, g1, isS, lastu);
        else pool_unit<16>(xres, sp, rl, dbuf, po, rowbase, t0, c0, g0, g1, isS, lastu);
    }
}

__device__ __forceinline__ void phase_final(const Params& p) {
    const float* rssc = (const float*)(p.ws + WS_RSS) + (size_t)8 * NTOK * 16;
    for (size_t i = (size_t)blockIdx.x * blockDim.x + opaque_tid(); i < (size_t)NTOK * 256; i += (size_t)gridDim.x * blockDim.x) {
        const int row = (int)(i >> 8), c = (int)(i & 255) * 4;
        const float r = rs_row(rssc + (size_t)row * 16);
        const float4 g = *(const float4*)(p.norm_final + c);
        float4 v = *(const float4*)(p.out + (size_t)row * DM + c);
        v.x *= r * g.x; v.y *= r * g.y; v.z *= r * g.z; v.w *= r * g.w;
        *(float4*)(p.out + (size_t)row * DM + c) = v;
    }
}

__device__ __forceinline__ unsigned offb(unsigned row, unsigned ch) { return 256u * row + 16u * (ch ^ (((row & 3u) << 2) | ((row >> 2) & 3u))); }
__device__ __forceinline__ unsigned img_off(unsigned row, unsigned ch32) { return (ch32 >> 4) * 16384u + offb(row, ch32 & 15u); }
constexpr unsigned IMG_Q = 0, IMG_K = 32768, IMG_V = 65536, IMG_P = 98304, IMG_O = 107520;

__device__ __forceinline__ void tile_load(u32x4 (&r)[4], const bf16_t* g, int ld, int nvalid, int tid_) {
    int tid = tid_; asm volatile("" : "+v"(tid));
    const int r0 = (tid >> 5) & 15, ch = tid & 31;
    const bf16_t* gp = g + (size_t)r0 * ld + ch * 8;
    if (nvalid >= 64) {
#pragma unroll
        for (int i = 0; i < 4; ++i) r[i] = *(const u32x4*)(gp + (size_t)(16 * i) * ld);
    } else {
        r[0] = *(const u32x4*)gp;
        unsigned z = 0u; asm volatile("" : "+v"(z));
#pragma unroll
        for (int i = 1; i < 4; ++i) r[i] = (u32x4){z, z, z, z};
    }
}
__device__ __forceinline__ void tile_store(LAS unsigned char* img, const u32x4 (&r)[4], int tid_) {
    int tid = tid_; asm volatile("" : "+v"(tid));
    const unsigned r0 = (tid >> 5) & 15, ch = tid & 31;
    LAS unsigned char* bp = img + img_off(r0, ch);
#pragma unroll
    for (int i = 0; i < 4; ++i) *(LAS u32x4*)(bp + 4096 * i) = r[i];
}
__device__ __forceinline__ bf16x8 tr_frag(LAS unsigned char* img, int lane, int cblk  , int ks) {
    const unsigned h = lane >> 5, blk = (lane >> 4) & 1, q = (lane & 15) >> 2, pp = lane & 3;
    const unsigned c = cblk & 3;
    const unsigned lowc = 2 * blk + (pp >> 1);
    const unsigned chx0 = ((c ^ q) << 2) | (lowc ^ (2 * h)), chx1 = chx0 ^ 1u;
    const unsigned rb = 256u * (8 * h + q) + 8 * (pp & 1);
    const unsigned a0 = rb + 16u * chx0, a1 = rb + 1024u + 16u * chx1;
    LAS unsigned char* base = img + (cblk >> 2) * 16384 + ks * 4096;
    const s16x4 lo = __builtin_amdgcn_ds_read_tr16_b64_v4i16((LAS s16x4*)(base + a0));
    const s16x4 hi = __builtin_amdgcn_ds_read_tr16_b64_v4i16((LAS s16x4*)(base + a1));
    return __builtin_shufflevector(lo, hi, 0, 1, 2, 3, 4, 5, 6, 7);
}
__device__ __forceinline__ bf16x8 pack8(const f32x16& s, int base) {
    u32x4 w; w.x = cvt_pk_bf16(s[base + 0], s[base + 1]); w.y = cvt_pk_bf16(s[base + 2], s[base + 3]); w.z = cvt_pk_bf16(s[base + 4], s[base + 5]); w.w = cvt_pk_bf16(s[base + 6], s[base + 7]);
    return __builtin_bit_cast(bf16x8, w);
}

__device__ __forceinline__ void state_update(f32x16 (&S)[8], LAS unsigned char* kimg, const bf16x8 (&Vf)[4], int lane) {
#pragma unroll
    for (int dt = 0; dt < 8; ++dt)
#pragma unroll
        for (int ks = 0; ks < 4; ++ks) {
            const bf16x8 a = tr_frag(kimg, lane, dt, ks);
            S[dt] = __builtin_amdgcn_mfma_f32_32x32x16_bf16(a, Vf[ks], S[dt], 0, 0, 0);
        }
}

__device__ __forceinline__ void phase_scan_local(const Params& p, LAS unsigned char* lds) {
    const int tid = opaque_tid(), lane_ = tid & 63, wid = __builtin_amdgcn_readfirstlane(tid >> 6);
    const bf16_t* qkv = (const bf16_t*)(p.ws + WS_QKV); float* T = (float*)(p.ws + WS_T);
    for (int u_ = blockIdx.x; u_ < 256; u_ += gridDim.x) {
        const int u = (gridDim.x == 256) ? (((u_ >> 4) << 4) | ((u_ & 7) << 1) | ((u_ >> 3) & 1)) : u_;
        const int eh = u & 1, seg = (u >> 1) & 15, h = (u >> 5) & 3, b = u >> 7;
        const size_t row0 = (size_t)b * SEQ + (size_t)seg * 1024;
        const bf16_t* kb = qkv + row0 * 4096 + 1024 + h * 256; const bf16_t* vb = qkv + row0 * 4096 + 2048 + h * 512 + eh * 256;
        const float gC = exp2f(64.f * lg2gamma(h));
        f32x16 S[8];
#pragma unroll
        for (int i = 0; i < 8; ++i)
#pragma unroll
            for (int r = 0; r < 16; ++r) S[i][r] = 0.f;
        u32x4 rk0[4], rv0[4], rk1[4], rv1[4];
        tile_load(rk0, kb, 4096, 64, tid); tile_load(rv0, vb, 4096, 64, tid);
        tile_load(rk1, kb + (size_t)64 * 4096, 4096, 64, tid); tile_load(rv1, vb + (size_t)64 * 4096, 4096, 64, tid);
        LDS_BARRIER();
        tile_store(lds, rk0, tid); tile_store(lds + 32768, rv0, tid);
        LDS_BARRIER();
        tile_load(rk0, kb + (size_t)2 * 64 * 4096, 4096, 64, tid); tile_load(rv0, vb + (size_t)2 * 64 * 4096, 4096, 64, tid);
        for (int c = 0; c < 16; c += 2) {
            {
                int lane = lane_; asm volatile("" : "+v"(lane));
                tile_store(lds + 65536, rk1, tid); tile_store(lds + 98304, rv1, tid);
#pragma unroll
                for (int i = 0; i < 8; ++i) S[i] *= gC;
                bf16x8 Vf[4];
#pragma unroll
                for (int ks = 0; ks < 4; ++ks) Vf[ks] = tr_frag(lds + 32768, lane, wid, ks);
                state_update(S, lds, Vf, lane);
                LDS_BARRIER();
                if (c + 3 < 16) { tile_load(rk1, kb + (size_t)(c + 3) * 64 * 4096, 4096, 64, tid); tile_load(rv1, vb + (size_t)(c + 3) * 64 * 4096, 4096, 64, tid); }
            }
            {
                int lane = lane_; asm volatile("" : "+v"(lane));
                if (c + 2 < 16) { tile_store(lds, rk0, tid); tile_store(lds + 32768, rv0, tid); }
#pragma unroll
                for (int i = 0; i < 8; ++i) S[i] *= gC;
                bf16x8 Vf[4];
#pragma unroll
                for (int ks = 0; ks < 4; ++ks) Vf[ks] = tr_frag(lds + 98304, lane, wid, ks);
                state_update(S, lds + 65536, Vf, lane);
                LDS_BARRIER();
                if (c + 4 < 16) { tile_load(rk0, kb + (size_t)(c + 4) * 64 * 4096, 4096, 64, tid); tile_load(rv0, vb + (size_t)(c + 4) * 64 * 4096, 4096, 64, tid); }
            }
        }
        float* Tu = T + (size_t)u * 65536;
        int lz = lane_; asm volatile("" : "+v"(lz));
        const int hl = lz >> 5, e = wid * 32 + (lz & 31);
#pragma unroll
        for (int dt = 0; dt < 8; ++dt)
#pragma unroll
            for (int r = 0; r < 16; ++r) Tu[(size_t)(32 * dt + (r & 3) + 8 * (r >> 2) + 4 * hl) * 256 + e] = S[dt][r];
    }
}

__device__ __forceinline__ void phase_scan_prefix(const Params& p, int jl) {
    float* T = (float*)(p.ws + WS_T);
    const int gt = blockIdx.x * 512 + opaque_tid(), nth = gridDim.x * 512;
    for (int i = gt; i < 262144; i += nth) {
        const int grp = i >> 14, pos = (i & 16383) * 4, eh = grp & 1, bh = grp >> 1, h = bh & 3;
        const float gS = exp2f(1024.f * lg2gamma(h));
        float* base = T + ((size_t)(bh * 16) * 2 + eh) * 65536 + pos;
        float4 t[16];
#pragma unroll
        for (int j = 0; j < 16; ++j) t[j] = *(const float4*)(base + (size_t)j * 131072);
        float zf = 0.f; asm volatile("" : "+v"(zf));
        float4 run = make_float4(zf, zf, zf, zf);
#pragma unroll
        for (int j = 0; j < 16; ++j) {
            *(float4*)(base + (size_t)j * 131072) = run;
            run.x = run.x * gS + t[j].x; run.y = run.y * gS + t[j].y; run.z = run.z * gS + t[j].z; run.w = run.w * gS + t[j].w;
        }
        const int d = pos >> 8, e = pos & 255;
        *(float4*)(p.out + OUT_RETP + ((size_t)((jl * 2 + (bh >> 2)) * 4 + h) * 256 + d) * 512 + eh * 256 + e) = run;
    }
}

__device__ __forceinline__ void phase_scan(const Params& p, LAS unsigned char* lds, int jl) {
    const int tid = opaque_tid(), lane_ = tid & 63, wid = __builtin_amdgcn_readfirstlane(tid >> 6);
    bf16_t* qkv = (bf16_t*)(p.ws + WS_QKV); const float* T = (const float*)(p.ws + WS_T);
    float* gss = (float*)(p.ws + WS_GSS) + (size_t)jl * NTOK * 8;
    for (int v_ = blockIdx.x; v_ < 384; v_ += gridDim.x) {
        const int v = (gridDim.x == 256) ? ((v_ & 256) | (((v_ & 255) >> 4) << 4) | ((v_ & 7) << 1) | ((v_ >> 3) & 1)) : v_;
        int eh, h, Lc, nch; size_t row0; float* Sout = nullptr;
        f32x16 S[8];
        if (v < 256) {
            eh = v & 1; const int seg = (v >> 1) & 15; h = (v >> 5) & 3; const int b = v >> 7;
            row0 = (size_t)b * SEQ + (size_t)seg * 1024; Lc = 64; nch = 16;
            {
                int lz = lane_; asm volatile("" : "+v"(lz)); const int hl_ = lz >> 5, ecol_ = wid * 32 + (lz & 31);
                const float* Tu = T + (size_t)v * 65536;
#pragma unroll
                for (int dt = 0; dt < 8; ++dt)
#pragma unroll
                    for (int r = 0; r < 16; ++r) S[dt][r] = Tu[(size_t)(32 * dt + (r & 3) + 8 * (r >> 2) + 4 * hl_) * 256 + ecol_];
            }
        } else {
            const int su = v - 256; eh = su & 1; h = (su >> 1) & 3; const int sb = su >> 3;
            row0 = (size_t)NP + (size_t)sb * 16; Lc = 16; nch = 1;
            Sout = p.out + OUT_RETS + ((size_t)((jl * 16 + sb) * 4 + h) * 256) * 512 + eh * 256;
            int lz = lane_; asm volatile("" : "+v"(lz)); const int hl_ = lz >> 5, ecol_ = wid * 32 + (lz & 31);
            const float* Sin = p.state_ret + ((size_t)((jl * 16 + sb) * 4 + h) * 256) * 512 + eh * 256;
#pragma unroll
            for (int dt = 0; dt < 8; ++dt)
#pragma unroll
                for (int r = 0; r < 16; ++r) S[dt][r] = Sin[(size_t)(32 * dt + (r & 3) + 8 * (r >> 2) + 4 * hl_) * 512 + ecol_];
        }
        const float lg = lg2gamma(h), gC = exp2f((float)Lc * lg), gCinv = exp2f(-(float)Lc * lg);
        bf16_t* qb = qkv + row0 * 4096 + h * 256; bf16_t* kb = qkv + row0 * 4096 + 1024 + h * 256; bf16_t* vb = qkv + row0 * 4096 + 2048 + h * 512 + eh * 256;
        u32x4 rq[4], rk[4], rv[4];
        tile_load(rq, qb, 4096, Lc, tid); tile_load(rk, kb, 4096, Lc, tid); tile_load(rv, vb, 4096, Lc, tid);
        LDS_BARRIER();
        tile_store(lds + IMG_Q, rq, tid); tile_store(lds + IMG_K, rk, tid); tile_store(lds + IMG_V, rv, tid);
        LDS_BARRIER();
        for (int c = 0; c < nch; ++c) {
            int lane = lane_; asm volatile("" : "+v"(lane)); const int hl = lane >> 5, ecol = wid * 32 + (lane & 31);
            {
                const int mi = wid >> 1, nj0 = 2 * (wid & 1), l15 = lane & 15, l4 = lane >> 4;
                f32x4 sc[2] = {(f32x4){0.f, 0.f, 0.f, 0.f}, (f32x4){0.f, 0.f, 0.f, 0.f}};
#pragma unroll
                for (int s = 0; s < 8; ++s) {
                    const bf16x8 a = *(const LAS bf16x8*)(lds + IMG_K + img_off(16 * mi + l15, 4 * s + l4));
#pragma unroll
                    for (int t = 0; t < 2; ++t) {
                        const bf16x8 bq = *(const LAS bf16x8*)(lds + IMG_Q + img_off(16 * (nj0 + t) + l15, 4 * s + l4));
                        sc[t] = __builtin_amdgcn_mfma_f32_16x16x32_bf16(a, bq, sc[t], 0, 0, 0);
                    }
                }
#pragma unroll
                for (int t = 0; t < 2; ++t) {
                    const int n = 16 * (nj0 + t) + l15, m0 = 16 * mi + 4 * l4;
                    float pv[4];
#pragma unroll
                    for (int r = 0; r < 4; ++r) pv[r] = (n >= m0 + r) ? sc[t][r] * gCinv : 0.f;
                    u32x2 w; w.x = cvt_pk_bf16(pv[0], pv[1]); w.y = cvt_pk_bf16(pv[2], pv[3]);
                    *(LAS u32x2*)(lds + IMG_P + n * 144 + m0 * 2) = w;
                }
            }
            LDS_BARRIER();
            f32x16 o[2];
#pragma unroll
            for (int nt = 0; nt < 2; ++nt)
#pragma unroll
                for (int r = 0; r < 16; ++r) o[nt][r] = 0.f;
#pragma unroll
            for (int s = 0; s < 16; ++s) {
                const bf16x8 bs = pack8(S[s >> 1], 8 * (s & 1));
#pragma unroll
                for (int nt = 0; nt < 2; ++nt) {
                    const unsigned rown = 32 * nt + (lane & 31);
                    const u32x2 lo = *(const LAS u32x2*)(lds + IMG_Q + img_off(rown, 2 * s) + 8 * hl);
                    const u32x2 hi = *(const LAS u32x2*)(lds + IMG_Q + img_off(rown, 2 * s + 1) + 8 * hl);
                    const u32x4 aw = (u32x4){lo.x, lo.y, hi.x, hi.y};
                    o[nt] = __builtin_amdgcn_mfma_f32_32x32x16_bf16(__builtin_bit_cast(bf16x8, aw), bs, o[nt], 0, 0, 0);
                }
            }
            bf16x8 Vf[4];
#pragma unroll
            for (int ks = 0; ks < 4; ++ks) Vf[ks] = tr_frag(lds + IMG_V, lane, wid, ks);
#pragma unroll
            for (int ks = 0; ks < 4; ++ks)
#pragma unroll
                for (int nt = 0; nt < 2; ++nt) {
                    const bf16x8 a = *(const LAS bf16x8*)(lds + IMG_P + (32 * nt + (lane & 31)) * 144 + (16 * ks + 8 * hl) * 2);
                    o[nt] = __builtin_amdgcn_mfma_f32_32x32x16_bf16(a, Vf[ks], o[nt], 0, 0, 0);
                }
            {
                LAS unsigned char* oi = lds + IMG_O + (4 * hl) * 528 + ecol * 2;
#pragma unroll
                for (int nt = 0; nt < 2; ++nt)
#pragma unroll
                    for (int r = 0; r < 16; ++r) *(LAS bf16_t*)(oi + (32 * nt + (r & 3) + 8 * (r >> 2)) * 528) = (bf16_t)cvt_pk_bf16(o[nt][r], o[nt][r]);
            }
            if (c + 1 < nch) { tile_load(rk, kb + (size_t)(c + 1) * 64 * 4096, 4096, 64, tid); tile_load(rv, vb + (size_t)(c + 1) * 64 * 4096, 4096, 64, tid); }
#pragma unroll
            for (int i = 0; i < 8; ++i) S[i] *= gC;
            {
                int lane2 = lane_; asm volatile("" : "+v"(lane2));
                bf16x8 Vg[4];
#pragma unroll
                for (int ks = 0; ks < 4; ++ks) Vg[ks] = tr_frag(lds + IMG_V, lane2, wid, ks);
                state_update(S, lds + IMG_K, Vg, lane2);
            }
            __builtin_amdgcn_sched_barrier(0);
            LDS_BARRIER();
            if (c + 1 < nch) { tile_load(rq, qb + (size_t)(c + 1) * 64 * 4096, 4096, 64, tid); tile_store(lds + IMG_K, rk, tid); tile_store(lds + IMG_V, rv, tid); tile_store(lds + IMG_Q, rq, tid); }
            {
                int t2 = tid; asm volatile("" : "+v"(t2));
                const int r0 = (t2 >> 5) & 15, ch = t2 & 31;
                bf16_t* og = vb + (size_t)c * 64 * 4096 + (size_t)r0 * 4096 + ch * 8;
#pragma unroll
                for (int i = 0; i < 4; ++i) {
                    if (i == 0 || Lc == 64) {
                        const u32x4 w = *(const LAS u32x4*)(lds + IMG_O + (r0 + 16 * i) * 528 + ch * 16);
                        *(u32x4*)(og + (size_t)(16 * i) * 4096) = w;
                        const float a0 = __uint_as_float(w.x << 16), a1 = __uint_as_float(w.x & 0xffff0000u), a2 = __uint_as_float(w.y << 16), a3 = __uint_as_float(w.y & 0xffff0000u);
                        const float a4 = __uint_as_float(w.z << 16), a5 = __uint_as_float(w.z & 0xffff0000u), a6 = __uint_as_float(w.w << 16), a7 = __uint_as_float(w.w & 0xffff0000u);
                        float ss = ((a0 * a0 + a1 * a1) + (a2 * a2 + a3 * a3)) + ((a4 * a4 + a5 * a5) + (a6 * a6 + a7 * a7));
                        ss += __shfl_xor(ss, 16); ss += __shfl_xor(ss, 8); ss += __shfl_xor(ss, 4); ss += __shfl_xor(ss, 2); ss += __shfl_xor(ss, 1);
                        if (ch == 0) gss[((row0 + (size_t)c * 64 + r0 + 16 * i) * 4 + h) * 2 + eh] = ss;
                    }
                }
            }
            LDS_BARRIER();
        }
        if (Sout) {
            int lz = lane_; asm volatile("" : "+v"(lz)); const int hl_ = lz >> 5, ecol_ = wid * 32 + (lz & 31);
#pragma unroll
            for (int dt = 0; dt < 8; ++dt)
#pragma unroll
                for (int r = 0; r < 16; ++r) Sout[(size_t)(32 * dt + (r & 3) + 8 * (r >> 2) + 4 * hl_) * 512 + ecol_] = S[dt][r];
        }
    }
}

struct PoolOrder : pg8::StaticOrder {
    __device__ __forceinline__ bool next(int i, Unit& u) const { const bool ok = pg8::StaticOrder::next(i, u); if (ok) u.kofs = u.pn * 256; return ok; }
};
template <class Epi>
__device__ __forceinline__ void run_gemm(LAS unsigned char* lds, const bf16_t* A, int lda, const bf16_t* Bt, int N, int K, const Epi& E, int M = NTOK) {
    pg8::Gemm g{A, Bt, M, N, K, lda, K}; pg8::StaticOrder S; S.init(M, N, (int)gridDim.x, (int)blockIdx.x);
    pg8::gemm_phase<Epi, pg8::StaticOrder, false>(lds, g, S, E, nullptr);
}

__device__ __forceinline__ void narrow_core(LAS unsigned char* lds, const bf16_t* ag, int lda, const bf16_t* bg0, const bf16_t* bg1, int K, f32x16& acc0, f32x16& acc1, int tid, int lane, int wid) {
    const int lr = tid >> 4, lc = tid & 15, hl = lane >> 5, l31 = lane & 31;
#pragma unroll
    for (int i = 0; i < 16; ++i) { acc0[i] = 0.f; acc1[i] = 0.f; }
    u32x4 ra0[8], rb0[2], ra1[8], rb1[2];
#define NR_LOAD(RA, RB, KO) do { int ko_ = (KO); asm volatile("" : "+s"(ko_)); const bf16_t* agp = ag + ko_; const bf16_t* b0p = bg0 + ko_; const bf16_t* b1p = bg1 + ko_; \
        _Pragma("unroll") for (int q = 0; q < 8; ++q) { RA[q] = *(const u32x4*)agp; agp += (size_t)32 * lda; } \
        RB[0] = *(const u32x4*)b0p; RB[1] = *(const u32x4*)b1p; } while (0)
#define NR_STORE(RA, RB) do { _Pragma("unroll") for (int q = 0; q < 8; ++q) *(LAS u32x4*)(lds + (q >> 1) * 16384 + offb((q & 1) * 32 + lr, lc)) = RA[q]; \
        *(LAS u32x4*)(lds + 65536 + offb(lr, lc)) = RB[0]; *(LAS u32x4*)(lds + 65536 + offb(32 + lr, lc)) = RB[1]; } while (0)
#define NR_COMPUTE() do { LAS unsigned char* ai = lds + (wid >> 1) * 16384; const unsigned arow = (wid & 1) * 32 + l31; \
        _Pragma("unroll") for (int q = 0; q < 8; ++q) { \
            const bf16x8 a = *(const LAS bf16x8*)(ai + offb(arow, 2 * q + hl)); \
            const bf16x8 x0 = *(const LAS bf16x8*)(lds + 65536 + offb(l31, 2 * q + hl)); \
            const bf16x8 x1 = *(const LAS bf16x8*)(lds + 65536 + offb(32 + l31, 2 * q + hl)); \
            acc0 = __builtin_amdgcn_mfma_f32_32x32x16_bf16(a, x0, acc0, 0, 0, 0); acc1 = __builtin_amdgcn_mfma_f32_32x32x16_bf16(a, x1, acc1, 0, 0, 0); } } while (0)
    NR_LOAD(ra0, rb0, 0); NR_LOAD(ra1, rb1, 128);
    LDS_BARRIER();
    for (int k = 0; k < K; k += 256) {
        NR_STORE(ra0, rb0); LDS_BARRIER();
        if (k + 256 < K) NR_LOAD(ra0, rb0, k + 256);
        NR_COMPUTE(); LDS_BARRIER();
        NR_STORE(ra1, rb1); LDS_BARRIER();
        if (k + 384 < K) NR_LOAD(ra1, rb1, k + 384);
        NR_COMPUTE(); LDS_BARRIER();
    }
#undef NR_LOAD
#undef NR_STORE
#undef NR_COMPUTE
}
__device__ __forceinline__ void narrow_scales(LAS unsigned char* lds, const float* rss, int tid) {
    if (tid < 256) ((LAS float*)(lds + 81920))[tid] = rs_row(rss + (size_t)(NP + tid) * 16);
}
__device__ __forceinline__ void narrow_ffn(LAS unsigned char* lds, const bf16_t* xb, const bf16_t* Wfi, bf16_t* act, const float* rss) {
    const int tid = opaque_tid(), lane = tid & 63, wid = __builtin_amdgcn_readfirstlane(tid >> 6), lr = tid >> 4, lc = tid & 15;
    for (int j = blockIdx.x; j < 88; j += gridDim.x) {
        const int jj = 32 * j + lr, dra = (jj >> 2) * 8 + (jj & 3);
        f32x16 acc0, acc1;
        __syncthreads(); narrow_scales(lds, rss, tid);
        narrow_core(lds, xb + (size_t)(NP + lr) * DM + lc * 8, DM, Wfi + (size_t)dra * DM + lc * 8, Wfi + (size_t)(dra + 4) * DM + lc * 8, DM, acc0, acc1, tid, lane, wid);
        int lz = lane; asm volatile("" : "+v"(lz)); const int hl = lz >> 5, l31 = lz & 31;
#pragma unroll
        for (int i = 0; i < 16; ++i) {
            const int rs = 32 * wid + (i & 3) + 8 * (i >> 2) + 4 * hl; const float r = ((const LAS float*)(lds + 81920))[rs];
            act[(size_t)(NP + rs) * DFF + 32 * j + l31] = f2bf(silu_f(acc0[i] * r) * (acc1[i] * r));
        }
    }
}
__device__ __forceinline__ void narrow_qkv(LAS unsigned char* lds, const bf16_t* xb, const bf16_t* Wri, bf16_t* qkv, const float* rss, const float* cosT, const float* sinT) {
    const int tid = opaque_tid(), lane = tid & 63, wid = __builtin_amdgcn_readfirstlane(tid >> 6), lr = tid >> 4, lc = tid & 15;
    for (int j = blockIdx.x; j < 64; j += gridDim.x) {
        const bool rot = j < 32; const int hd = j >> 2, j0 = (j & 3) * 32;
        const int cA = rot ? hd * 256 + j0 : 2048 + (j - 32) * 64, cB = rot ? cA + 128 : cA + 32;
        f32x16 acc0, acc1;
        __syncthreads(); narrow_scales(lds, rss, tid);
        narrow_core(lds, xb + (size_t)(NP + lr) * DM + lc * 8, DM, Wri + (size_t)(cA + lr) * DM + lc * 8, Wri + (size_t)(cB + lr) * DM + lc * 8, DM, acc0, acc1, tid, lane, wid);
        int lz = lane; asm volatile("" : "+v"(lz)); const int hl = lz >> 5, l31 = lz & 31;
        const float lg = lg2gamma(hd & 3);
        float cs[16], sn_[16];
        if (rot) {
#pragma unroll
            for (int i = 0; i < 16; ++i) { const int l = (32 * wid + (i & 3) + 8 * (i >> 2) + 4 * hl) & 15; cs[i] = cosT[(size_t)(1024 + l) * 128 + j0 + l31]; sn_[i] = sinT[(size_t)(1024 + l) * 128 + j0 + l31]; }
        }
#pragma unroll
        for (int i = 0; i < 16; ++i) {
            const int rs = 32 * wid + (i & 3) + 8 * (i >> 2) + 4 * hl; const float r = ((const LAS float*)(lds + 81920))[rs];
            bf16_t* op = qkv + (size_t)(NP + rs) * 4096;
            if (rot) {
                const int l = rs & 15; const float e = (hd < 4) ? (float)(l + 1) : (float)(15 - l);
                const float dec = exp2f(e * lg) * r, x1 = acc0[i] * dec, x2 = acc1[i] * dec;
                const float c = cs[i], sn = sn_[i];
                op[cA + l31] = f2bf(x1 * c - x2 * sn); op[cB + l31] = f2bf(x1 * sn + x2 * c);
            } else { op[cA + l31] = f2bf(acc0[i] * r); op[cB + l31] = f2bf(acc1[i] * r); }
        }
    }
}
__device__ __forceinline__ void narrow_gate(LAS unsigned char* lds, const bf16_t* xb, const bf16_t* Wg, bf16_t* qkv, const float* rss, const float* gss) {
    const int tid = opaque_tid(), lane = tid & 63, wid = __builtin_amdgcn_readfirstlane(tid >> 6), lr = tid >> 4, lc = tid & 15;
    for (int j = blockIdx.x; j < 32; j += gridDim.x) {
        const int cA = j * 64, head = j >> 3;
        f32x16 acc0, acc1;
        __syncthreads(); narrow_scales(lds, rss, tid);
        if (tid < 256) { const float2 gp = *(const float2*)(gss + ((size_t)(NP + tid) * 4 + head) * 2); ((LAS float*)(lds + 81920 + 1024))[tid] = __builtin_amdgcn_rsqf((gp.x + gp.y) * (1.0f / 512.0f) + EPS); }
        narrow_core(lds, xb + (size_t)(NP + lr) * DM + lc * 8, DM, Wg + (size_t)(cA + lr) * DM + lc * 8, Wg + (size_t)(cA + 32 + lr) * DM + lc * 8, DM, acc0, acc1, tid, lane, wid);
        int lz = lane; asm volatile("" : "+v"(lz)); const int hl = lz >> 5, l31 = lz & 31;
        unsigned short ob0[16], ob1[16];
#pragma unroll
        for (int i = 0; i < 16; ++i) { const bf16_t* op = qkv + (size_t)(NP + 32 * wid + (i & 3) + 8 * (i >> 2) + 4 * hl) * 4096 + 2048 + cA + l31; ob0[i] = op[0]; ob1[i] = op[32]; }
#pragma unroll
        for (int i = 0; i < 16; ++i) {
            const int rs = 32 * wid + (i & 3) + 8 * (i >> 2) + 4 * hl; const float r = ((const LAS float*)(lds + 81920))[rs], rn = ((const LAS float*)(lds + 81920 + 1024))[rs];
            bf16_t* op = qkv + (size_t)(NP + rs) * 4096 + 2048 + cA + l31;
            const float o0 = __uint_as_float(((unsigned)ob0[i]) << 16), o1 = __uint_as_float(((unsigned)ob1[i]) << 16);
            op[0] = f2bf(silu_f(acc0[i] * r) * o0 * rn); op[32] = f2bf(silu_f(acc1[i] * r) * o1 * rn);
        }
    }
}
__device__ __forceinline__ void narrow_res(LAS unsigned char* lds, const bf16_t* A, int lda, const bf16_t* Bt, int K, const EpiRes& E, int ldb = 0, int kstep = 0) {
    const int tid = opaque_tid(), lane = tid & 63, wid = __builtin_amdgcn_readfirstlane(tid >> 6), lr = tid >> 4, lc = tid & 15;
    for (int j = blockIdx.x; j < 16; j += gridDim.x) {
        const int pn = j >> 2, wc = j & 3, c0 = pn * 256 + wc * 32;
        f32x16 acc0, acc1;
        __syncthreads();
        const int ldb_ = ldb ? ldb : K, ko = pn * kstep;
        narrow_core(lds, A + (size_t)(NP + lr) * lda + ko + lc * 8, lda, Bt + (size_t)(c0 + lr) * ldb_ + ko + lc * 8, Bt + (size_t)(c0 + 128 + lr) * ldb_ + ko + lc * 8, K, acc0, acc1, tid, lane, wid);
        float sq[16];
        int lz = lane; asm volatile("" : "+v"(lz)); const int hl = lz >> 5, l31 = lz & 31;
        float bb0[16], bb1[16];
#pragma unroll
        for (int i = 0; i < 16; ++i) { const float* bp = E.base_s + (size_t)(32 * wid + (i & 3) + 8 * (i >> 2) + 4 * hl) * DM + c0 + l31; bb0[i] = bp[0]; bb1[i] = bp[128]; }
#pragma unroll
        for (int i = 0; i < 16; ++i) {
            const int rs = 32 * wid + (i & 3) + 8 * (i >> 2) + 4 * hl;
            const float v0 = bb0[i] + acc0[i], v1 = bb1[i] + acc1[i];
            float* xo = E.xres + (size_t)(NP + rs) * DM + c0 + l31; xo[0] = v0; xo[128] = v1;
            if (E.xb) { bf16_t* bo = E.xb + (size_t)(NP + rs) * DM + c0 + l31; bo[0] = f2bf(v0); bo[128] = f2bf(v1); }
            sq[i] = v0 * v0 + v1 * v1;
        }
        float s8[8], s4[4], s2[2], s1;
        { const bool bit = (lane & 16) != 0;
#pragma unroll
          for (int i = 0; i < 8; ++i) { const float keep = bit ? sq[i + 8] : sq[i], send = bit ? sq[i] : sq[i + 8]; s8[i] = keep + __shfl_xor(send, 16); } }
        { const bool bit = (lane & 8) != 0;
#pragma unroll
          for (int i = 0; i < 4; ++i) { const float keep = bit ? s8[i + 4] : s8[i], send = bit ? s8[i] : s8[i + 4]; s4[i] = keep + __shfl_xor(send, 8); } }
        { const bool bit = (lane & 4) != 0;
#pragma unroll
          for (int i = 0; i < 2; ++i) { const float keep = bit ? s4[i + 2] : s4[i], send = bit ? s4[i] : s4[i + 2]; s2[i] = keep + __shfl_xor(send, 4); } }
        { const bool bit = (lane & 2) != 0; const float keep = bit ? s2[1] : s2[0], send = bit ? s2[0] : s2[1]; s1 = keep + __shfl_xor(send, 2); }
        s1 += __shfl_xor(s1, 1);
        const int idx = (lane >> 1) & 15, rs = 32 * wid + (idx & 3) + 8 * (idx >> 2) + 4 * hl;
        if ((lane & 1) == 0) E.rss_next[(size_t)(NP + rs) * 16 + pn * 4 + wc] = s1;
    }
}

__device__ __forceinline__ void run_phase(const Params& p_, LAS unsigned char* lds, int ph_) {
    const bool nonarrow = false; const int ph = ph_ >= 100 ? ph_ - 100 : ph_;
    Params p = p_; { size_t z0 = 0, z1 = 0; asm volatile("" : "+s"(z0), "+s"(z1)); p.ws = p_.ws + z0; p.out = p_.out + z1; }
    bf16_t* xb = (bf16_t*)(p.ws + WS_XB); bf16_t* qkv = (bf16_t*)(p.ws + WS_QKV); float* rss = (float*)(p.ws + WS_RSS); float* gss = (float*)(p.ws + WS_GSS);
    const bf16_t* Wri = (const bf16_t*)(p.ws + WS_WRI); const bf16_t* Wro = (const bf16_t*)(p.ws + WS_WRO); const bf16_t* Wpl = (const bf16_t*)(p.ws + WS_WPL);
    const bf16_t* Wfi = (const bf16_t*)(p.ws + WS_WFI); const bf16_t* Wfo = (const bf16_t*)(p.ws + WS_WFO);
    float* xres = p.out;
    if (ph == NPHASE - 1) { phase_final(p); return; }
    int layer, step;
    if (ph < 9) { layer = 0; step = ph - 1; } else if (ph < 13) { layer = 1; step = ph - 9; } else if (ph < 21) { layer = 2; step = ph - 13; } else { layer = 3; step = ph - 21; }
    const int jl = layer >> 1;
    const bool is_ret = (layer & 1) == 0;
    const int fstep = is_ret ? step - 6 : step - 2;
    if (step == 0 && layer >= 1) { convert_ffn(p, lds, layer); if (layer + 1 < 4) convert_mixer(p, lds, layer + 1); __syncthreads(); }
    if (fstep == 0) { EpiFfn E{qkv, rss + (size_t)(2 * layer + 1) * NTOK * 16}; run_gemm(lds, xb, 1024, Wfi, 5632, 1024, E, NP); if (!nonarrow) narrow_ffn(lds, xb, Wfi, qkv, rss + (size_t)(2 * layer + 1) * NTOK * 16); return; }
    if (fstep == 1) { EpiRes E{xres, xres + (size_t)NP * DM, xres, layer == 1 ? xb : (bf16_t*)nullptr  , rss + (size_t)(2 * layer + 2) * NTOK * 16}; run_gemm(lds, qkv, DFF, Wfo, 1024, DFF, E, NP); narrow_res(lds, qkv, DFF, Wfo, DFF, E); return; }
    if (is_ret) {
        if (step == 0) { EpiQKV E{qkv, rss + (size_t)(2 * layer) * NTOK * 16, (const float*)(p.ws + WS_COS), (const float*)(p.ws + WS_SIN)}; run_gemm(lds, xb, 1024, Wri, 4096, 1024, E, NP); if (!nonarrow) narrow_qkv(lds, xb, Wri, qkv, rss + (size_t)(2 * layer) * NTOK * 16, (const float*)(p.ws + WS_COS), (const float*)(p.ws + WS_SIN)); }
        else if (step == 1) phase_scan_local(p, lds);
        else if (step == 2) phase_scan_prefix(p, jl);
        else if (step == 3) phase_scan(p, lds, jl);
        else if (step == 4) { EpiGate E{qkv, rss + (size_t)(2 * layer) * NTOK * 16, gss + (size_t)jl * NTOK * 8}; run_gemm(lds, xb, 1024, Wri + (size_t)4096 * 1024, 2048, 1024, E, NP); narrow_gate(lds, xb, Wri + (size_t)4096 * 1024, qkv, rss + (size_t)(2 * layer) * NTOK * 16, gss + (size_t)jl * NTOK * 8); }
        else if (step == 5) {
            const float* bp = layer == 0 ? p.x_prompt : xres; const float* bs = layer == 0 ? p.x_sample : xres + (size_t)NP * DM;
            EpiRes E{bp, bs, xres, xb, rss + (size_t)(2 * layer + 1) * NTOK * 16};
            run_gemm(lds, qkv + 2048, 4096, Wro, 1024, 2048, E, NP); narrow_res(lds, qkv + 2048, 4096, Wro, 2048, E);
        }
    } else {
        if (step == 0) phase_pool_prep(p, lds, layer);
        else if (step == 1) { EpiRes E{xres, xres + (size_t)NP * DM, xres, xb, rss + (size_t)(2 * layer + 1) * NTOK * 16}; pg8::Gemm g{qkv, Wpl, NP, 1024, 256, 1024, 1024}; PoolOrder S; S.init(NP, 1024, (int)gridDim.x, (int)blockIdx.x);
            pg8::gemm_phase<EpiRes, PoolOrder, false>(lds, g, S, E, nullptr); narrow_res(lds, qkv, 1024, Wpl, 256, E, 1024, 256); }
    }
}

__global__ void __launch_bounds__(512) mega(Params p) {
    extern __shared__ __attribute__((aligned(16))) unsigned char lds_raw[];
    LAS unsigned char* lds = (LAS unsigned char*)lds_raw;
    volatile LAS unsigned* bst = (volatile LAS unsigned*)(lds + LDS_MAIN);
    if (threadIdx.x == 0) { bst[0] = 0u; bst[1] = 0u; }
    __syncthreads();
    const XcdBarrier gbar = xcd_barrier_post((unsigned*)(p.ws + WS_BAR), bst);
#define GRID_SYNC() xcd_barrier(gbar)
#ifdef MK_PRE_SYNCS
    for (int i = 0; i < MK_PRE_SYNCS; ++i) GRID_SYNC();
#endif
#ifdef MK_PRE_MASK
#define MK_PRE(PH) if ((MK_PRE_MASK >> PH) & 1) { if (PH == 0) phase0(p, lds); else run_phase(p, lds, PH); GRID_SYNC(); }
    MK_PRE(0) MK_PRE(1) MK_PRE(2) MK_PRE(3) MK_PRE(4) MK_PRE(5) MK_PRE(6) MK_PRE(7) MK_PRE(8) MK_PRE(9) MK_PRE(10) MK_PRE(11) MK_PRE(12) MK_PRE(25)
#endif
    int ph = p.ph_lo;
    if (p.ph_hi < 0) cg::this_grid().sync();
    if (ph == 0) { phase0(p, lds); ++ph; if (ph < p.ph_hi) { GRID_SYNC(); } }
#ifdef MK_PRE_PH
    ph = 1 - MK_PRE_REP;
#endif
    for (; ph < p.ph_hi; ++ph) {
#ifdef MK_PRE_PH
        const int phx = (ph < 1) ? MK_PRE_PH + 100 : ph;
#else
        const int phx = ph;
#endif
        run_phase(p, lds, phx);
        if (ph + 1 < p.ph_hi) { GRID_SYNC(); }
    }
}
}

#ifndef MK_SINGLE
#define MK_SINGLE 1
#endif
extern "C" void kernel_launch(void* const* d_in, const int* in_sizes, int n_in, void* d_out, int out_size, void* d_ws, size_t ws_size, hipStream_t stream) {
    static int grid = 0;
    constexpr int LDS_BYTES = mk::LDS_TOTAL;
    if (grid == 0) {
        int dev = 0, cus = 0, per_cu = 0;
        hipGetDevice(&dev); hipDeviceGetAttribute(&cus, hipDeviceAttributeMultiprocessorCount, dev);
        if (hipFuncSetAttribute((const void*)mk::mega, hipFuncAttributeMaxDynamicSharedMemorySize, LDS_BYTES) != hipSuccess) { fprintf(stderr, "hipFuncSetAttribute failed\n"); }
        if (hipOccupancyMaxActiveBlocksPerMultiprocessor(&per_cu, (const void*)mk::mega, 512, LDS_BYTES) != hipSuccess || per_cu < 1) { fprintf(stderr, "occupancy query: %d\n", per_cu); per_cu = 1; }
        (void)hipGetLastError();
        grid = cus * (per_cu < 1 ? 1 : per_cu);
        if (grid <= 0) grid = 256;
    }
    if (ws_size < mk::WS_END) { fprintf(stderr, "workspace too small: %zu < %zu\n", ws_size, (size_t)mk::WS_END); return; }
    mk::Params p{};
    p.x_prompt = (const float*)d_in[0]; p.x_sample = (const float*)d_in[1]; p.state_ret = (const float*)d_in[2]; p.state_pool = (const float*)d_in[3];
    p.norm_mix = (const float*)d_in[4]; p.w_ret_in = (const float*)d_in[5]; p.w_ret_out = (const float*)d_in[6]; p.w_pool = (const float*)d_in[7];
    p.pool_scale = (const float*)d_in[8]; p.norm_ffn = (const float*)d_in[9]; p.w_ffn_in = (const float*)d_in[10]; p.w_ffn_out = (const float*)d_in[11]; p.norm_final = (const float*)d_in[12];
    p.out = (float*)d_out; p.ws = (unsigned char*)d_ws;
#if MK_SINGLE
    hipMemsetAsync((unsigned char*)d_ws + mk::WS_BAR, 0, XCD_BAR_WORDS * 4, stream);
    p.ph_lo = 0; p.ph_hi = mk::NPHASE;
    void* args[] = {&p};
    hipError_t e = hipLaunchCooperativeKernel((const void*)mk::mega, dim3(grid), dim3(512), args, LDS_BYTES, stream);
    if (e != hipSuccess) fprintf(stderr, "cooperative launch failed: %s (grid %d)\n", hipGetErrorString(e), grid);
#else
#ifndef MK_STOP
#define MK_STOP 23
#endif
    for (int ph = 0; ph < mk::NPHASE; ++ph) {
        p.ph_lo = ph; p.ph_hi = ph + 1;
        hipLaunchKernelGGL(mk::mega, dim3(grid), dim3(512), LDS_BYTES, stream, p);
    }
#endif
}
```

```cpp
#include <hip/hip_runtime.h>
#include <hip/hip_cooperative_groups.h>
#include <cstdio>
namespace cg = cooperative_groups;
#define LDS_BARRIER() asm volatile("s_waitcnt lgkmcnt(0)\n\ts_barrier" ::: "memory")
__device__ __forceinline__ int opaque_tid() { int t = (int)threadIdx.x; asm volatile("" : "+v"(t)); return t; }
namespace pg8 {
#define PG8_LAS __attribute__((address_space(3)))
typedef unsigned short bf16_t;
typedef short bf16x8 __attribute__((ext_vector_type(8)));
typedef float f32x4 __attribute__((ext_vector_type(4)));
typedef unsigned u32x4 __attribute__((ext_vector_type(4)));
constexpr int BM = 256, BK = 64, HALF = 128, HTB = HALF * BK * 2  , STAGE_BYTES = 8 * HTB, NXCD = 8, WGM = 8;

__host__ __device__ __forceinline__ int lds_byte(int r, int c) { const int st = (r >> 4) * 2 + (c >> 5), rr = r & 15, cc = c & 31, ob = rr * 64 + cc * 2; return st * 1024 + (ob ^ (((ob >> 9) & 1) << 5)); }
__host__ __device__ __forceinline__ void stage_rc(int b, int& R, int& C) { const int st = b / 1024, sb = b % 1024, swz = sb ^ (((sb >> 9) & 1) << 5); R = (st >> 1) * 16 + swz / 64; C = (st & 1) * 32 + (swz % 64) / 2; }
__host__ __device__ __forceinline__ int perm32(int rho) { const int n = rho >> 4, i = rho & 15; return 8 * (i >> 2) + 4 * n + (i & 3); }

struct Unit { int pm, pn, kofs; };
struct Gemm { const bf16_t* A; const bf16_t* Bt; int M, N, K, lda, ldb; };

struct StaticOrder {
    int nM, nN, nwg, G, c;
    __host__ __device__ void init(int M, int N, int G_, int c_) { nM = M / BM; nN = N / BM; nwg = nM * nN; G = G_; c = c_; }
    __host__ __device__ bool next(int i, Unit& u) const {
        const long L = (long)i * G + c; if (L >= nwg) return false;
        int wgid = (int)L; { const int q = nwg / NXCD, r = nwg % NXCD, xcd = wgid % NXCD, off = wgid / NXCD; wgid = (xcd < r ? xcd * (q + 1) : r * (q + 1) + (xcd - r) * q) + off; }
        const int nig = WGM * nN, gid = wgid / nig, fm = gid * WGM, gsz = (nM - fm) < WGM ? (nM - fm) : WGM;
        u.pm = fm + ((wgid % nig) % gsz); u.pn = (wgid % nig) / gsz; u.kofs = 0; return true;
    }
    __device__ __forceinline__ void a_ready(const Unit&) const {}
    __device__ __forceinline__ void done(const Unit&) const {}
};
struct CountedOrder : StaticOrder {
    const unsigned* ready; unsigned need; unsigned* tmo;
    __device__ __forceinline__ void a_ready(const Unit& u) const {
        if (threadIdx.x < 64) {
            const unsigned long long t0 = __builtin_amdgcn_s_memrealtime(); unsigned polls = 0;
            while ((unsigned)__builtin_amdgcn_readfirstlane(__hip_atomic_load(ready + 64 * u.pm, __ATOMIC_RELAXED, __HIP_MEMORY_SCOPE_AGENT)) < need) {
                if ((++polls & 255u) == 0u && __builtin_amdgcn_readfirstlane(__hip_atomic_load(tmo, __ATOMIC_RELAXED, __HIP_MEMORY_SCOPE_AGENT)) != 0u) break;
                if (__builtin_amdgcn_s_memrealtime() - t0 > 2000000ull) {
                    if (threadIdx.x == 0) { unsigned expect = 0u; __hip_atomic_compare_exchange_strong(tmo + 1, &expect, 0x600u | (unsigned)(u.pm & 0xff), __ATOMIC_RELAXED, __ATOMIC_RELAXED, __HIP_MEMORY_SCOPE_AGENT); __hip_atomic_store(tmo, 1u, __ATOMIC_RELAXED, __HIP_MEMORY_SCOPE_AGENT); }
                    break; }
                __builtin_amdgcn_s_sleep(2); }
            __builtin_amdgcn_fence(__ATOMIC_ACQUIRE, "agent");
            asm volatile("s_waitcnt vmcnt(0)" ::: "memory");
        }
#if !defined(BROKEN_HOOK_NO_BARRIER)
        asm volatile("" ::: "memory"); __builtin_amdgcn_s_barrier(); asm volatile("" ::: "memory");
#endif
    }
};

__device__ __forceinline__ unsigned cvt_pk_bf16(float lo, float hi) { unsigned r; asm volatile("v_cvt_pk_bf16_f32 %0, %1, %2" : "=v"(r) : "v"(lo), "v"(hi)); return r; }
typedef float f32x2 __attribute__((ext_vector_type(2)));
__device__ __forceinline__ f32x2 gelu_pk(f32x2 v) {
    const f32x2 av = __builtin_elementwise_abs(v), d = av * 0.2316418882f + 1.0f;
    f32x2 t; t.x = __builtin_amdgcn_rcpf(d.x); t.y = __builtin_amdgcn_rcpf(d.y);
    f32x2 q = t * 0.5307027145f + (-0.7265760135f); q = q * t + 0.7107068705f; q = q * t + (-0.142248368f); q = q * t + 0.127414796f; q = q * t;
    const f32x2 s = (v * v) * (-0.72134752044f);
    f32x2 e; e.x = __builtin_amdgcn_exp2f(s.x); e.y = __builtin_amdgcn_exp2f(s.y);
    const f32x2 m = v * (q * e), r = v - m;
    f32x2 o; o.x = v.x < 0.f ? m.x : r.x; o.y = v.y < 0.f ? m.y : r.y; return o;
}

struct EpiF32 {
    static constexpr bool PERM = false, AFTER_DRAIN = false;
    float* C; int ldc; const float* bias;
    __device__ __forceinline__ void operator()(const f32x4 (&acc)[2][2][4][2], const Unit& u, int wr, int wc, int fr_, int fq_) const {
        const int tl_ = opaque_tid(), fr = tl_ & 15, fq = (tl_ >> 4) & 3; (void)fr_; (void)fq_;
        const int row0 = u.pm * BM + wr * 64 + fr, col0 = u.pn * BM + wc * 32 + 4 * fq;
        f32x4 bv[2][2];
#pragma unroll
        for (int bj = 0; bj < 2; ++bj)
#pragma unroll
            for (int n = 0; n < 2; ++n) bv[bj][n] = bias ? *(const f32x4*)(bias + col0 + bj * HALF + n * 16) : (f32x4){0.f, 0.f, 0.f, 0.f};
#pragma unroll
        for (int ai = 0; ai < 2; ++ai)
#pragma unroll
            for (int m = 0; m < 4; ++m) { float* rowp = C + (size_t)(row0 + ai * HALF + m * 16) * ldc + col0;
#pragma unroll
                for (int bj = 0; bj < 2; ++bj)
#pragma unroll
                    for (int n = 0; n < 2; ++n) *(f32x4*)(rowp + bj * HALF + n * 16) = acc[ai][bj][m][n] + bv[bj][n]; }
    }
};
template <int ACT  > struct EpiBf16 {
    static constexpr bool PERM = true, AFTER_DRAIN = false;
    bf16_t* O; int ldc; const float* bias; int split_cols; size_t split_stride;
    __device__ __forceinline__ void operator()(const f32x4 (&acc)[2][2][4][2], const Unit& u, int wr, int wc, int fr_, int fq_) const {
        const int tl_ = opaque_tid(), fr = tl_ & 15, fq = (tl_ >> 4) & 3; (void)fr_; (void)fq_;
        const int row0 = u.pm * BM + wr * 64 + fr; int colt = u.pn * BM; bf16_t* base = O;
        if (split_cols) { const int t = colt / split_cols; base += (size_t)t * split_stride; colt -= t * split_cols; }
        const int col0 = colt + wc * 32 + 8 * fq, bcol0 = u.pn * BM + wc * 32 + 8 * fq;
        f32x4 bv[2][2];
#pragma unroll
        for (int bj = 0; bj < 2; ++bj)
#pragma unroll
            for (int n = 0; n < 2; ++n) bv[bj][n] = bias ? *(const f32x4*)(bias + bcol0 + bj * HALF + 4 * n) : (f32x4){0.f, 0.f, 0.f, 0.f};
#pragma unroll
        for (int ai = 0; ai < 2; ++ai)
#pragma unroll
            for (int m = 0; m < 4; ++m) { bf16_t* rowp = base + (size_t)(row0 + ai * HALF + m * 16) * ldc + col0;
#pragma unroll
                for (int bj = 0; bj < 2; ++bj) { f32x4 v0 = acc[ai][bj][m][0] + bv[bj][0], v1 = acc[ai][bj][m][1] + bv[bj][1];
                    if (ACT == 1) { f32x2 a = gelu_pk((f32x2){v0[0], v0[1]}), b = gelu_pk((f32x2){v0[2], v0[3]}), c = gelu_pk((f32x2){v1[0], v1[1]}), d = gelu_pk((f32x2){v1[2], v1[3]});
                        v0 = (f32x4){a.x, a.y, b.x, b.y}; v1 = (f32x4){c.x, c.y, d.x, d.y}; }
                    if (ACT == 2) {
#pragma unroll
                        for (int j = 0; j < 4; ++j) { v0[j] = 0.5f * v0[j] * (1.0f + erff(v0[j] * 0.70710678f)); v1[j] = 0.5f * v1[j] * (1.0f + erff(v1[j] * 0.70710678f)); } }
                    u32x4 w; w.x = cvt_pk_bf16(v0[0], v0[1]); w.y = cvt_pk_bf16(v0[2], v0[3]); w.z = cvt_pk_bf16(v1[0], v1[1]); w.w = cvt_pk_bf16(v1[2], v1[3]);
                    *(u32x4*)(rowp + bj * HALF) = w; } }
    }
};

template <class Epi, class Sched, bool STAMP = false>
__device__ __forceinline__ void gemm_phase(PG8_LAS unsigned char* lds, const Gemm g, const Sched& S, const Epi& E, unsigned long long* stamps) {
    const int tid = opaque_tid(), wid = __builtin_amdgcn_readfirstlane(tid >> 6), lane = tid & 63, wr = wid >> 2, wc = wid & 3, fr = lane & 15, fq = lane >> 4;
    const int K = g.K, nt = K / BK, lda = g.lda, ldb = g.ldb;
    int ts_lo = 0, ts_hi = 0, nts = 0; const unsigned long long rt_entry = STAMP ? (unsigned long long)wall_clock64() : 0ull;
#define PG8_STAMP() do { if (STAMP && wid == 0 && nts < 64) { const unsigned long long _c = (unsigned long long)clock64(); \
        ts_lo = (lane == nts) ? (int)(unsigned)_c : ts_lo; ts_hi = (lane == nts) ? (int)(unsigned)(_c >> 32) : ts_hi; ++nts; } } while (0)
    PG8_STAMP();
    unsigned voffA[2], voffB[2];
#pragma unroll
    for (int i = 0; i < 2; ++i) { int R, C; stage_rc(tid * 16 + i * 8192, R, C); const int Rb = Epi::PERM ? ((R & ~31) + perm32(R & 31)) : R;
        voffA[i] = (unsigned)(R * lda + C) * 2u; voffB[i] = (unsigned)(Rb * ldb + C) * 2u; }
    const size_t kstep = (size_t)(BK * 2);
    const size_t hstep = (size_t)HALF * ldb * 2;
    const size_t tstep = 2 * hstep; const size_t hstepA = (size_t)HALF * lda * 2, tstepA = 2 * hstepA;
    const unsigned ldsw = (unsigned)wid * 1024u;
    const int aoff = lds_byte(wr * 64 + fr, fq * 8), boff = lds_byte(wc * 32 + fr, fq * 8);
#define PG8_SA(b, h) (((b) * 2 + (h)) * HTB)
#define PG8_SB(b, h) ((4 + (b) * 2 + (h)) * HTB)
#define PG8_STAGE(bufoff, gbase, voff) do { _Pragma("unroll") for (int _i = 0; _i < 2; ++_i) \
        __builtin_amdgcn_global_load_lds((const unsigned*)((const char*)(gbase) + (voff)[_i]), (PG8_LAS unsigned*)(lds + (bufoff) + ldsw + _i * 8192), 16, 0, 0); } while (0)
#define PG8_LDA(dst, b, h) do { _Pragma("unroll") for (int m = 0; m < 4; ++m) _Pragma("unroll") for (int k = 0; k < 2; ++k) dst[m][k] = *(const PG8_LAS bf16x8*)(lds + PG8_SA(b, h) + aoff + m * 2048 + k * 1024); } while (0)
#define PG8_LDB(dst, b, h) do { _Pragma("unroll") for (int n = 0; n < 2; ++n) _Pragma("unroll") for (int k = 0; k < 2; ++k) dst[n][k] = *(const PG8_LAS bf16x8*)(lds + PG8_SB(b, h) + boff + n * 2048 + k * 1024); } while (0)
#define PG8_MMA(ai, bj, At, Bt) do { __builtin_amdgcn_s_setprio(1); _Pragma("unroll") for (int m = 0; m < 4; ++m) _Pragma("unroll") for (int n = 0; n < 2; ++n) _Pragma("unroll") for (int k = 0; k < 2; ++k) \
        acc[ai][bj][m][n] = __builtin_amdgcn_mfma_f32_16x16x32_bf16(Bt[n][k], At[m][k], acc[ai][bj][m][n], 0, 0, 0); __builtin_amdgcn_s_setprio(0); } while (0)
#define PG8_WAIT_V(n) asm volatile("s_waitcnt vmcnt(" #n ")" ::: "memory")
#define PG8_WAIT_L(n) asm volatile("s_waitcnt lgkmcnt(" #n ")" ::: "memory")
#define PG8_BAR __builtin_amdgcn_s_barrier()
#define PG8_SCHED __builtin_amdgcn_sched_barrier(0)
    Unit cur, nxt; int ui = 0;
    if (!S.next(0, cur)) return;
    f32x4 acc[2][2][4][2];
#pragma unroll
    for (int a = 0; a < 2; ++a)
#pragma unroll
        for (int b = 0; b < 2; ++b)
#pragma unroll
            for (int m = 0; m < 4; ++m)
#pragma unroll
                for (int n = 0; n < 2; ++n) acc[a][b][m][n] = (f32x4){0.f, 0.f, 0.f, 0.f};
    bf16x8 At[4][2], B0[2][2], B1[2][2];
    const char* cA = (const char*)g.A + (size_t)cur.pm * tstepA + (size_t)cur.kofs * 2; const char* cB = (const char*)g.Bt + (size_t)cur.pn * tstep + (size_t)cur.kofs * 2;
    S.a_ready(cur);
    PG8_STAGE(PG8_SB(0, 0), cB, voffB); PG8_STAGE(PG8_SA(0, 0), cA, voffA); PG8_STAGE(PG8_SB(0, 1), cB + hstep, voffB); PG8_STAGE(PG8_SA(0, 1), cA + hstepA, voffA);
    if (wr == 1) PG8_BAR;
    PG8_WAIT_V(4); PG8_BAR;
    PG8_STAGE(PG8_SB(1, 0), cB + kstep, voffB); PG8_STAGE(PG8_SA(1, 0), cA + kstep, voffA); PG8_STAGE(PG8_SB(1, 1), cB + hstep + kstep, voffB);
    PG8_WAIT_V(6); PG8_BAR;
    PG8_STAMP();
    for (;;) {
        const bool has_next = S.next(ui + 1, nxt);
        const char* nA = has_next ? (const char*)g.A + (size_t)nxt.pm * tstepA + (size_t)nxt.kofs * 2 : cA; const char* nB = has_next ? (const char*)g.Bt + (size_t)nxt.pn * tstep + (size_t)nxt.kofs * 2 : cB;
        for (int t = 0; t < nt; t += 2) {
            const bool last = (t == nt - 2);
            const char* a1 = cA + (size_t)(t + 1) * kstep;
            const char* a2 = last ? nA : cA + (size_t)(t + 2) * kstep; const char* b2 = last ? nB : cB + (size_t)(t + 2) * kstep;
            const char* a3 = a2 + kstep; const char* b3 = b2 + kstep;
            if (last && has_next) S.a_ready(nxt);
            PG8_LDB(B0, 0, 0); PG8_SCHED; PG8_LDA(At, 0, 0); PG8_STAGE(PG8_SA(1, 1), a1 + hstepA, voffA);
            PG8_WAIT_L(8); PG8_BAR; PG8_WAIT_L(0); PG8_MMA(0, 0, At, B0); PG8_BAR; PG8_SCHED;
            PG8_LDB(B1, 0, 1); PG8_STAGE(PG8_SB(0, 0), b2, voffB);
            PG8_BAR; PG8_WAIT_L(0); PG8_MMA(0, 1, At, B1); PG8_BAR;
            PG8_LDA(At, 0, 1); PG8_STAGE(PG8_SA(0, 0), a2, voffA);
            PG8_BAR; PG8_WAIT_L(0); PG8_MMA(1, 0, At, B0); PG8_BAR; PG8_SCHED;
            PG8_STAGE(PG8_SB(0, 1), b2 + hstep, voffB);
            PG8_WAIT_V(6); PG8_BAR; PG8_MMA(1, 1, At, B1); PG8_BAR;
            PG8_LDB(B0, 1, 0); PG8_SCHED; PG8_LDA(At, 1, 0); PG8_STAGE(PG8_SA(0, 1), a2 + hstepA, voffA);
            PG8_WAIT_L(8); PG8_BAR; PG8_WAIT_L(0); PG8_MMA(0, 0, At, B0); PG8_BAR; PG8_SCHED;
            PG8_LDB(B1, 1, 1); PG8_STAGE(PG8_SB(1, 0), b3, voffB);
            PG8_BAR; PG8_WAIT_L(0); PG8_MMA(0, 1, At, B1); PG8_BAR;
            PG8_LDA(At, 1, 1); PG8_STAGE(PG8_SA(1, 0), a3, voffA);
            PG8_BAR; PG8_WAIT_L(0); PG8_MMA(1, 0, At, B0); PG8_BAR; PG8_SCHED;
            PG8_STAGE(PG8_SB(1, 1), b3 + hstep, voffB);
            PG8_WAIT_V(6); PG8_BAR; PG8_MMA(1, 1, At, B1); PG8_BAR;
        }
        PG8_STAMP();
        if constexpr (!Epi::AFTER_DRAIN) { E(acc, cur, wr, wc, fr, fq); S.done(cur); }
        PG8_STAMP();
        if (!has_next) break;
#pragma unroll
        for (int a = 0; a < 2; ++a)
#pragma unroll
            for (int b = 0; b < 2; ++b)
#pragma unroll
                for (int m = 0; m < 4; ++m)
#pragma unroll
                    for (int n = 0; n < 2; ++n) acc[a][b][m][n] = (f32x4){0.f, 0.f, 0.f, 0.f};
        cur = nxt; cA = nA; cB = nB; ++ui;
    }
    PG8_WAIT_V(0);
    if (wr == 0) PG8_BAR;
    PG8_BAR;
    if constexpr (Epi::AFTER_DRAIN) { E.fused(acc, cur, wr, wc, fr, fq, lds, wid, lane); S.done(cur); }
    PG8_STAMP();
    if (STAMP && wid == 0) { stamps[lane] = lane < nts ? (((unsigned long long)(unsigned)ts_hi << 32) | (unsigned)ts_lo) : 0ull;
        if (lane == 62) stamps[62] = rt_entry; if (lane == 63) stamps[63] = (unsigned long long)wall_clock64(); }
#undef PG8_STAMP
#undef PG8_SA
#undef PG8_SB
#undef PG8_STAGE
#undef PG8_LDA
#undef PG8_LDB
#undef PG8_MMA
#undef PG8_WAIT_V
#undef PG8_WAIT_L
#undef PG8_BAR
#undef PG8_SCHED
}
}

#define XB_TMO      128
#define XB_XCNT(j)  (256  + 64 * (j))
#define XB_XSUB(j)  (1280 + 64 * (j))
#define XB_XGEN(j)  (2304 + 64 * (j))
#define XB_TOP      3328
#define XB_TOPGEN   3392
#define XCD_BAR_WORDS 3456
#define XB_SPIN_CAP (1u << 18)
#define LAS __attribute__((address_space(3)))

__device__ __forceinline__ unsigned xb_ld(unsigned* p)              { return __hip_atomic_load(p, __ATOMIC_RELAXED, __HIP_MEMORY_SCOPE_AGENT); }
__device__ __forceinline__ unsigned xb_add(unsigned* p, unsigned v) { return __hip_atomic_fetch_add(p, v, __ATOMIC_RELAXED, __HIP_MEMORY_SCOPE_AGENT); }
__device__ __forceinline__ unsigned xb_xcc_id() { return (unsigned)__builtin_amdgcn_s_getreg((3 << 11) | 20) & 0xFu; }
#define XB_SPIN(cond, bar) do { unsigned _sp = 0; while (cond) { __builtin_amdgcn_s_sleep(1); \
    if ((++_sp & 255u) == 0u) { if (xb_ld(&(bar)[XB_TMO])) break; if (_sp > XB_SPIN_CAP) { atomicAdd(&(bar)[XB_TMO], 1u); break; } } } } while (0)

struct XcdBarrier {
    unsigned* bar; unsigned x;
    volatile LAS unsigned* st;
};

__device__ __forceinline__ XcdBarrier xcd_barrier_post(unsigned* bar, volatile LAS unsigned* st) {
    XcdBarrier b; b.bar = bar; b.x = xb_xcc_id(); b.st = st;
    if (threadIdx.x == 0) (void)xb_add(&bar[XB_XCNT(b.x)], 1u);
    return b;
}
__device__ __forceinline__ void xcd_barrier_complete(unsigned* bar, unsigned x, unsigned& nloc, unsigned& nx) {
    const unsigned G = gridDim.x * gridDim.y * gridDim.z;
    unsigned sum, cnt, mine, sp = 0u;
    for (;;) {
        sum = 0u; cnt = 0u; mine = 0u;
#pragma unroll
        for (unsigned j = 0; j < 16; ++j) { const unsigned c = xb_ld(&bar[XB_XCNT(j)]); sum += c; cnt += (c > 0u) ? 1u : 0u; mine = (j == x) ? c : mine; }
        if (sum == G) break;
        __builtin_amdgcn_s_sleep(1);
        if ((++sp & 255u) == 0u) { if (xb_ld(&bar[XB_TMO])) break; if (sp > XB_SPIN_CAP) { atomicAdd(&bar[XB_TMO], 1u); break; } }
    }
    nloc = mine > 0u ? mine : 1u; nx = cnt > 0u ? cnt : 1u;
}

__device__ __forceinline__ void xcd_barrier(const XcdBarrier& b) {
    asm volatile("s_waitcnt vmcnt(0)" ::: "memory");
    __syncthreads();
    if (threadIdx.x == 0) {
        unsigned* bar = b.bar;
        __builtin_amdgcn_s_waitcnt(0);
        unsigned nloc = b.st[0], nx = b.st[1];
        if (nloc == 0u) { xcd_barrier_complete(bar, b.x, nloc, nx); b.st[0] = nloc; b.st[1] = nx; }
        const unsigned old = xb_add(&bar[XB_XSUB(b.x)], 1u);
        const unsigned gen = old / nloc;
        if (old + 1u == (gen + 1u) * nloc) {
            __builtin_amdgcn_fence(__ATOMIC_RELEASE, "agent");
            asm volatile("s_waitcnt vmcnt(0)" ::: "memory");
            const unsigned og = xb_add(&bar[XB_TOP], 1u);
            const unsigned tg = og / nx;
            if (og + 1u == (tg + 1u) * nx) xb_add(&bar[XB_TOPGEN], 1u);
            else XB_SPIN(xb_ld(&bar[XB_TOPGEN]) == tg, bar);
            __builtin_amdgcn_fence(__ATOMIC_ACQUIRE, "agent");
            xb_add(&bar[XB_XGEN(b.x)], 1u);
            asm volatile("s_waitcnt vmcnt(0)" ::: "memory");
        } else {
            XB_SPIN(xb_ld(&bar[XB_XGEN(b.x)]) == gen, bar);
            __builtin_amdgcn_fence(__ATOMIC_ACQUIRE, "agent");
            asm volatile("s_waitcnt vmcnt(0)" ::: "memory");
        }
    }
    __syncthreads();
}

namespace mk {
using pg8::bf16_t; using pg8::bf16x8; using pg8::f32x4; using pg8::u32x4; using pg8::Unit; using pg8::cvt_pk_bf16;
typedef float f32x16 __attribute__((ext_vector_type(16)));
typedef short s16x4 __attribute__((ext_vector_type(4)));
typedef unsigned u32x2 __attribute__((ext_vector_type(2)));

constexpr int NTOK = 33024, NP = 32768, DM = 1024, SEQ = 16384, DFF = 2816;
constexpr float EPS = 1e-6f;
constexpr int NPHASE = 26;
constexpr int LDS_MAIN = 141312, LDS_TOTAL = LDS_MAIN + 16;
constexpr size_t OUT_RETP = 33816576, OUT_RETS = 35913728, OUT_POOLP = 52690944, OUT_POOLS = 52752384;
constexpr size_t WS_WRI = 0, WS_WRO = 12582912, WS_WPL = 16777216, WS_WFI = 18874368, WS_WFO = 30408704, WS_XB = 36175872,
                 WS_QKV = 103809024, WS_T = 374341632, WS_COS = 441450496, WS_SIN = 449839104, WS_RSS = 458227712, WS_GSS = 477249536, WS_BAR = 494157824, WS_END = 494174208;

struct Params {
    const float *x_prompt, *x_sample, *state_ret, *state_pool, *norm_mix, *w_ret_in, *w_ret_out, *w_pool, *pool_scale, *norm_ffn, *w_ffn_in, *w_ffn_out, *norm_final;
    float* out; unsigned char* ws; int ph_lo, ph_hi;
};

__device__ __forceinline__ float lg2gamma(int h) { return h == 0 ? -0.04580368961312479f : h == 1 ? -0.02272007650008353f : h == 2 ? -0.011315313227834146f : -0.005646563141142063f; }
__device__ __forceinline__ float sum16(const float* p) {
    const float4 a = *(const float4*)p, b = *(const float4*)(p + 4), c = *(const float4*)(p + 8), d = *(const float4*)(p + 12);
    return (((a.x + a.y) + (a.z + a.w)) + ((b.x + b.y) + (b.z + b.w))) + (((c.x + c.y) + (c.z + c.w)) + ((d.x + d.y) + (d.z + d.w)));
}
__device__ __forceinline__ float rs_row(const float* rssrow) { return __builtin_amdgcn_rsqf(sum16(rssrow) * (1.0f / 1024.0f) + EPS); }
__device__ __forceinline__ float silu_f(float v) { return v * __builtin_amdgcn_rcpf(1.0f + __builtin_amdgcn_exp2f(v * -1.4426950408889634f)); }
__device__ __forceinline__ bf16_t f2bf(float f) { unsigned u = __float_as_uint(f); u += 0x7FFFu + ((u >> 16) & 1u); return (bf16_t)(u >> 16); }
__device__ __forceinline__ float bf2f(unsigned short b) { return __uint_as_float(((unsigned)b) << 16); }

__device__ __forceinline__ void row_scales(float (&r)[8], const float* rss, int row0, int fq) {
    float4 q[8];
#pragma unroll
    for (int i = 0; i < 8; ++i) q[i] = *(const float4*)(rss + (size_t)(row0 + (i >> 2) * 128 + (i & 3) * 16) * 16 + fq * 4);
#pragma unroll
    for (int i = 0; i < 8; ++i) { float t = (q[i].x + q[i].y) + (q[i].z + q[i].w); t += __shfl_xor(t, 16); t += __shfl_xor(t, 32); r[i] = __builtin_amdgcn_rsqf(t * (1.0f / 1024.0f) + EPS); }
}
struct EpiQKV {
    static constexpr bool PERM = true, AFTER_DRAIN = false;
    bf16_t* O; const float* rss; const float* cosT; const float* sinT;
    __device__ __forceinline__ void operator()(const f32x4 (&acc)[2][2][4][2], const Unit& u, int wr, int wc, int fr_, int fq_) const {
        const int tl_ = opaque_tid(), fr = tl_ & 15, fq = (tl_ >> 4) & 3; (void)fr_; (void)fq_;
        const int row0 = u.pm * 256 + wr * 64 + fr, cin = wc * 32 + 8 * fq;
        const bool rot = u.pn < 8; const float lg = lg2gamma(u.pn & 3);
        float rr[8]; row_scales(rr, rss, row0, fq);
        u32x4 wout[8][2];
#pragma unroll
        for (int am = 0; am < 4; ++am) {
            const int ai = am >> 1;
            f32x4 ct[2][2], st[2][2];
            if (rot) {
#pragma unroll
                for (int mm = 0; mm < 2; ++mm) {
                    const int row = row0 + ai * 128 + ((am & 1) * 2 + mm) * 16; const int pos = (row < NP) ? (row & (SEQ - 1)) : 1024 + ((row - NP) & 15);
#pragma unroll
                    for (int n = 0; n < 2; ++n) { ct[mm][n] = *(const f32x4*)(cosT + (size_t)pos * 128 + cin + 4 * n); st[mm][n] = *(const f32x4*)(sinT + (size_t)pos * 128 + cin + 4 * n); }
                }
            }
#pragma unroll
            for (int mm = 0; mm < 2; ++mm) {
                const int m = (am & 1) * 2 + mm;
                const int row = row0 + ai * 128 + m * 16;
                const float r = rr[ai * 4 + m];
                int l, Lc;
                if (row < NP) { l = row & 63; Lc = 64; } else { l = (row - NP) & 15; Lc = 16; }
                f32x4 o1[2], o2[2];
                if (rot) {
                    const float e = (u.pn < 4) ? (float)(l + 1) : (float)(Lc - 1 - l);
                    const float dec = exp2f(e * lg) * r;
#pragma unroll
                    for (int n = 0; n < 2; ++n) {
                        const f32x4 c4 = ct[mm][n], s4 = st[mm][n];
                        const f32x4 x1 = acc[ai][0][m][n] * dec, x2 = acc[ai][1][m][n] * dec;
                        o1[n] = x1 * c4 - x2 * s4; o2[n] = x1 * s4 + x2 * c4;
                    }
                } else {
#pragma unroll
                    for (int n = 0; n < 2; ++n) { o1[n] = acc[ai][0][m][n] * r; o2[n] = acc[ai][1][m][n] * r; }
                }
                u32x4 w; w.x = cvt_pk_bf16(o1[0][0], o1[0][1]); w.y = cvt_pk_bf16(o1[0][2], o1[0][3]); w.z = cvt_pk_bf16(o1[1][0], o1[1][1]); w.w = cvt_pk_bf16(o1[1][2], o1[1][3]);
                wout[ai * 4 + m][0] = w;
                w.x = cvt_pk_bf16(o2[0][0], o2[0][1]); w.y = cvt_pk_bf16(o2[0][2], o2[0][3]); w.z = cvt_pk_bf16(o2[1][0], o2[1][1]); w.w = cvt_pk_bf16(o2[1][2], o2[1][3]);
                wout[ai * 4 + m][1] = w;
            }
        }
#pragma unroll
        for (int i = 0; i < 8; ++i) {
            bf16_t* rowp = O + (size_t)(row0 + (i >> 2) * 128 + (i & 3) * 16) * 4096 + u.pn * 256 + cin;
            *(u32x4*)rowp = wout[i][0]; *(u32x4*)(rowp + 128) = wout[i][1];
        }
    }
};
struct EpiGate {
    static constexpr bool PERM = true, AFTER_DRAIN = false;
    bf16_t* QKV; const float* rss; const float* gss;
    __device__ __forceinline__ void operator()(const f32x4 (&acc)[2][2][4][2], const Unit& u, int wr, int wc, int fr_, int fq_) const {
        const int tl_ = opaque_tid(), fr = tl_ & 15, fq = (tl_ >> 4) & 3; (void)fr_; (void)fq_;
        const int row0 = u.pm * 256 + wr * 64 + fr, cin = wc * 32 + 8 * fq, head = u.pn >> 1;
        float rr[8]; row_scales(rr, rss, row0, fq);
        u32x4 wout[8][2];
#pragma unroll
        for (int ai = 0; ai < 2; ++ai) {
            u32x4 ovs[4][2]; float2 gps[4];
#pragma unroll
            for (int i = 0; i < 4; ++i) {
                const int row = row0 + ai * 128 + i * 16; const bf16_t* rp = QKV + (size_t)row * 4096 + 2048 + u.pn * 256 + cin;
                ovs[i][0] = *(const u32x4*)rp; ovs[i][1] = *(const u32x4*)(rp + 128); gps[i] = *(const float2*)(gss + ((size_t)row * 4 + head) * 2);
            }
#pragma unroll
            for (int m = 0; m < 4; ++m) {
                const float r = rr[ai * 4 + m];
                const float rn = __builtin_amdgcn_rsqf((gps[m].x + gps[m].y) * (1.0f / 512.0f) + EPS);
#pragma unroll
                for (int bj = 0; bj < 2; ++bj) {
                    const u32x4 ov = ovs[m][bj];
                    float g[8], o[8];
#pragma unroll
                    for (int j = 0; j < 4; ++j) { g[j] = acc[ai][bj][m][0][j] * r; g[4 + j] = acc[ai][bj][m][1][j] * r; }
                    o[0] = __uint_as_float(ov.x << 16); o[1] = __uint_as_float(ov.x & 0xffff0000u); o[2] = __uint_as_float(ov.y << 16); o[3] = __uint_as_float(ov.y & 0xffff0000u);
                    o[4] = __uint_as_float(ov.z << 16); o[5] = __uint_as_float(ov.z & 0xffff0000u); o[6] = __uint_as_float(ov.w << 16); o[7] = __uint_as_float(ov.w & 0xffff0000u);
                    float y[8];
#pragma unroll
                    for (int j = 0; j < 8; ++j) y[j] = silu_f(g[j]) * o[j] * rn;
                    u32x4 w; w.x = cvt_pk_bf16(y[0], y[1]); w.y = cvt_pk_bf16(y[2], y[3]); w.z = cvt_pk_bf16(y[4], y[5]); w.w = cvt_pk_bf16(y[6], y[7]);
                    wout[ai * 4 + m][bj] = w;
                }
            }
        }
#pragma unroll
        for (int i = 0; i < 8; ++i) {
            bf16_t* rowp = QKV + (size_t)(row0 + (i >> 2) * 128 + (i & 3) * 16) * 4096 + 2048 + u.pn * 256 + cin;
            *(u32x4*)rowp = wout[i][0]; *(u32x4*)(rowp + 128) = wout[i][1];
        }
    }
};
struct EpiFfn {
    static constexpr bool PERM = true, AFTER_DRAIN = false;
    bf16_t* ACT; const float* rss;
    __device__ __forceinline__ void operator()(const f32x4 (&acc)[2][2][4][2], const Unit& u, int wr, int wc, int fr_, int fq_) const {
        const int tl_ = opaque_tid(), fr = tl_ & 15, fq = (tl_ >> 4) & 3; (void)fr_; (void)fq_;
        const int row0 = u.pm * 256 + wr * 64 + fr, cout = u.pn * 128 + wc * 32 + 8 * fq;
        float rr[8]; row_scales(rr, rss, row0, fq);
#pragma unroll
        for (int ai = 0; ai < 2; ++ai)
#pragma unroll
            for (int m = 0; m < 4; ++m) {
                const int row = row0 + ai * 128 + m * 16;
                const float r = rr[ai * 4 + m];
                const f32x4 a0 = acc[ai][0][m][0] * r, a1 = acc[ai][0][m][1] * r, b0 = acc[ai][1][m][0] * r, b1 = acc[ai][1][m][1] * r;
                u32x4 w; w.x = cvt_pk_bf16(silu_f(a0[0]) * b0[0], silu_f(a0[1]) * b0[1]); w.y = cvt_pk_bf16(silu_f(a0[2]) * b0[2], silu_f(a0[3]) * b0[3]);
                w.z = cvt_pk_bf16(silu_f(a1[0]) * b1[0], silu_f(a1[1]) * b1[1]); w.w = cvt_pk_bf16(silu_f(a1[2]) * b1[2], silu_f(a1[3]) * b1[3]);
                *(u32x4*)(ACT + (size_t)row * DFF + cout) = w;
            }
    }
};
struct EpiRes {
    static constexpr bool PERM = true, AFTER_DRAIN = false;
    const float* base_p; const float* base_s; float* xres; bf16_t* xb; float* rss_next;
    __device__ __forceinline__ void operator()(const f32x4 (&acc)[2][2][4][2], const Unit& u, int wr, int wc, int fr_, int fq_) const {
        const int tl_ = opaque_tid(), fr = tl_ & 15, fq = (tl_ >> 4) & 3; (void)fr_; (void)fq_;
        const int row0 = u.pm * 256 + wr * 64 + fr, col0 = u.pn * 256 + wc * 32 + 8 * fq;
#pragma unroll
        for (int ai = 0; ai < 2; ++ai) {
            f32x4 bv[4][4];
#pragma unroll
            for (int m = 0; m < 4; ++m) {
                const int row = row0 + ai * 128 + m * 16;
                const float* bp = (row < NP) ? base_p + (size_t)row * DM : base_s + (size_t)(row - NP) * DM;
#pragma unroll
                for (int q = 0; q < 4; ++q) bv[m][q] = *(const f32x4*)(bp + col0 + (q >> 1) * 128 + (q & 1) * 4);
            }
#pragma unroll
            for (int m = 0; m < 4; ++m) {
                const int row = row0 + ai * 128 + m * 16;
                float ss = 0.f;
#pragma unroll
                for (int bj = 0; bj < 2; ++bj) {
                    const int c = col0 + bj * 128;
                    const f32x4 v0 = bv[m][bj * 2 + 0] + acc[ai][bj][m][0], v1 = bv[m][bj * 2 + 1] + acc[ai][bj][m][1];
                    *(f32x4*)(xres + (size_t)row * DM + c) = v0; *(f32x4*)(xres + (size_t)row * DM + c + 4) = v1;
                    if (xb) { u32x4 w; w.x = cvt_pk_bf16(v0[0], v0[1]); w.y = cvt_pk_bf16(v0[2], v0[3]); w.z = cvt_pk_bf16(v1[0], v1[1]); w.w = cvt_pk_bf16(v1[2], v1[3]); *(u32x4*)(xb + (size_t)row * DM + c) = w; }
                    ss += ((v0[0] * v0[0] + v0[1] * v0[1]) + (v0[2] * v0[2] + v0[3] * v0[3])) + ((v1[0] * v1[0] + v1[1] * v1[1]) + (v1[2] * v1[2] + v1[3] * v1[3]));
                }
                ss += __shfl_xor(ss, 16); ss += __shfl_xor(ss, 32);
                if (fq == 0) rss_next[(size_t)row * 16 + u.pn * 4 + wc] = ss;
            }
        }
    }
};

struct MapId { __device__ __forceinline__ float scale(int) const { return 1.f; } __device__ __forceinline__ int drow(int n) const { return n; } };
struct MapRetIn { __device__ __forceinline__ float scale(int n) const { return (n >= 1024 && n < 2048) ? 0.0625f : 1.f; } __device__ __forceinline__ int drow(int n) const { return n; } };
struct MapFfnIn { __device__ __forceinline__ float scale(int) const { return 1.f; }
    __device__ __forceinline__ int drow(int n) const { const int isb = n >= DFF, j = n - isb * DFF; return (j >> 7) * 256 + isb * 128 + (j & 127); } };
struct MapPool { const float* cs; __device__ __forceinline__ float scale(int n) const { return cs[n]; } __device__ __forceinline__ int drow(int n) const { return n; } };

template <class MapF>
__device__ __forceinline__ void conv_T(LAS unsigned char* lds, const float* src, int K, int Nsrc, int ldsrc, bf16_t* dst, int lddst, const float* gain, const MapF map) {
    const int tid = opaque_tid(), tk = K >> 6, tn = Nsrc >> 8, ntile = tk * tn;
    LAS bf16_t* tile = (LAS bf16_t*)lds;
    for (int t = blockIdx.x; t < ntile; t += gridDim.x) {
        const int k0 = (t % tk) << 6, n0 = (t / tk) << 8;
        {
            const int kk = tid >> 3, nn = (tid & 7) * 8; const float* sp = src + (size_t)(k0 + kk) * ldsrc + n0 + nn;
            const float gk = gain ? gain[k0 + kk] : 1.f;
            float4 a[4], b[4];
#pragma unroll
            for (int q = 0; q < 4; ++q) { a[q] = *(const float4*)(sp + q * 64); b[q] = *(const float4*)(sp + q * 64 + 4); }
#pragma unroll
            for (int q = 0; q < 4; ++q) {
                const int nb = q * 64 + nn; LAS bf16_t* tp = tile + nb * 72 + kk;
                tp[0 * 72] = f2bf(a[q].x * gk * map.scale(n0 + nb + 0)); tp[1 * 72] = f2bf(a[q].y * gk * map.scale(n0 + nb + 1));
                tp[2 * 72] = f2bf(a[q].z * gk * map.scale(n0 + nb + 2)); tp[3 * 72] = f2bf(a[q].w * gk * map.scale(n0 + nb + 3));
                tp[4 * 72] = f2bf(b[q].x * gk * map.scale(n0 + nb + 4)); tp[5 * 72] = f2bf(b[q].y * gk * map.scale(n0 + nb + 5));
                tp[6 * 72] = f2bf(b[q].z * gk * map.scale(n0 + nb + 6)); tp[7 * 72] = f2bf(b[q].w * gk * map.scale(n0 + nb + 7));
            }
        }
        __syncthreads();
        {
            const int nn = tid >> 3, kc = (tid & 7) * 8;
#pragma unroll
            for (int q = 0; q < 4; ++q) {
                const u32x4 raw = *(const LAS u32x4*)(tile + (q * 64 + nn) * 72 + kc);
                *(u32x4*)(dst + (size_t)map.drow(n0 + q * 64 + nn) * lddst + k0 + kc) = raw;
            }
        }
        __syncthreads();
    }
}
__device__ __forceinline__ void convert_ret(const Params& p, LAS unsigned char* lds, int j) {
    conv_T(lds, p.w_ret_in + (size_t)j * 1024 * 6144, 1024, 6144, 6144, (bf16_t*)(p.ws + WS_WRI), 1024, p.norm_mix + (size_t)(2 * j) * DM, MapRetIn{});
    conv_T(lds, p.w_ret_out + (size_t)j * 2048 * 1024, 2048, 1024, 1024, (bf16_t*)(p.ws + WS_WRO), 2048, nullptr, MapId{});
}
__device__ __forceinline__ void convert_pool(const Params& p, LAS unsigned char* lds, int j) {
    bf16_t* W = (bf16_t*)(p.ws + WS_WPL);
    for (size_t i = (size_t)blockIdx.x * blockDim.x + opaque_tid(); i < (size_t)1024 * 128; i += (size_t)gridDim.x * blockDim.x) {
        const int n = (int)(i >> 7), k = (int)(i & 127) * 8;
        if ((n >> 8) != (k >> 8)) { unsigned z = 0u; asm volatile("" : "+v"(z)); *(u32x4*)(W + (size_t)n * 1024 + k) = (u32x4){z, z, z, z}; }
    }
    for (int g = 0; g < 4; ++g)
        conv_T(lds, p.w_pool + ((size_t)j * 4 + g) * 65536, 256, 256, 256, W + (size_t)(g * 256) * 1024 + g * 256, 1024, nullptr, MapPool{p.pool_scale + (size_t)j * DM + g * 256});
}
__device__ __forceinline__ void convert_ffn(const Params& p, LAS unsigned char* lds, int i) {
    conv_T(lds, p.w_ffn_in + (size_t)i * 1024 * 5632, 1024, 5632, 5632, (bf16_t*)(p.ws + WS_WFI), 1024, p.norm_ffn + (size_t)i * DM, MapFfnIn{});
    conv_T(lds, p.w_ffn_out + (size_t)i * DFF * 1024, DFF, 1024, 1024, (bf16_t*)(p.ws + WS_WFO), DFF, nullptr, MapId{});
}
__device__ __forceinline__ void convert_mixer(const Params& p, LAS unsigned char* lds, int layer) { if (layer & 1) convert_pool(p, lds, layer >> 1); else convert_ret(p, lds, layer >> 1); }

__device__ __forceinline__ void phase0(const Params& p, LAS unsigned char* lds) {
    const int tid = opaque_tid(), lane = tid & 63, wid = tid >> 6;
    bf16_t* xb = (bf16_t*)(p.ws + WS_XB); float* rss = (float*)(p.ws + WS_RSS);
    for (int row = blockIdx.x * 8 + wid; row < NTOK; row += gridDim.x * 8) {
        const float* src = (row < NP) ? p.x_prompt + (size_t)row * DM : p.x_sample + (size_t)(row - NP) * DM;
        float ss = 0.f;
#pragma unroll
        for (int i = 0; i < 4; ++i) {
            const float4 v = *(const float4*)(src + i * 256 + lane * 4);
            ss += (v.x * v.x + v.y * v.y) + (v.z * v.z + v.w * v.w);
            u32x2 w; w.x = cvt_pk_bf16(v.x, v.y); w.y = cvt_pk_bf16(v.z, v.w);
            *(u32x2*)(xb + (size_t)row * DM + i * 256 + lane * 4) = w;
        }
#pragma unroll
        for (int o = 32; o >= 1; o >>= 1) ss += __shfl_xor(ss, o);
        if (lane < 16) rss[(size_t)row * 16 + lane] = (lane == 0) ? ss : 0.f;
    }
    const size_t gt = (size_t)blockIdx.x * blockDim.x + tid, nth = (size_t)gridDim.x * blockDim.x;
    float* cosT = (float*)(p.ws + WS_COS); float* sinT = (float*)(p.ws + WS_SIN);
    for (size_t i = gt; i < (size_t)SEQ * 128; i += nth) {
        const int pos = (int)(i >> 7), j = (int)(i & 127);
        const double inv = exp2(-(double)j * 0.10381025296523007), t = (double)pos * inv * 0.31830988618379067154;
        double s, c; sincospi(t, &s, &c);
        cosT[i] = (float)c; sinT[i] = (float)s;
    }
    convert_mixer(p, lds, 0); convert_mixer(p, lds, 1); convert_ffn(p, lds, 0);
}

template <int W>
__device__ __forceinline__ void pool_unit(const float* xres, const float* sp, const LAS float* rl, bf16_t* dbuf, float* po, int rowbase, int t0, int c0, float g0, float g1, bool isS, bool lastu) {
    float2 hv[15 + W];
#pragma unroll
    for (int i = 0; i < 15 + W; ++i) {
        const int t = t0 - (W - 1) + i;
        float2 v = make_float2(0.f, 0.f);
        if (t >= 0) { const float2 x = *(const float2*)(xres + (size_t)(rowbase + t) * DM + c0); const float r = rl[i + 16 - W]; v = make_float2(x.x * r * g0, x.y * r * g1); }
        else if (isS) v = *(const float2*)(sp + (size_t)(15 + t) * DM + c0);
        hv[i] = v;
    }
    float2 s = make_float2(0.f, 0.f);
#pragma unroll
    for (int i = 0; i < W - 1; ++i) { s.x += hv[i].x; s.y += hv[i].y; }
#pragma unroll
    for (int k = 0; k < 16; ++k) {
        const float2 h = hv[W - 1 + k];
        s.x += h.x; s.y += h.y;
        const float inv = 1.0f / (isS ? (float)W : (float)min(t0 + k + 1, W));
        *(unsigned*)(dbuf + (size_t)(rowbase + t0 + k) * DM + c0) = cvt_pk_bf16(s.x * inv - h.x, s.y * inv - h.y);
        if (lastu && k >= 1) *(float2*)(po + (size_t)(k - 1) * DM + c0) = h;
        s.x -= hv[k].x; s.y -= hv[k].y;
    }
}
__device__ __forceinline__ void phase_pool_prep(const Params& p, LAS unsigned char* lds, int layer) {
    const int j = layer >> 1, tid = opaque_tid(), c0 = tid * 2, gi = __builtin_amdgcn_readfirstlane(tid >> 7);
    const float* xres = p.out; const float* rssc = (const float*)(p.ws + WS_RSS) + (size_t)(2 * layer) * NTOK * 16;
    const float g0 = p.norm_mix[(size_t)layer * DM + c0], g1 = p.norm_mix[(size_t)layer * DM + c0 + 1];
    bf16_t* dbuf = (bf16_t*)(p.ws + WS_QKV);
    LAS float* rl = (LAS float*)lds;
    for (int u = blockIdx.x; u < 2064; u += gridDim.x) {
        int t0, rowbase; bool isS, lastu; const float* sp = nullptr; float* po;
        if (u < 2048) { const int b = u >> 10; t0 = (u & 1023) * 16; rowbase = b * SEQ; isS = false; lastu = (u & 1023) == 1023; po = p.out + OUT_POOLP + ((size_t)(j * 2 + b) * 15) * DM; }
        else { const int sb = u - 2048; t0 = 0; rowbase = NP + sb * 16; isS = true; lastu = true; sp = p.state_pool + ((size_t)(j * 16 + sb) * 15) * DM; po = p.out + OUT_POOLS + ((size_t)(j * 16 + sb) * 15) * DM; }
        __syncthreads();
        if (tid < 31) { const int t = t0 - 15 + tid; rl[tid] = (t >= 0) ? rs_row(rssc + (size_t)(rowbase + t) * 16) : 0.f; }
        __syncthreads();
        if (gi == 0) pool_unit<2>(xres, sp, rl, dbuf, po, rowbase, t0, c0, g0, g1, isS, lastu);
        else if (gi == 1) pool_unit<4>(xres, sp, rl, dbuf, po, rowbase, t0, c0, g0, g1, isS, lastu);
        else if (gi == 2) pool_unit<8>(xres, sp, rl, dbuf, po, rowbase, t0, c0, g0, g1, isS, lastu);
        else pool_unit<16>(xres, sp, rl, dbuf, po, rowbase, t0, c0, g0, g1, isS, lastu);
    }
}

__device__ __forceinline__ void phase_final(const Params& p) {
    const float* rssc = (const float*)(p.ws + WS_RSS) + (size_t)8 * NTOK * 16;
    for (size_t i = (size_t)blockIdx.x * blockDim.x + opaque_tid(); i < (size_t)NTOK * 256; i += (size_t)gridDim.x * blockDim.x) {
        const int row = (int)(i >> 8), c = (int)(i & 255) * 4;
        const float r = rs_row(rssc + (size_t)row * 16);
        const float4 g = *(const float4*)(p.norm_final + c);
        float4 v = *(const float4*)(p.out + (size_t)row * DM + c);
        v.x *= r * g.x; v.y *= r * g.y; v.z *= r * g.z; v.w *= r * g.w;
        *(float4*)(p.out + (size_t)row * DM + c) = v;
    }
}

__device__ __forceinline__ unsigned offb(unsigned row, unsigned ch) { return 256u * row + 16u * (ch ^ (((row & 3u) << 2) | ((row >> 2) & 3u))); }
__device__ __forceinline__ unsigned img_off(unsigned row, unsigned ch32) { return (ch32 >> 4) * 16384u + offb(row, ch32 & 15u); }
constexpr unsigned IMG_Q = 0, IMG_K = 32768, IMG_V = 65536, IMG_P = 98304, IMG_O = 107520;

__device__ __forceinline__ void tile_load(u32x4 (&r)[4], const bf16_t* g, int ld, int nvalid, int tid_) {
    int tid = tid_; asm volatile("" : "+v"(tid));
    const int r0 = (tid >> 5) & 15, ch = tid & 31;
    const bf16_t* gp = g + (size_t)r0 * ld + ch * 8;
    if (nvalid >= 64) {
#pragma unroll
        for (int i = 0; i < 4; ++i) r[i] = *(const u32x4*)(gp + (size_t)(16 * i) * ld);
    } else {
        r[0] = *(const u32x4*)gp;
        unsigned z = 0u; asm volatile("" : "+v"(z));
#pragma unroll
        for (int i = 1; i < 4; ++i) r[i] = (u32x4){z, z, z, z};
    }
}
__device__ __forceinline__ void tile_store(LAS unsigned char* img, const u32x4 (&r)[4], int tid_) {
    int tid = tid_; asm volatile("" : "+v"(tid));
    const unsigned r0 = (tid >> 5) & 15, ch = tid & 31;
    LAS unsigned char* bp = img + img_off(r0, ch);
#pragma unroll
    for (int i = 0; i < 4; ++i) *(LAS u32x4*)(bp + 4096 * i) = r[i];
}
__device__ __forceinline__ bf16x8 tr_frag(LAS unsigned char* img, int lane, int cblk  , int ks) {
    const unsigned h = lane >> 5, blk = (lane >> 4) & 1, q = (lane & 15) >> 2, pp = lane & 3;
    const unsigned c = cblk & 3;
    const unsigned lowc = 2 * blk + (pp >> 1);
    const unsigned chx0 = ((c ^ q) << 2) | (lowc ^ (2 * h)), chx1 = chx0 ^ 1u;
    const unsigned rb = 256u * (8 * h + q) + 8 * (pp & 1);
    const unsigned a0 = rb + 16u * chx0, a1 = rb + 1024u + 16u * chx1;
    LAS unsigned char* base = img + (cblk >> 2) * 16384 + ks * 4096;
    const s16x4 lo = __builtin_amdgcn_ds_read_tr16_b64_v4i16((LAS s16x4*)(base + a0));
    const s16x4 hi = __builtin_amdgcn_ds_read_tr16_b64_v4i16((LAS s16x4*)(base + a1));
    return __builtin_shufflevector(lo, hi, 0, 1, 2, 3, 4, 5, 6, 7);
}
__device__ __forceinline__ bf16x8 pack8(const f32x16& s, int base) {
    u32x4 w; w.x = cvt_pk_bf16(s[base + 0], s[base + 1]); w.y = cvt_pk_bf16(s[base + 2], s[base + 3]); w.z = cvt_pk_bf16(s[base + 4], s[base + 5]); w.w = cvt_pk_bf16(s[base + 6], s[base + 7]);
    return __builtin_bit_cast(bf16x8, w);
}

__device__ __forceinline__ void state_update(f32x16 (&S)[8], LAS unsigned char* kimg, const bf16x8 (&Vf)[4], int lane) {
#pragma unroll
    for (int dt = 0; dt < 8; ++dt)
#pragma unroll
        for (int ks = 0; ks < 4; ++ks) {
            const bf16x8 a = tr_frag(kimg, lane, dt, ks);
            S[dt] = __builtin_amdgcn_mfma_f32_32x32x16_bf16(a, Vf[ks], S[dt], 0, 0, 0);
        }
}

__device__ __forceinline__ void phase_scan_local(const Params& p, LAS unsigned char* lds) {
    const int tid = opaque_tid(), lane_ = tid & 63, wid = __builtin_amdgcn_readfirstlane(tid >> 6);
    const bf16_t* qkv = (const bf16_t*)(p.ws + WS_QKV); float* T = (float*)(p.ws + WS_T);
    for (int u_ = blockIdx.x; u_ < 256; u_ += gridDim.x) {
        const int u = (gridDim.x == 256) ? (((u_ >> 4) << 4) | ((u_ & 7) << 1) | ((u_ >> 3) & 1)) : u_;
        const int eh = u & 1, seg = (u >> 1) & 15, h = (u >> 5) & 3, b = u >> 7;
        const size_t row0 = (size_t)b * SEQ + (size_t)seg * 1024;
        const bf16_t* kb = qkv + row0 * 4096 + 1024 + h * 256; const bf16_t* vb = qkv + row0 * 4096 + 2048 + h * 512 + eh * 256;
        const float gC = exp2f(64.f * lg2gamma(h));
        f32x16 S[8];
#pragma unroll
        for (int i = 0; i < 8; ++i)
#pragma unroll
            for (int r = 0; r < 16; ++r) S[i][r] = 0.f;
        u32x4 rk0[4], rv0[4], rk1[4], rv1[4];
        tile_load(rk0, kb, 4096, 64, tid); tile_load(rv0, vb, 4096, 64, tid);
        tile_load(rk1, kb + (size_t)64 * 4096, 4096, 64, tid); tile_load(rv1, vb + (size_t)64 * 4096, 4096, 64, tid);
        LDS_BARRIER();
        tile_store(lds, rk0, tid); tile_store(lds + 32768, rv0, tid);
        LDS_BARRIER();
        tile_load(rk0, kb + (size_t)2 * 64 * 4096, 4096, 64, tid); tile_load(rv0, vb + (size_t)2 * 64 * 4096, 4096, 64, tid);
        for (int c = 0; c < 16; c += 2) {
            {
                int lane = lane_; asm volatile("" : "+v"(lane));
                tile_store(lds + 65536, rk1, tid); tile_store(lds + 98304, rv1, tid);
#pragma unroll
                for (int i = 0; i < 8; ++i) S[i] *= gC;
                bf16x8 Vf[4];
#pragma unroll
                for (int ks = 0; ks < 4; ++ks) Vf[ks] = tr_frag(lds + 32768, lane, wid, ks);
                state_update(S, lds, Vf, lane);
                LDS_BARRIER();
                if (c + 3 < 16) { tile_load(rk1, kb + (size_t)(c + 3) * 64 * 4096, 4096, 64, tid); tile_load(rv1, vb + (size_t)(c + 3) * 64 * 4096, 4096, 64, tid); }
            }
            {
                int lane = lane_; asm volatile("" : "+v"(lane));
                if (c + 2 < 16) { tile_store(lds, rk0, tid); tile_store(lds + 32768, rv0, tid); }
#pragma unroll
                for (int i = 0; i < 8; ++i) S[i] *= gC;
                bf16x8 Vf[4];
#pragma unroll
                for (int ks = 0; ks < 4; ++ks) Vf[ks] = tr_frag(lds + 98304, lane, wid, ks);
                state_update(S, lds + 65536, Vf, lane);
                LDS_BARRIER();
                if (c + 4 < 16) { tile_load(rk0, kb + (size_t)(c + 4) * 64 * 4096, 4096, 64, tid); tile_load(rv0, vb + (size_t)(c + 4) * 64 * 4096, 4096, 64, tid); }
            }
        }
        float* Tu = T + (size_t)u * 65536;
        int lz = lane_; asm volatile("" : "+v"(lz));
        const int hl = lz >> 5, e = wid * 32 + (lz & 31);
#pragma unroll
        for (int dt = 0; dt < 8; ++dt)
#pragma unroll
            for (int r = 0; r < 16; ++r) Tu[(size_t)(32 * dt + (r & 3) + 8 * (r >> 2) + 4 * hl) * 256 + e] = S[dt][r];
    }
}

__device__ __forceinline__ void phase_scan_prefix(const Params& p, int jl) {
    float* T = (float*)(p.ws + WS_T);
    const int gt = blockIdx.x * 512 + opaque_tid(), nth = gridDim.x * 512;
    for (int i = gt; i < 262144; i += nth) {
        const int grp = i >> 14, pos = (i & 16383) * 4, eh = grp & 1, bh = grp >> 1, h = bh & 3;
        const float gS = exp2f(1024.f * lg2gamma(h));
        float* base = T + ((size_t)(bh * 16) * 2 + eh) * 65536 + pos;
        float4 t[16];
#pragma unroll
        for (int j = 0; j < 16; ++j) t[j] = *(const float4*)(base + (size_t)j * 131072);
        float zf = 0.f; asm volatile("" : "+v"(zf));
        float4 run = make_float4(zf, zf, zf, zf);
#pragma unroll
        for (int j = 0; j < 16; ++j) {
            *(float4*)(base + (size_t)j * 131072) = run;
            run.x = run.x * gS + t[j].x; run.y = run.y * gS + t[j].y; run.z = run.z * gS + t[j].z; run.w = run.w * gS + t[j].w;
        }
        const int d = pos >> 8, e = pos & 255;
        *(float4*)(p.out + OUT_RETP + ((size_t)((jl * 2 + (bh >> 2)) * 4 + h) * 256 + d) * 512 + eh * 256 + e) = run;
    }
}

__device__ __forceinline__ void phase_scan(const Params& p, LAS unsigned char* lds, int jl) {
    const int tid = opaque_tid(), lane_ = tid & 63, wid = __builtin_amdgcn_readfirstlane(tid >> 6);
    bf16_t* qkv = (bf16_t*)(p.ws + WS_QKV); const float* T = (const float*)(p.ws + WS_T);
    float* gss = (float*)(p.ws + WS_GSS) + (size_t)jl * NTOK * 8;
    for (int v_ = blockIdx.x; v_ < 384; v_ += gridDim.x) {
        const int v = (gridDim.x == 256) ? ((v_ & 256) | (((v_ & 255) >> 4) << 4) | ((v_ & 7) << 1) | ((v_ >> 3) & 1)) : v_;
        int eh, h, Lc, nch; size_t row0; float* Sout = nullptr;
        f32x16 S[8];
        if (v < 256) {
            eh = v & 1; const int seg = (v >> 1) & 15; h = (v >> 5) & 3; const int b = v >> 7;
            row0 = (size_t)b * SEQ + (size_t)seg * 1024; Lc = 64; nch = 16;
            {
                int lz = lane_; asm volatile("" : "+v"(lz)); const int hl_ = lz >> 5, ecol_ = wid * 32 + (lz & 31);
                const float* Tu = T + (size_t)v * 65536;
#pragma unroll
                for (int dt = 0; dt < 8; ++dt)
#pragma unroll
                    for (int r = 0; r < 16; ++r) S[dt][r] = Tu[(size_t)(32 * dt + (r & 3) + 8 * (r >> 2) + 4 * hl_) * 256 + ecol_];
            }
        } else {
            const int su = v - 256; eh = su & 1; h = (su >> 1) & 3; const int sb = su >> 3;
            row0 = (size_t)NP + (size_t)sb * 16; Lc = 16; nch = 1;
            Sout = p.out + OUT_RETS + ((size_t)((jl * 16 + sb) * 4 + h) * 256) * 512 + eh * 256;
            int lz = lane_; asm volatile("" : "+v"(lz)); const int hl_ = lz >> 5, ecol_ = wid * 32 + (lz & 31);
            const float* Sin = p.state_ret + ((size_t)((jl * 16 + sb) * 4 + h) * 256) * 512 + eh * 256;
#pragma unroll
            for (int dt = 0; dt < 8; ++dt)
#pragma unroll
                for (int r = 0; r < 16; ++r) S[dt][r] = Sin[(size_t)(32 * dt + (r & 3) + 8 * (r >> 2) + 4 * hl_) * 512 + ecol_];
        }
        const float lg = lg2gamma(h), gC = exp2f((float)Lc * lg), gCinv = exp2f(-(float)Lc * lg);
        bf16_t* qb = qkv + row0 * 4096 + h * 256; bf16_t* kb = qkv + row0 * 4096 + 1024 + h * 256; bf16_t* vb = qkv + row0 * 4096 + 2048 + h * 512 + eh * 256;
        u32x4 rq[4], rk[4], rv[4];
        tile_load(rq, qb, 4096, Lc, tid); tile_load(rk, kb, 4096, Lc, tid); tile_load(rv, vb, 4096, Lc, tid);
        LDS_BARRIER();
        tile_store(lds + IMG_Q, rq, tid); tile_store(lds + IMG_K, rk, tid); tile_store(lds + IMG_V, rv, tid);
        LDS_BARRIER();
        for (int c = 0; c < nch; ++c) {
            int lane = lane_; asm volatile("" : "+v"(lane)); const int hl = lane >> 5, ecol = wid * 32 + (lane & 31);
            {
                const int mi = wid >> 1, nj0 = 2 * (wid & 1), l15 = lane & 15, l4 = lane >> 4;
                f32x4 sc[2] = {(f32x4){0.f, 0.f, 0.f, 0.f}, (f32x4){0.f, 0.f, 0.f, 0.f}};
#pragma unroll
                for (int s = 0; s < 8; ++s) {
                    const bf16x8 a = *(const LAS bf16x8*)(lds + IMG_K + img_off(16 * mi + l15, 4 * s + l4));
#pragma unroll
                    for (int t = 0; t < 2; ++t) {
                        const bf16x8 bq = *(const LAS bf16x8*)(lds + IMG_Q + img_off(16 * (nj0 + t) + l15, 4 * s + l4));
                        sc[t] = __builtin_amdgcn_mfma_f32_16x16x32_bf16(a, bq, sc[t], 0, 0, 0);
                    }
                }
#pragma unroll
                for (int t = 0; t < 2; ++t) {
                    const int n = 16 * (nj0 + t) + l15, m0 = 16 * mi + 4 * l4;
                    float pv[4];
#pragma unroll
                    for (int r = 0; r < 4; ++r) pv[r] = (n >= m0 + r) ? sc[t][r] * gCinv : 0.f;
                    u32x2 w; w.x = cvt_pk_bf16(pv[0], pv[1]); w.y = cvt_pk_bf16(pv[2], pv[3]);
                    *(LAS u32x2*)(lds + IMG_P + n * 144 + m0 * 2) = w;
                }
            }
            LDS_BARRIER();
            f32x16 o[2];
#pragma unroll
            for (int nt = 0; nt < 2; ++nt)
#pragma unroll
                for (int r = 0; r < 16; ++r) o[nt][r] = 0.f;
#pragma unroll
            for (int s = 0; s < 16; ++s) {
                const bf16x8 bs = pack8(S[s >> 1], 8 * (s & 1));
#pragma unroll
                for (int nt = 0; nt < 2; ++nt) {
                    const unsigned rown = 32 * nt + (lane & 31);
                    const u32x2 lo = *(const LAS u32x2*)(lds + IMG_Q + img_off(rown, 2 * s) + 8 * hl);
                    const u32x2 hi = *(const LAS u32x2*)(lds + IMG_Q + img_off(rown, 2 * s + 1) + 8 * hl);
                    const u32x4 aw = (u32x4){lo.x, lo.y, hi.x, hi.y};
                    o[nt] = __builtin_amdgcn_mfma_f32_32x32x16_bf16(__builtin_bit_cast(bf16x8, aw), bs, o[nt], 0, 0, 0);
                }
            }
            bf16x8 Vf[4];
#pragma unroll
            for (int ks = 0; ks < 4; ++ks) Vf[ks] = tr_frag(lds + IMG_V, lane, wid, ks);
#pragma unroll
            for (int ks = 0; ks < 4; ++ks)
#pragma unroll
                for (int nt = 0; nt < 2; ++nt) {
                    const bf16x8 a = *(const LAS bf16x8*)(lds + IMG_P + (32 * nt + (lane & 31)) * 144 + (16 * ks + 8 * hl) * 2);
                    o[nt] = __builtin_amdgcn_mfma_f32_32x32x16_bf16(a, Vf[ks], o[nt], 0, 0, 0);
                }
            {
                LAS unsigned char* oi = lds + IMG_O + (4 * hl) * 528 + ecol * 2;
#pragma unroll
                for (int nt = 0; nt < 2; ++nt)
#pragma unroll
                    for (int r = 0; r < 16; ++r) *(LAS bf16_t*)(oi + (32 * nt + (r & 3) + 8 * (r >> 2)) * 528) = (bf16_t)cvt_pk_bf16(o[nt][r], o[nt][r]);
            }
            if (c + 1 < nch) { tile_load(rk, kb + (size_t)(c + 1) * 64 * 4096, 4096, 64, tid); tile_load(rv, vb + (size_t)(c + 1) * 64 * 4096, 4096, 64, tid); }
#pragma unroll
            for (int i = 0; i < 8; ++i) S[i] *= gC;
            {
                int lane2 = lane_; asm volatile("" : "+v"(lane2));
                bf16x8 Vg[4];
#pragma unroll
                for (int ks = 0; ks < 4; ++ks) Vg[ks] = tr_frag(lds + IMG_V, lane2, wid, ks);
                state_update(S, lds + IMG_K, Vg, lane2);
            }
            __builtin_amdgcn_sched_barrier(0);
            LDS_BARRIER();
            if (c + 1 < nch) { tile_load(rq, qb + (size_t)(c + 1) * 64 * 4096, 4096, 64, tid); tile_store(lds + IMG_K, rk, tid); tile_store(lds + IMG_V, rv, tid); tile_store(lds + IMG_Q, rq, tid); }
            {
                int t2 = tid; asm volatile("" : "+v"(t2));
                const int r0 = (t2 >> 5) & 15, ch = t2 & 31;
                bf16_t* og = vb + (size_t)c * 64 * 4096 + (size_t)r0 * 4096 + ch * 8;
#pragma unroll
                for (int i = 0; i < 4; ++i) {
                    if (i == 0 || Lc == 64) {
                        const u32x4 w = *(const LAS u32x4*)(lds + IMG_O + (r0 + 16 * i) * 528 + ch * 16);
                        *(u32x4*)(og + (size_t)(16 * i) * 4096) = w;
                        const float a0 = __uint_as_float(w.x << 16), a1 = __uint_as_float(w.x & 0xffff0000u), a2 = __uint_as_float(w.y << 16), a3 = __uint_as_float(w.y & 0xffff0000u);
                        const float a4 = __uint_as_float(w.z << 16), a5 = __uint_as_float(w.z & 0xffff0000u), a6 = __uint_as_float(w.w << 16), a7 = __uint_as_float(w.w & 0xffff0000u);
                        float ss = ((a0 * a0 + a1 * a1) + (a2 * a2 + a3 * a3)) + ((a4 * a4 + a5 * a5) + (a6 * a6 + a7 * a7));
                        ss += __shfl_xor(ss, 16); ss += __shfl_xor(ss, 8); ss += __shfl_xor(ss, 4); ss += __shfl_xor(ss, 2); ss += __shfl_xor(ss, 1);
                        if (ch == 0) gss[((row0 + (size_t)c * 64 + r0 + 16 * i) * 4 + h) * 2 + eh] = ss;
                    }
                }
            }
            LDS_BARRIER();
        }
        if (Sout) {
            int lz = lane_; asm volatile("" : "+v"(lz)); const int hl_ = lz >> 5, ecol_ = wid * 32 + (lz & 31);
#pragma unroll
            for (int dt = 0; dt < 8; ++dt)
#pragma unroll
                for (int r = 0; r < 16; ++r) Sout[(size_t)(32 * dt + (r & 3) + 8 * (r >> 2) + 4 * hl_) * 512 + ecol_] = S[dt][r];
        }
    }
}

struct PoolOrder : pg8::StaticOrder {
    __device__ __forceinline__ bool next(int i, Unit& u) const { const bool ok = pg8::StaticOrder::next(i, u); if (ok) u.kofs = u.pn * 256; return ok; }
};
template <class Epi>
__device__ __forceinline__ void run_gemm(LAS unsigned char* lds, const bf16_t* A, int lda, const bf16_t* Bt, int N, int K, const Epi& E, int M = NTOK) {
    pg8::Gemm g{A, Bt, M, N, K, lda, K}; pg8::StaticOrder S; S.init(M, N, (int)gridDim.x, (int)blockIdx.x);
    pg8::gemm_phase<Epi, pg8::StaticOrder, false>(lds, g, S, E, nullptr);
}

__device__ __forceinline__ void narrow_core(LAS unsigned char* lds, const bf16_t* ag, int lda, const bf16_t* bg0, const bf16_t* bg1, int K, f32x16& acc0, f32x16& acc1, int tid, int lane, int wid) {
    const int lr = tid >> 4, lc = tid & 15, hl = lane >> 5, l31 = lane & 31;
#pragma unroll
    for (int i = 0; i < 16; ++i) { acc0[i] = 0.f; acc1[i] = 0.f; }
    u32x4 ra0[8], rb0[2], ra1[8], rb1[2];
#define NR_LOAD(RA, RB, KO) do { int ko_ = (KO); asm volatile("" : "+s"(ko_)); const bf16_t* agp = ag + ko_; const bf16_t* b0p = bg0 + ko_; const bf16_t* b1p = bg1 + ko_; \
        _Pragma("unroll") for (int q = 0; q < 8; ++q) { RA[q] = *(const u32x4*)agp; agp += (size_t)32 * lda; } \
        RB[0] = *(const u32x4*)b0p; RB[1] = *(const u32x4*)b1p; } while (0)
#define NR_STORE(RA, RB) do { _Pragma("unroll") for (int q = 0; q < 8; ++q) *(LAS u32x4*)(lds + (q >> 1) * 16384 + offb((q & 1) * 32 + lr, lc)) = RA[q]; \
        *(LAS u32x4*)(lds + 65536 + offb(lr, lc)) = RB[0]; *(LAS u32x4*)(lds + 65536 + offb(32 + lr, lc)) = RB[1]; } while (0)
#define NR_COMPUTE() do { LAS unsigned char* ai = lds + (wid >> 1) * 16384; const unsigned arow = (wid & 1) * 32 + l31; \
        _Pragma("unroll") for (int q = 0; q < 8; ++q) { \
            const bf16x8 a = *(const LAS bf16x8*)(ai + offb(arow, 2 * q + hl)); \
            const bf16x8 x0 = *(const LAS bf16x8*)(lds + 65536 + offb(l31, 2 * q + hl)); \
            const bf16x8 x1 = *(const LAS bf16x8*)(lds + 65536 + offb(32 + l31, 2 * q + hl)); \
            acc0 = __builtin_amdgcn_mfma_f32_32x32x16_bf16(a, x0, acc0, 0, 0, 0); acc1 = __builtin_amdgcn_mfma_f32_32x32x16_bf16(a, x1, acc1, 0, 0, 0); } } while (0)
    NR_LOAD(ra0, rb0, 0); NR_LOAD(ra1, rb1, 128);
    LDS_BARRIER();
    for (int k = 0; k < K; k += 256) {
        NR_STORE(ra0, rb0); LDS_BARRIER();
        if (k + 256 < K) NR_LOAD(ra0, rb0, k + 256);
        NR_COMPUTE(); LDS_BARRIER();
        NR_STORE(ra1, rb1); LDS_BARRIER();
        if (k + 384 < K) NR_LOAD(ra1, rb1, k + 384);
        NR_COMPUTE(); LDS_BARRIER();
    }
#undef NR_LOAD
#undef NR_STORE
#undef NR_COMPUTE
}
__device__ __forceinline__ void narrow_scales(LAS unsigned char* lds, const float* rss, int tid) {
    if (tid < 256) ((LAS float*)(lds + 81920))[tid] = rs_row(rss + (size_t)(NP + tid) * 16);
}
__device__ __forceinline__ void narrow_ffn(LAS unsigned char* lds, const bf16_t* xb, const bf16_t* Wfi, bf16_t* act, const float* rss) {
    const int tid = opaque_tid(), lane = tid & 63, wid = __builtin_amdgcn_readfirstlane(tid >> 6), lr = tid >> 4, lc = tid & 15;
    for (int j = blockIdx.x; j < 88; j += gridDim.x) {
        const int jj = 32 * j + lr, dra = (jj >> 7) * 256 + (jj & 127);
        f32x16 acc0, acc1;
        __syncthreads(); narrow_scales(lds, rss, tid);
        narrow_core(lds, xb + (size_t)(NP + lr) * DM + lc * 8, DM, Wfi + (size_t)dra * DM + lc * 8, Wfi + (size_t)(dra + 128) * DM + lc * 8, DM, acc0, acc1, tid, lane, wid);
        int lz = lane; asm volatile("" : "+v"(lz)); const int hl = lz >> 5, l31 = lz & 31;
#pragma unroll
        for (int i = 0; i < 16; ++i) {
            const int rs = 32 * wid + (i & 3) + 8 * (i >> 2) + 4 * hl; const float r = ((const LAS float*)(lds + 81920))[rs];
            act[(size_t)(NP + rs) * DFF + 32 * j + l31] = f2bf(silu_f(acc0[i] * r) * (acc1[i] * r));
        }
    }
}
__device__ __forceinline__ void narrow_qkv(LAS unsigned char* lds, const bf16_t* xb, const bf16_t* Wri, bf16_t* qkv, const float* rss, const float* cosT, const float* sinT) {
    const int tid = opaque_tid(), lane = tid & 63, wid = __builtin_amdgcn_readfirstlane(tid >> 6), lr = tid >> 4, lc = tid & 15;
    for (int j = blockIdx.x; j < 64; j += gridDim.x) {
        const bool rot = j < 32; const int hd = j >> 2, j0 = (j & 3) * 32;
        const int cA = rot ? hd * 256 + j0 : 2048 + (j - 32) * 64, cB = rot ? cA + 128 : cA + 32;
        f32x16 acc0, acc1;
        __syncthreads(); narrow_scales(lds, rss, tid);
        narrow_core(lds, xb + (size_t)(NP + lr) * DM + lc * 8, DM, Wri + (size_t)(cA + lr) * DM + lc * 8, Wri + (size_t)(cB + lr) * DM + lc * 8, DM, acc0, acc1, tid, lane, wid);
        int lz = lane; asm volatile("" : "+v"(lz)); const int hl = lz >> 5, l31 = lz & 31;
        const float lg = lg2gamma(hd & 3);
        float cs[16], sn_[16];
        if (rot) {
#pragma unroll
            for (int i = 0; i < 16; ++i) { const int l = (32 * wid + (i & 3) + 8 * (i >> 2) + 4 * hl) & 15; cs[i] = cosT[(size_t)(1024 + l) * 128 + j0 + l31]; sn_[i] = sinT[(size_t)(1024 + l) * 128 + j0 + l31]; }
        }
#pragma unroll
        for (int i = 0; i < 16; ++i) {
            const int rs = 32 * wid + (i & 3) + 8 * (i >> 2) + 4 * hl; const float r = ((const LAS float*)(lds + 81920))[rs];
            bf16_t* op = qkv + (size_t)(NP + rs) * 4096;
            if (rot) {
                const int l = rs & 15; const float e = (hd < 4) ? (float)(l + 1) : (float)(15 - l);
                const float dec = exp2f(e * lg) * r, x1 = acc0[i] * dec, x2 = acc1[i] * dec;
                const float c = cs[i], sn = sn_[i];
                op[cA + l31] = f2bf(x1 * c - x2 * sn); op[cB + l31] = f2bf(x1 * sn + x2 * c);
            } else { op[cA + l31] = f2bf(acc0[i] * r); op[cB + l31] = f2bf(acc1[i] * r); }
        }
    }
}
__device__ __forceinline__ void narrow_gate(LAS unsigned char* lds, const bf16_t* xb, const bf16_t* Wg, bf16_t* qkv, const float* rss, const float* gss) {
    const int tid = opaque_tid(), lane = tid & 63, wid = __builtin_amdgcn_readfirstlane(tid >> 6), lr = tid >> 4, lc = tid & 15;
    for (int j = blockIdx.x; j < 32; j += gridDim.x) {
        const int cA = j * 64, head = j >> 3;
        f32x16 acc0, acc1;
        __syncthreads(); narrow_scales(lds, rss, tid);
        if (tid < 256) { const float2 gp = *(const float2*)(gss + ((size_t)(NP + tid) * 4 + head) * 2); ((LAS float*)(lds + 81920 + 1024))[tid] = __builtin_amdgcn_rsqf((gp.x + gp.y) * (1.0f / 512.0f) + EPS); }
        narrow_core(lds, xb + (size_t)(NP + lr) * DM + lc * 8, DM, Wg + (size_t)(cA + lr) * DM + lc * 8, Wg + (size_t)(cA + 32 + lr) * DM + lc * 8, DM, acc0, acc1, tid, lane, wid);
        int lz = lane; asm volatile("" : "+v"(lz)); const int hl = lz >> 5, l31 = lz & 31;
        unsigned short ob0[16], ob1[16];
#pragma unroll
        for (int i = 0; i < 16; ++i) { const bf16_t* op = qkv + (size_t)(NP + 32 * wid + (i & 3) + 8 * (i >> 2) + 4 * hl) * 4096 + 2048 + cA + l31; ob0[i] = op[0]; ob1[i] = op[32]; }
#pragma unroll
        for (int i = 0; i < 16; ++i) {
            const int rs = 32 * wid + (i & 3) + 8 * (i >> 2) + 4 * hl; const float r = ((const LAS float*)(lds + 81920))[rs], rn = ((const LAS float*)(lds + 81920 + 1024))[rs];
            bf16_t* op = qkv + (size_t)(NP + rs) * 4096 + 2048 + cA + l31;
            const float o0 = __uint_as_float(((unsigned)ob0[i]) << 16), o1 = __uint_as_float(((unsigned)ob1[i]) << 16);
            op[0] = f2bf(silu_f(acc0[i] * r) * o0 * rn); op[32] = f2bf(silu_f(acc1[i] * r) * o1 * rn);
        }
    }
}
__device__ __forceinline__ void narrow_res(LAS unsigned char* lds, const bf16_t* A, int lda, const bf16_t* Bt, int K, const EpiRes& E, int ldb = 0, int kstep = 0) {
    const int tid = opaque_tid(), lane = tid & 63, wid = __builtin_amdgcn_readfirstlane(tid >> 6), lr = tid >> 4, lc = tid & 15;
    for (int j = blockIdx.x; j < 16; j += gridDim.x) {
        const int pn = j >> 2, wc = j & 3, c0 = pn * 256 + wc * 32;
        f32x16 acc0, acc1;
        __syncthreads();
        const int ldb_ = ldb ? ldb : K, ko = pn * kstep;
        narrow_core(lds, A + (size_t)(NP + lr) * lda + ko + lc * 8, lda, Bt + (size_t)(c0 + lr) * ldb_ + ko + lc * 8, Bt + (size_t)(c0 + 128 + lr) * ldb_ + ko + lc * 8, K, acc0, acc1, tid, lane, wid);
        float sq[16];
        int lz = lane; asm volatile("" : "+v"(lz)); const int hl = lz >> 5, l31 = lz & 31;
        float bb0[16], bb1[16];
#pragma unroll
        for (int i = 0; i < 16; ++i) { const float* bp = E.base_s + (size_t)(32 * wid + (i & 3) + 8 * (i >> 2) + 4 * hl) * DM + c0 + l31; bb0[i] = bp[0]; bb1[i] = bp[128]; }
#pragma unroll
        for (int i = 0; i < 16; ++i) {
            const int rs = 32 * wid + (i & 3) + 8 * (i >> 2) + 4 * hl;
            const float v0 = bb0[i] + acc0[i], v1 = bb1[i] + acc1[i];
            float* xo = E.xres + (size_t)(NP + rs) * DM + c0 + l31; xo[0] = v0; xo[128] = v1;
            if (E.xb) { bf16_t* bo = E.xb + (size_t)(NP + rs) * DM + c0 + l31; bo[0] = f2bf(v0); bo[128] = f2bf(v1); }
            sq[i] = v0 * v0 + v1 * v1;
        }
        float s8[8], s4[4], s2[2], s1;
        { const bool bit = (lane & 16) != 0;
#pragma unroll
          for (int i = 0; i < 8; ++i) { const float keep = bit ? sq[i + 8] : sq[i], send = bit ? sq[i] : sq[i + 8]; s8[i] = keep + __shfl_xor(send, 16); } }
        { const bool bit = (lane & 8) != 0;
#pragma unroll
          for (int i = 0; i < 4; ++i) { const float keep = bit ? s8[i + 4] : s8[i], send = bit ? s8[i] : s8[i + 4]; s4[i] = keep + __shfl_xor(send, 8); } }
        { const bool bit = (lane & 4) != 0;
#pragma unroll
          for (int i = 0; i < 2; ++i) { const float keep = bit ? s4[i + 2] : s4[i], send = bit ? s4[i] : s4[i + 2]; s2[i] = keep + __shfl_xor(send, 4); } }
        { const bool bit = (lane & 2) != 0; const float keep = bit ? s2[1] : s2[0], send = bit ? s2[0] : s2[1]; s1 = keep + __shfl_xor(send, 2); }
        s1 += __shfl_xor(s1, 1);
        const int idx = (lane >> 1) & 15, rs = 32 * wid + (idx & 3) + 8 * (idx >> 2) + 4 * hl;
        if ((lane & 1) == 0) E.rss_next[(size_t)(NP + rs) * 16 + pn * 4 + wc] = s1;
    }
}

__device__ __forceinline__ void run_phase(const Params& p_, LAS unsigned char* lds, int ph_) {
    const bool nonarrow = false; const int ph = ph_ >= 100 ? ph_ - 100 : ph_;
    Params p = p_; { size_t z0 = 0, z1 = 0; asm volatile("" : "+s"(z0), "+s"(z1)); p.ws = p_.ws + z0; p.out = p_.out + z1; }
    bf16_t* xb = (bf16_t*)(p.ws + WS_XB); bf16_t* qkv = (bf16_t*)(p.ws + WS_QKV); float* rss = (float*)(p.ws + WS_RSS); float* gss = (float*)(p.ws + WS_GSS);
    const bf16_t* Wri = (const bf16_t*)(p.ws + WS_WRI); const bf16_t* Wro = (const bf16_t*)(p.ws + WS_WRO); const bf16_t* Wpl = (const bf16_t*)(p.ws + WS_WPL);
    const bf16_t* Wfi = (const bf16_t*)(p.ws + WS_WFI); const bf16_t* Wfo = (const bf16_t*)(p.ws + WS_WFO);
    float* xres = p.out;
    if (ph == NPHASE - 1) { phase_final(p); return; }
    int layer, step;
    if (ph < 9) { layer = 0; step = ph - 1; } else if (ph < 13) { layer = 1; step = ph - 9; } else if (ph < 21) { layer = 2; step = ph - 13; } else { layer = 3; step = ph - 21; }
    const int jl = layer >> 1;
    const bool is_ret = (layer & 1) == 0;
    const int fstep = is_ret ? step - 6 : step - 2;
    if (step == 0 && layer >= 1) { convert_ffn(p, lds, layer); if (layer + 1 < 4) convert_mixer(p, lds, layer + 1); __syncthreads(); }
    if (fstep == 0) { EpiFfn E{qkv, rss + (size_t)(2 * layer + 1) * NTOK * 16}; run_gemm(lds, xb, 1024, Wfi, 5632, 1024, E, NP); if (!nonarrow) narrow_ffn(lds, xb, Wfi, qkv, rss + (size_t)(2 * layer + 1) * NTOK * 16); return; }
    if (fstep == 1) { EpiRes E{xres, xres + (size_t)NP * DM, xres, layer == 1 ? xb : (bf16_t*)nullptr  , rss + (size_t)(2 * layer + 2) * NTOK * 16}; run_gemm(lds, qkv, DFF, Wfo, 1024, DFF, E, NP); narrow_res(lds, qkv, DFF, Wfo, DFF, E); return; }
    if (is_ret) {
        if (step == 0) { EpiQKV E{qkv, rss + (size_t)(2 * layer) * NTOK * 16, (const float*)(p.ws + WS_COS), (const float*)(p.ws + WS_SIN)}; run_gemm(lds, xb, 1024, Wri, 4096, 1024, E, NP); if (!nonarrow) narrow_qkv(lds, xb, Wri, qkv, rss + (size_t)(2 * layer) * NTOK * 16, (const float*)(p.ws + WS_COS), (const float*)(p.ws + WS_SIN)); }
        else if (step == 1) phase_scan_local(p, lds);
        else if (step == 2) phase_scan_prefix(p, jl);
        else if (step == 3) phase_scan(p, lds, jl);
        else if (step == 4) { EpiGate E{qkv, rss + (size_t)(2 * layer) * NTOK * 16, gss + (size_t)jl * NTOK * 8}; run_gemm(lds, xb, 1024, Wri + (size_t)4096 * 1024, 2048, 1024, E, NP); narrow_gate(lds, xb, Wri + (size_t)4096 * 1024, qkv, rss + (size_t)(2 * layer) * NTOK * 16, gss + (size_t)jl * NTOK * 8); }
        else if (step == 5) {
            const float* bp = layer == 0 ? p.x_prompt : xres; const float* bs = layer == 0 ? p.x_sample : xres + (size_t)NP * DM;
            EpiRes E{bp, bs, xres, xb, rss + (size_t)(2 * layer + 1) * NTOK * 16};
            run_gemm(lds, qkv + 2048, 4096, Wro, 1024, 2048, E, NP); narrow_res(lds, qkv + 2048, 4096, Wro, 2048, E);
        }
    } else {
        if (step == 0) phase_pool_prep(p, lds, layer);
        else if (step == 1) { EpiRes E{xres, xres + (size_t)NP * DM, xres, xb, rss + (size_t)(2 * layer + 1) * NTOK * 16}; pg8::Gemm g{qkv, Wpl, NP, 1024, 256, 1024, 1024}; PoolOrder S; S.init(NP, 1024, (int)gridDim.x, (int)blockIdx.x);
            pg8::gemm_phase<EpiRes, PoolOrder, false>(lds, g, S, E, nullptr); narrow_res(lds, qkv, 1024, Wpl, 256, E, 1024, 256); }
    }
}

__global__ void __launch_bounds__(512) mega(Params p) {
    extern __shared__ __attribute__((aligned(16))) unsigned char lds_raw[];
    LAS unsigned char* lds = (LAS unsigned char*)lds_raw;
    volatile LAS unsigned* bst = (volatile LAS unsigned*)(lds + LDS_MAIN);
    if (threadIdx.x == 0) { bst[0] = 0u; bst[1] = 0u; }
    __syncthreads();
    const XcdBarrier gbar = xcd_barrier_post((unsigned*)(p.ws + WS_BAR), bst);
#define GRID_SYNC() xcd_barrier(gbar)
#ifdef MK_PRE_SYNCS
    for (int i = 0; i < MK_PRE_SYNCS; ++i) GRID_SYNC();
#endif
#ifdef MK_PRE_MASK
#define MK_PRE(PH) if ((MK_PRE_MASK >> PH) & 1) { if (PH == 0) phase0(p, lds); else run_phase(p, lds, PH); GRID_SYNC(); }
    MK_PRE(0) MK_PRE(1) MK_PRE(2) MK_PRE(3) MK_PRE(4) MK_PRE(5) MK_PRE(6) MK_PRE(7) MK_PRE(8) MK_PRE(9) MK_PRE(10) MK_PRE(11) MK_PRE(12) MK_PRE(25)
#endif
    int ph = p.ph_lo;
    if (p.ph_hi < 0) cg::this_grid().sync();
    if (ph == 0) { phase0(p, lds); ++ph; if (ph < p.ph_hi) { GRID_SYNC(); } }
#ifdef MK_PRE_PH
    ph = 1 - MK_PRE_REP;
#endif
    for (; ph < p.ph_hi; ++ph) {
#ifdef MK_PRE_PH
        const int phx = (ph < 1) ? MK_PRE_PH + 100 : ph;
#else
        const int phx = ph;
#endif
        run_phase(p, lds, phx);
        if (ph + 1 < p.ph_hi) { GRID_SYNC(); }
    }
}
}

#ifndef MK_SINGLE
#define MK_SINGLE 1
#endif
extern "C" void kernel_launch(void* const* d_in, const int* in_sizes, int n_in, void* d_out, int out_size, void* d_ws, size_t ws_size, hipStream_t stream) {
    static int grid = 0;
    constexpr int LDS_BYTES = mk::LDS_TOTAL;
    if (grid == 0) {
        int dev = 0, cus = 0, per_cu = 0;
        hipGetDevice(&dev); hipDeviceGetAttribute(&cus, hipDeviceAttributeMultiprocessorCount, dev);
        if (hipFuncSetAttribute((const void*)mk::mega, hipFuncAttributeMaxDynamicSharedMemorySize, LDS_BYTES) != hipSuccess) { fprintf(stderr, "hipFuncSetAttribute failed\n"); }
        if (hipOccupancyMaxActiveBlocksPerMultiprocessor(&per_cu, (const void*)mk::mega, 512, LDS_BYTES) != hipSuccess || per_cu < 1) { fprintf(stderr, "occupancy query: %d\n", per_cu); per_cu = 1; }
        (void)hipGetLastError();
        grid = cus * (per_cu < 1 ? 1 : per_cu);
        if (grid <= 0) grid = 256;
    }
    if (ws_size < mk::WS_END) { fprintf(stderr, "workspace too small: %zu < %zu\n", ws_size, (size_t)mk::WS_END); return; }
    mk::Params p{};
    p.x_prompt = (const float*)d_in[0]; p.x_sample = (const float*)d_in[1]; p.state_ret = (const float*)d_in[2]; p.state_pool = (const float*)d_in[3];
    p.norm_mix = (const float*)d_in[4]; p.w_ret_in = (const float*)d_in[5]; p.w_ret_out = (const float*)d_in[6]; p.w_pool = (const float*)d_in[7];
    p.pool_scale = (const float*)d_in[8]; p.norm_ffn = (const float*)d_in[9]; p.w_ffn_in = (const float*)d_in[10]; p.w_ffn_out = (const float*)d_in[11]; p.norm_final = (const float*)d_in[12];
    p.out = (float*)d_out; p.ws = (unsigned char*)d_ws;
#if MK_SINGLE
    hipMemsetAsync((unsigned char*)d_ws + mk::WS_BAR, 0, XCD_BAR_WORDS * 4, stream);
    p.ph_lo = 0; p.ph_hi = mk::NPHASE;
    void* args[] = {&p};
    hipError_t e = hipLaunchCooperativeKernel((const void*)mk::mega, dim3(grid), dim3(512), args, LDS_BYTES, stream);
    if (e != hipSuccess) fprintf(stderr, "cooperative launch failed: %s (grid %d)\n", hipGetErrorString(e), grid);
#else
#ifndef MK_STOP
#define MK_STOP 23
#endif
    for (int ph = 0; ph < mk::NPHASE; ++ph) {
        p.ph_lo = ph; p.ph_hi = ph + 1;
        hipLaunchKernelGGL(mk::mega, dim3(grid), dim3(512), LDS_BYTES, stream, p);
    }
#endif
}
```
